# Optimizing an MI355X kernel written in HIP

```python
import jax, jax.numpy as jnp
from jax import lax
import numpy as np

D_MODEL = 2048
BATCH = 2
SEQ = 8192
DEPTH = 2

HEAD_DIM = 128
BLOCK_Q = 128
ROPE_THETA = 10000.0
LN_EPS = 1e-5
RMS_EPS = 1e-6

MLA_HEADS = 10
MLA_Q_RANK = 448
MLA_KV_RANK = 128
MLA_NOPE_DIM = 128
MLA_ROPE_DIM = 64
MLA_V_DIM = 128
MLA_QK_DIM = MLA_NOPE_DIM + MLA_ROPE_DIM

DIL_PATTERNS = ((128, 1), (512, 4), (2048, 16))
DIL_GROUPS = len(DIL_PATTERNS)
DIL_HEADS = 6

OFF_CQ = 0
OFF_CKV = OFF_CQ + MLA_Q_RANK
OFF_KROPE = OFF_CKV + MLA_KV_RANK
OFF_DQ = OFF_KROPE + MLA_ROPE_DIM
OFF_DK = OFF_DQ + DIL_GROUPS * DIL_HEADS * HEAD_DIM
OFF_DV = OFF_DK + DIL_HEADS * HEAD_DIM
W_IN_COLS = OFF_DV + DIL_HEADS * HEAD_DIM
MIX_WIDTH = MLA_HEADS * MLA_V_DIM + DIL_HEADS * HEAD_DIM

FOX_HEADS = 16
FOX_WIDTH = FOX_HEADS * HEAD_DIM

D_FF = 5632
N_EXPERTS = 8
TOP_K = 2

ALPHA = (2.0 * DEPTH) ** 0.25
BETA = (8.0 * DEPTH) ** -0.25
N_EVEN_LAYERS = (DEPTH + 1) // 2
N_ODD_LAYERS = DEPTH // 2

kernel_name = "hybrid_mla_dilated_fox_moe_deepnorm"

F32 = jnp.float32


def layer_norm(x, g, b):
    xf = x.astype(F32)
    mu = jnp.mean(xf, axis=-1, keepdims=True)
    var = jnp.mean(jnp.square(xf - mu), axis=-1, keepdims=True)
    return ((xf - mu) * lax.rsqrt(var + LN_EPS) * g.astype(F32) + b.astype(F32)).astype(x.dtype)


def rms_norm(x, g):
    xf = x.astype(F32)
    y = xf * lax.rsqrt(jnp.mean(jnp.square(xf), axis=-1, keepdims=True) + RMS_EPS)
    return (y * g.astype(F32)).astype(x.dtype)


def rope_tables(seq, dim):
    inv_freq = 1.0 / (ROPE_THETA ** (jnp.arange(0, dim, 2, dtype=F32) / dim))
    ang = jnp.arange(seq, dtype=F32)[:, None] * inv_freq[None, :]
    return jnp.cos(ang), jnp.sin(ang)


def apply_rope(x, cos, sin):
    half = x.shape[-1] // 2
    xf = x.astype(F32)
    x1, x2 = xf[..., :half], xf[..., half:]
    c = cos[None, :, None, :]
    s = sin[None, :, None, :]
    return jnp.concatenate([x1 * c - x2 * s, x2 * c + x1 * s], axis=-1).astype(x.dtype)


def _to_blocks(a):
    b, s = a.shape[0], a.shape[1]
    a = a.reshape((b, s // BLOCK_Q, BLOCK_Q) + a.shape[2:])
    return jnp.moveaxis(a, 1, 0)


def _from_blocks(a):
    a = jnp.moveaxis(a, 0, 1)
    return a.reshape((a.shape[0], a.shape[1] * a.shape[2]) + a.shape[3:])


def causal_block_attention(q, k, v, scale, log_f_cum=None):
    seq = q.shape[1]
    kpos = jnp.arange(seq)
    qb = _to_blocks(q)
    blk_idx = jnp.arange(qb.shape[0])
    if log_f_cum is None:
        xs = (blk_idx, qb)
    else:
        c_keys = jnp.transpose(log_f_cum, (0, 2, 1))[:, :, None, :]
        xs = (blk_idx, qb, _to_blocks(log_f_cum))

    def one_block(args):
        i, q_blk = args[0], args[1]
        qpos = i * BLOCK_Q + jnp.arange(BLOCK_Q)
        s = jnp.einsum('bqhd,bkhd->bhqk', q_blk, k, preferred_element_type=F32) * scale
        if log_f_cum is not None:
            c_q = jnp.transpose(args[2], (0, 2, 1))[..., None]
            s = s + (c_q - c_keys)
        s = jnp.where((kpos[None, :] <= qpos[:, None])[None, None], s, -jnp.inf)
        p = jax.nn.softmax(s, axis=-1)
        return jnp.einsum('bhqk,bkhd->bqhd', p.astype(v.dtype), v)

    return _from_blocks(lax.map(one_block, xs))


def dilated_group_attention(q, k, v, window, dilation, scale):
    offs = jnp.arange(window // dilation + 1) * dilation
    qb = _to_blocks(q)

    def one_block(args):
        i, q_blk = args
        qpos = i * BLOCK_Q + jnp.arange(BLOCK_Q)
        kidx = qpos[:, None] - offs[None, :]
        valid = kidx >= 0
        kidx = jnp.maximum(kidx, 0)
        k_g = jnp.take(k, kidx, axis=1)
        v_g = jnp.take(v, kidx, axis=1)
        s = jnp.einsum('bqhd,bqjhd->bhqj', q_blk, k_g, preferred_element_type=F32) * scale
        s = jnp.where(valid[None, None], s, -jnp.inf)
        lse = jax.nn.logsumexp(s, axis=-1, keepdims=True)
        p = jnp.exp(s - lse)
        o = jnp.einsum('bhqj,bqjhd->bqhd', p.astype(v.dtype), v_g)
        return o, jnp.transpose(lse[..., 0], (0, 2, 1))

    o, lse = lax.map(one_block, (jnp.arange(qb.shape[0]), qb))
    return _from_blocks(o), _from_blocks(lse)


def mla_dilated_mixer(x, w_in, q_norm, w_q_b, kv_norm, w_kv_b, w_out, cos64, sin64, cos128, sin128):
    b, s, _ = x.shape
    h = x @ w_in
    c_q = rms_norm(h[..., OFF_CQ:OFF_CKV], q_norm)
    q = (c_q @ w_q_b).reshape(b, s, MLA_HEADS, MLA_QK_DIM)
    q = jnp.concatenate([q[..., :MLA_NOPE_DIM],
                         apply_rope(q[..., MLA_NOPE_DIM:], cos64, sin64)], axis=-1)
    c_kv = rms_norm(h[..., OFF_CKV:OFF_KROPE], kv_norm)
    kv = (c_kv @ w_kv_b).reshape(b, s, MLA_HEADS, MLA_NOPE_DIM + MLA_V_DIM)
    k_rope = apply_rope(h[..., OFF_KROPE:OFF_DQ].reshape(b, s, 1, MLA_ROPE_DIM), cos64, sin64)
    k = jnp.concatenate([kv[..., :MLA_NOPE_DIM],
                         jnp.broadcast_to(k_rope, (b, s, MLA_HEADS, MLA_ROPE_DIM))], axis=-1)
    v = kv[..., MLA_NOPE_DIM:]
    o_mla = causal_block_attention(q, k, v, MLA_QK_DIM ** -0.5)
    dq = apply_rope(h[..., OFF_DQ:OFF_DK].reshape(b, s, DIL_GROUPS * DIL_HEADS, HEAD_DIM), cos128, sin128)
    dq = dq.reshape(b, s, DIL_GROUPS, DIL_HEADS, HEAD_DIM)
    dk = apply_rope(h[..., OFF_DK:OFF_DV].reshape(b, s, DIL_HEADS, HEAD_DIM), cos128, sin128)
    dv = h[..., OFF_DV:W_IN_COLS].reshape(b, s, DIL_HEADS, HEAD_DIM)
    outs, lses = [], []
    for g, (window, dilation) in enumerate(DIL_PATTERNS):
        o_g, lse_g = dilated_group_attention(dq[:, :, g], dk, dv, window, dilation, HEAD_DIM ** -0.5)
        outs.append(o_g)
        lses.append(lse_g)
    wts = jax.nn.softmax(jnp.stack(lses, axis=0), axis=0)
    o_dil = jnp.sum(wts[..., None] * jnp.stack(outs, axis=0).astype(F32), axis=0).astype(x.dtype)
    mixed = jnp.concatenate([o_mla.reshape(b, s, MLA_HEADS * MLA_V_DIM),
                             o_dil.reshape(b, s, DIL_HEADS * HEAD_DIM)], axis=-1)
    return mixed @ w_out


def forgetting_attention_mixer(x, w_qkv, w_f, b_f, w_out):
    b, s, _ = x.shape
    qkv = (x @ w_qkv).reshape(b, s, 3, FOX_HEADS, HEAD_DIM)
    log_f = jax.nn.log_sigmoid((x @ w_f + b_f).astype(F32))
    c = jnp.cumsum(log_f, axis=1)
    o = causal_block_attention(qkv[:, :, 0], qkv[:, :, 1], qkv[:, :, 2], HEAD_DIM ** -0.5, c)
    return o.reshape(b, s, FOX_WIDTH) @ w_out


def swiglu(x, w_gate, w_up, w_down):
    return (jax.nn.silu(x @ w_gate) * (x @ w_up)) @ w_down


def top2_moe(x, router_w, router_b, w_gate, w_up, w_down):
    logits = (x @ router_w + router_b).astype(F32)
    top_logits, top_idx = lax.top_k(logits, TOP_K)
    top_w = jax.nn.softmax(top_logits, axis=-1)
    gate = jnp.sum(jax.nn.one_hot(top_idx, N_EXPERTS, dtype=F32) * top_w[..., None], axis=-2).astype(x.dtype)
    out = jnp.zeros_like(x)
    for e in range(N_EXPERTS):
        out = out + gate[..., e:e + 1] * swiglu(x, w_gate[e], w_up[e], w_down[e])
    return out


def setup_inputs(seed: int = 0) -> dict:
    key = jax.random.key(seed)
    ks = jax.random.split(key, 32)

    def w(k, shape, fan_in, scale=1.0):
        return jax.random.normal(k, shape, F32) * (scale * fan_in ** -0.5)

    def gain(k, shape):
        return 1.0 + 0.02 * jax.random.normal(k, shape, F32)

    def bias(k, shape, scale=0.02):
        return scale * jax.random.normal(k, shape, F32)

    ne, no = N_EVEN_LAYERS, N_ODD_LAYERS
    in_col_scale = jnp.ones((W_IN_COLS,), F32).at[OFF_DV:].set(BETA)
    kv_b_col_scale = jnp.tile(jnp.concatenate([jnp.ones((MLA_NOPE_DIM,), F32),
                                               jnp.full((MLA_V_DIM,), BETA, F32)]), MLA_HEADS)
    qkv_col_scale = jnp.ones((3 * FOX_WIDTH,), F32).at[2 * FOX_WIDTH:].set(BETA)
    return {
        "x": jax.random.normal(ks[0], (BATCH, SEQ, D_MODEL), F32),
        "ev_w_in": w(ks[1], (ne, D_MODEL, W_IN_COLS), D_MODEL) * in_col_scale,
        "ev_q_norm": gain(ks[2], (ne, MLA_Q_RANK)),
        "ev_w_q_b": w(ks[3], (ne, MLA_Q_RANK, MLA_HEADS * MLA_QK_DIM), MLA_Q_RANK),
        "ev_kv_norm": gain(ks[4], (ne, MLA_KV_RANK)),
        "ev_w_kv_b": w(ks[5], (ne, MLA_KV_RANK, MLA_HEADS * (MLA_NOPE_DIM + MLA_V_DIM)), MLA_KV_RANK) * kv_b_col_scale,
        "ev_w_out": w(ks[6], (ne, MIX_WIDTH, D_MODEL), MIX_WIDTH, BETA),
        "ev_ln1_g": gain(ks[7], (ne, D_MODEL)),
        "ev_ln1_b": bias(ks[8], (ne, D_MODEL)),
        "ev_ffn_w_gate": w(ks[9], (ne, D_MODEL, D_FF), D_MODEL),
        "ev_ffn_w_up": w(ks[10], (ne, D_MODEL, D_FF), D_MODEL, BETA),
        "ev_ffn_w_down": w(ks[11], (ne, D_FF, D_MODEL), D_FF, BETA),
        "ev_ln2_g": gain(ks[12], (ne, D_MODEL)),
        "ev_ln2_b": bias(ks[13], (ne, D_MODEL)),
        "od_w_qkv": w(ks[14], (no, D_MODEL, 3 * FOX_WIDTH), D_MODEL) * qkv_col_scale,
        "od_w_f": w(ks[15], (no, D_MODEL, FOX_HEADS), D_MODEL),
        "od_b_f": bias(ks[16], (no, FOX_HEADS), 0.1),
        "od_w_out": w(ks[17], (no, FOX_WIDTH, D_MODEL), FOX_WIDTH, BETA),
        "od_ln1_g": gain(ks[18], (no, D_MODEL)),
        "od_ln1_b": bias(ks[19], (no, D_MODEL)),
        "od_router_w": w(ks[20], (no, D_MODEL, N_EXPERTS), D_MODEL),
        "od_router_b": bias(ks[21], (no, N_EXPERTS), 0.01),
        "od_exp_w_gate": w(ks[22], (no, N_EXPERTS, D_MODEL, D_FF), D_MODEL),
        "od_exp_w_up": w(ks[23], (no, N_EXPERTS, D_MODEL, D_FF), D_MODEL, BETA),
        "od_exp_w_down": w(ks[24], (no, N_EXPERTS, D_FF, D_MODEL), D_FF, BETA),
        "od_ln2_g": gain(ks[25], (no, D_MODEL)),
        "od_ln2_b": bias(ks[26], (no, D_MODEL)),
    }


def reference(x, ev_w_in, ev_q_norm, ev_w_q_b, ev_kv_norm, ev_w_kv_b, ev_w_out, ev_ln1_g, ev_ln1_b,
              ev_ffn_w_gate, ev_ffn_w_up, ev_ffn_w_down, ev_ln2_g, ev_ln2_b,
              od_w_qkv, od_w_f, od_b_f, od_w_out, od_ln1_g, od_ln1_b,
              od_router_w, od_router_b, od_exp_w_gate, od_exp_w_up, od_exp_w_down, od_ln2_g, od_ln2_b):
    seq = x.shape[1]
    cos64, sin64 = rope_tables(seq, MLA_ROPE_DIM)
    cos128, sin128 = rope_tables(seq, HEAD_DIM)
    for layer in range(DEPTH):
        i = layer // 2
        if layer % 2 == 0:
            mix = mla_dilated_mixer(x, ev_w_in[i], ev_q_norm[i], ev_w_q_b[i], ev_kv_norm[i], ev_w_kv_b[i],
                                    ev_w_out[i], cos64, sin64, cos128, sin128)
            x = layer_norm(ALPHA * x + mix, ev_ln1_g[i], ev_ln1_b[i])
            ffn = swiglu(x, ev_ffn_w_gate[i], ev_ffn_w_up[i], ev_ffn_w_down[i])
            x = layer_norm(ALPHA * x + ffn, ev_ln2_g[i], ev_ln2_b[i])
        else:
            mix = forgetting_attention_mixer(x, od_w_qkv[i], od_w_f[i], od_b_f[i], od_w_out[i])
            x = layer_norm(ALPHA * x + mix, od_ln1_g[i], od_ln1_b[i])
            ffn = top2_moe(x, od_router_w[i], od_router_b[i], od_exp_w_gate[i], od_exp_w_up[i], od_exp_w_down[i])
            x = layer_norm(ALPHA * x + ffn, od_ln2_g[i], od_ln2_b[i])
    return x
```

```cpp
#include <hip/hip_runtime.h>
#include <cstdio>
#include <cstdint>
namespace pg8 {
#define PG8_LAS __attribute__((address_space(3)))
typedef unsigned short bf16_t;
typedef short bf16x8 __attribute__((ext_vector_type(8)));
typedef float f32x4 __attribute__((ext_vector_type(4)));
typedef unsigned u32x4 __attribute__((ext_vector_type(4)));
constexpr int BM = 256, BK = 64, HALF = 128, HTB = HALF * BK * 2  , STAGE_BYTES = 8 * HTB, NXCD = 8, WGM = 8;

__host__ __device__ __forceinline__ int lds_byte(int r, int c) { const int st = (r >> 4) * 2 + (c >> 5), rr = r & 15, cc = c & 31, ob = rr * 64 + cc * 2; return st * 1024 + (ob ^ (((ob >> 9) & 1) << 5)); }
__host__ __device__ __forceinline__ void stage_rc(int b, int& R, int& C) { const int st = b / 1024, sb = b % 1024, swz = sb ^ (((sb >> 9) & 1) << 5); R = (st >> 1) * 16 + swz / 64; C = (st & 1) * 32 + (swz % 64) / 2; }
__host__ __device__ __forceinline__ int perm32(int rho) { const int n = rho >> 4, i = rho & 15; return 8 * (i >> 2) + 4 * n + (i & 3); }

struct Unit { int pm, pn, kh; };
struct Gemm { const bf16_t* A; const bf16_t* Bt; int M, N, K; int Kl = 0; };

struct StaticOrder {
    int nM, nN, nwg, G, c;
    __host__ __device__ void init(int M, int N, int G_, int c_) { nM = M / BM; nN = N / BM; nwg = nM * nN; G = G_; c = c_; }
    __host__ __device__ bool next(int i, Unit& u) const {
        const long L = (long)i * G + c; if (L >= nwg) return false;
        int wgid = (int)L; { const int q = nwg / NXCD, r = nwg % NXCD, xcd = wgid % NXCD, off = wgid / NXCD; wgid = (xcd < r ? xcd * (q + 1) : r * (q + 1) + (xcd - r) * q) + off; }
        const int nig = WGM * nN, gid = wgid / nig, fm = gid * WGM, gsz = (nM - fm) < WGM ? (nM - fm) : WGM;
        u.pm = fm + ((wgid % nig) % gsz); u.pn = (wgid % nig) / gsz; u.kh = 0; return true;
    }
    __device__ __forceinline__ const char* bbase(const Gemm& g, const Unit&) const { return (const char*)g.Bt; }
    __device__ __forceinline__ size_t aoff(const Unit&) const { return 0; }
    __device__ __forceinline__ void a_ready(const Unit&) const {}
    __device__ __forceinline__ void done(const Unit&) const {}
};

__device__ __forceinline__ unsigned cvt_pk_bf16(float lo, float hi) { unsigned r; asm volatile("v_cvt_pk_bf16_f32 %0, %1, %2" : "=v"(r) : "v"(lo), "v"(hi)); return r; }
__device__ __forceinline__ u32x4 pack8(f32x4 a, f32x4 b) { u32x4 w; w.x = cvt_pk_bf16(a[0], a[1]); w.y = cvt_pk_bf16(a[2], a[3]); w.z = cvt_pk_bf16(b[0], b[1]); w.w = cvt_pk_bf16(b[2], b[3]); return w; }
__device__ __forceinline__ float sq4(f32x4 v) { return (v[0] * v[0] + v[1] * v[1]) + (v[2] * v[2] + v[3] * v[3]); }
typedef int i32x8 __attribute__((ext_vector_type(8)));
typedef int i32x4 __attribute__((ext_vector_type(4)));
typedef float f32x2 __attribute__((ext_vector_type(2)));
__device__ __forceinline__ i32x8 cat8(bf16x8 lo, bf16x8 hi) { const i32x4 a = __builtin_bit_cast(i32x4, lo), b = __builtin_bit_cast(i32x4, hi); return __builtin_shufflevector(a, b, 0, 1, 2, 3, 4, 5, 6, 7); }
__device__ __forceinline__ void mfma8(f32x4& c, const i32x8 a, const i32x8 b) { asm volatile("v_mfma_f32_16x16x128_f8f6f4 %0, %1, %2, %0" : "+v"(c) : "v"(a), "v"(b)); }
constexpr float ALPHA_RES = 1.41421356237309515f;

struct MoeOrder {
    StaticOrder so; int t0; const int* texp; size_t estride;
    __device__ __forceinline__ void init(int ntiles, int N, int G_, int c_, int t0_, const int* texp_, size_t estride_) { so.init(ntiles * BM, N, G_, c_); t0 = t0_; texp = texp_; estride = estride_; }
    __device__ __forceinline__ bool next(int i, Unit& u) const { if (!so.next(i, u)) return false; u.pm += t0; return true; }
    __device__ __forceinline__ const char* bbase(const Gemm& g, const Unit& u) const {
        const int e = __builtin_amdgcn_readfirstlane(__hip_atomic_load(texp + u.pm, __ATOMIC_RELAXED, __HIP_MEMORY_SCOPE_AGENT));
        return (const char*)g.Bt + (size_t)e * estride; }
    __device__ __forceinline__ size_t aoff(const Unit&) const { return 0; }
    __device__ __forceinline__ void a_ready(const Unit&) const {}
    __device__ __forceinline__ void done(const Unit&) const {}
};
struct TailOrder {
    int t0, nrt, G, c; const int* texp; size_t estride, khbytes;
    __device__ __forceinline__ bool next(int i, Unit& u) const { const int L = i * G + c; if (L >= nrt * 16) return false; u.kh = L & 1; u.pn = (L >> 1) & 7; u.pm = t0 + (L >> 4); return true; }
    __device__ __forceinline__ const char* bbase(const Gemm& g, const Unit& u) const {
        const int e = __builtin_amdgcn_readfirstlane(__hip_atomic_load(texp + u.pm, __ATOMIC_RELAXED, __HIP_MEMORY_SCOPE_AGENT));
        return (const char*)g.Bt + (size_t)e * estride + (size_t)u.kh * khbytes; }
    __device__ __forceinline__ size_t aoff(const Unit& u) const { return (size_t)u.kh * khbytes; }
    __device__ __forceinline__ void a_ready(const Unit&) const {}
    __device__ __forceinline__ void done(const Unit&) const {}
};

struct EpiIn {
    static constexpr bool PERM = true, AFTER_DRAIN = false;
    bf16_t *DQ, *DK, *DV, *CQ, *CKV, *KR; float* SSQ; const float *cos128, *sin128, *cos64, *sin64;
    __device__ __forceinline__ void rope_tile(const f32x4 (&acc)[2][2][4][2], bf16_t* base, int pitch, int head, int i0, int row0) const {
        f32x4 c0[2], c1[2], s0[2], s1[2];
#define EPIIN_LOAD(k) _Pragma("unroll") for (int q = 0; q < 2; ++q) { const int it = 2 * (k) + q, pos = (row0 + (it >> 2) * HALF + (it & 3) * 16) & 8191; \
            c0[q] = *(const f32x4*)(cos128 + pos * 64 + i0); c1[q] = *(const f32x4*)(cos128 + pos * 64 + i0 + 4); s0[q] = *(const f32x4*)(sin128 + pos * 64 + i0); s1[q] = *(const f32x4*)(sin128 + pos * 64 + i0 + 4); }
        EPIIN_LOAD(0)
#pragma unroll
        for (int k = 0; k < 4; ++k) {
            u32x4 w0[2], w1[2];
#pragma unroll
            for (int q = 0; q < 2; ++q) { const int it = 2 * k + q, ai = it >> 2, m = it & 3;
                const f32x4 a0 = acc[ai][0][m][0], a1 = acc[ai][0][m][1], b0 = acc[ai][1][m][0], b1 = acc[ai][1][m][1];
                w0[q] = pack8(a0 * c0[q] - b0 * s0[q], a1 * c1[q] - b1 * s1[q]); w1[q] = pack8(b0 * c0[q] + a0 * s0[q], b1 * c1[q] + a1 * s1[q]); }
            if (k < 3) { EPIIN_LOAD(k + 1) }
#pragma unroll
            for (int q = 0; q < 2; ++q) { const int it = 2 * k + q, row = row0 + (it >> 2) * HALF + (it & 3) * 16;
                bf16_t* p = base + (size_t)row * pitch + head * 128 + i0; *(u32x4*)p = w0[q]; *(u32x4*)(p + 64) = w1[q]; }
        }
#undef EPIIN_LOAD
    }
    __device__ __forceinline__ void operator()(const f32x4 (&acc)[2][2][4][2], const Unit& u, int wr, int wc, int fr, int fq) const {
        const int t = u.pn, row0 = u.pm * BM + wr * 64 + fr;
        if (t < 12) {
            bf16_t* base; int pitch, head0;
            if (t < 9) { base = DQ; pitch = 2304; head0 = 2 * t; } else { base = DK; pitch = 768; head0 = 2 * (t - 9); }
            const int ch = wc * 32 + 8 * fq, head = head0 + (ch >> 6), i0 = ch & 63;
            rope_tile(acc, base, pitch, head, i0, row0);
        } else if (t < 15) {
#pragma unroll
            for (int ai = 0; ai < 2; ++ai)
#pragma unroll
                for (int m = 0; m < 4; ++m) {
                    const int row = row0 + ai * HALF + m * 16;
#pragma unroll
                    for (int bj = 0; bj < 2; ++bj) *(u32x4*)(DV + (size_t)row * 768 + (t - 12) * 256 + bj * HALF + wc * 32 + 8 * fq) = pack8(acc[ai][bj][m][0], acc[ai][bj][m][1]);
                }
        } else if (t < 17) {
#pragma unroll
            for (int ai = 0; ai < 2; ++ai)
#pragma unroll
                for (int m = 0; m < 4; ++m) {
                    const int row = row0 + ai * HALF + m * 16; float s = 0.f;
#pragma unroll
                    for (int bj = 0; bj < 2; ++bj) { *(u32x4*)(CQ + (size_t)row * 512 + (t - 15) * 256 + bj * HALF + wc * 32 + 8 * fq) = pack8(acc[ai][bj][m][0], acc[ai][bj][m][1]);
                        s += sq4(acc[ai][bj][m][0]) + sq4(acc[ai][bj][m][1]); }
                    s += __shfl_xor(s, 16); s += __shfl_xor(s, 32);
                    if (fq == 0) SSQ[(size_t)row * 12 + (t - 15) * 4 + wc] = s;
                }
        } else {
#pragma unroll
            for (int ai = 0; ai < 2; ++ai)
#pragma unroll
                for (int m = 0; m < 4; ++m) {
                    const int row = row0 + ai * HALF + m * 16, pos = row & 8191;
                    if (wc < 2) {
                        float s = 0.f;
#pragma unroll
                        for (int bj = 0; bj < 2; ++bj) { *(u32x4*)(CKV + (size_t)row * 256 + bj * 64 + wc * 32 + 8 * fq) = pack8(acc[ai][bj][m][0], acc[ai][bj][m][1]);
                            s += sq4(acc[ai][bj][m][0]) + sq4(acc[ai][bj][m][1]); }
                        s += __shfl_xor(s, 16); s += __shfl_xor(s, 32);
                        if (fq == 0) SSQ[(size_t)row * 12 + 8 + wc] = s;
                    } else {
                        const u32x4 z = {0u, 0u, 0u, 0u};
#pragma unroll
                        for (int bj = 0; bj < 2; ++bj) *(u32x4*)(CKV + (size_t)row * 256 + 128 + (wc - 2) * 64 + bj * 32 + 8 * fq) = z;
                        if (wc == 2) {
                            const int i0 = 8 * fq;
                            const f32x4 c0 = *(const f32x4*)(cos64 + pos * 32 + i0), c1 = *(const f32x4*)(cos64 + pos * 32 + i0 + 4);
                            const f32x4 s0 = *(const f32x4*)(sin64 + pos * 32 + i0), s1 = *(const f32x4*)(sin64 + pos * 32 + i0 + 4);
                            const f32x4 a0 = acc[ai][0][m][0], a1 = acc[ai][0][m][1], b0 = acc[ai][1][m][0], b1 = acc[ai][1][m][1];
                            bf16_t* p = KR + (size_t)row * 64 + i0;
                            *(u32x4*)p = pack8(a0 * c0 - b0 * s0, a1 * c1 - b1 * s1);
                            *(u32x4*)(p + 32) = pack8(b0 * c0 + a0 * s0, b1 * c1 + a1 * s1);
                        }
                    }
                }
        }
    }
};

struct EpiQb {
    static constexpr bool PERM = true, AFTER_DRAIN = false;
    bf16_t *QN, *QR; const float* SSQ; const float *cos64, *sin64;
    __device__ __forceinline__ void rope_tile(const f32x4 (&acc)[2][2][4][2], const float (&rs)[8], int head, int i0, int row0) const {
        f32x4 c0[2], c1[2], s0[2], s1[2];
#define EPIQB_LOAD(k) _Pragma("unroll") for (int q = 0; q < 2; ++q) { const int it = 2 * (k) + q, pos = (row0 + (it >> 2) * HALF + (it & 3) * 16) & 8191; \
            c0[q] = *(const f32x4*)(cos64 + pos * 32 + i0); c1[q] = *(const f32x4*)(cos64 + pos * 32 + i0 + 4); s0[q] = *(const f32x4*)(sin64 + pos * 32 + i0); s1[q] = *(const f32x4*)(sin64 + pos * 32 + i0 + 4); }
        EPIQB_LOAD(0)
#pragma unroll
        for (int k = 0; k < 4; ++k) {
            u32x4 w0[2], w1[2];
#pragma unroll
            for (int q = 0; q < 2; ++q) { const int it = 2 * k + q, ai = it >> 2, m = it & 3; const float r = rs[it];
                const f32x4 a0 = acc[ai][0][m][0] * r, a1 = acc[ai][0][m][1] * r, b0 = acc[ai][1][m][0] * r, b1 = acc[ai][1][m][1] * r;
                w0[q] = pack8(a0 * c0[q] - b0 * s0[q], a1 * c1[q] - b1 * s1[q]); w1[q] = pack8(b0 * c0[q] + a0 * s0[q], b1 * c1[q] + a1 * s1[q]); }
            if (k < 3) { EPIQB_LOAD(k + 1) }
#pragma unroll
            for (int q = 0; q < 2; ++q) { const int it = 2 * k + q, row = row0 + (it >> 2) * HALF + (it & 3) * 16;
                bf16_t* p = QR + (size_t)row * 640 + head * 64 + i0; *(u32x4*)p = w0[q]; *(u32x4*)(p + 32) = w1[q]; }
        }
#undef EPIQB_LOAD
    }
    __device__ __forceinline__ void operator()(const f32x4 (&acc)[2][2][4][2], const Unit& u, int wr, int wc, int fr, int fq) const {
        const int t = u.pn, row0 = u.pm * BM + wr * 64 + fr;
        float rs[8];
#pragma unroll
        for (int h = 0; h < 2; ++h) { f32x4 q0[4], q1[4];
#pragma unroll
            for (int m = 0; m < 4; ++m) { const int row = row0 + h * HALF + m * 16; q0[m] = *(const f32x4*)(SSQ + (size_t)row * 12); q1[m] = *(const f32x4*)(SSQ + (size_t)row * 12 + 4); }
#pragma unroll
            for (int m = 0; m < 4; ++m) { const f32x4 a = q0[m], b = q1[m]; rs[h * 4 + m] = 1.0f / sqrtf((((a[0] + a[1]) + (a[2] + a[3])) + ((b[0] + b[1]) + (b[2] + b[3]))) * (1.0f / 448.0f) + 1e-6f); } }
        if (t < 5) {
#pragma unroll
            for (int ai = 0; ai < 2; ++ai)
#pragma unroll
                for (int m = 0; m < 4; ++m) { const int row = row0 + ai * HALF + m * 16; const float r = rs[ai * 4 + m];
#pragma unroll
                    for (int bj = 0; bj < 2; ++bj) *(u32x4*)(QN + (size_t)row * 1280 + t * 256 + bj * HALF + wc * 32 + 8 * fq) = pack8(acc[ai][bj][m][0] * r, acc[ai][bj][m][1] * r); }
        } else {
            const int head = 4 * (t - 5) + wc, i0 = 8 * fq;
            if (head < 10) rope_tile(acc, rs, head, i0, row0);
        }
    }
};

struct EpiKvb {
    static constexpr bool PERM = true, AFTER_DRAIN = false;
    bf16_t *KN, *VV; const float* SSQ;
    __device__ __forceinline__ void operator()(const f32x4 (&acc)[2][2][4][2], const Unit& u, int wr, int wc, int fr, int fq) const {
        const int t = u.pn, row0 = u.pm * BM + wr * 64 + fr;
#pragma unroll
        for (int ai = 0; ai < 2; ++ai)
#pragma unroll
            for (int m = 0; m < 4; ++m) {
                const int row = row0 + ai * HALF + m * 16;
                const float rs = 1.0f / sqrtf((SSQ[(size_t)row * 12 + 8] + SSQ[(size_t)row * 12 + 9]) * (1.0f / 128.0f) + 1e-6f);
                *(u32x4*)(KN + (size_t)row * 1280 + t * 128 + wc * 32 + 8 * fq) = pack8(acc[ai][0][m][0] * rs, acc[ai][0][m][1] * rs);
                *(u32x4*)(VV + (size_t)row * 1280 + t * 128 + wc * 32 + 8 * fq) = pack8(acc[ai][1][m][0] * rs, acc[ai][1][m][1] * rs);
            }
    }
};

struct EpiRes {
    static constexpr bool PERM = true, AFTER_DRAIN = false;
    const float* res; float* out; float s;
    const float* st; const float* g; const float* b;
    __device__ __forceinline__ void operator()(const f32x4 (&acc)[2][2][4][2], const Unit& u, int wr, int wc, int fr, int fq) const {
        const int row0 = u.pm * BM + wr * 64 + fr, col0 = u.pn * BM + wc * 32 + 8 * fq;
        if (st) {
#pragma unroll
            for (int bj = 0; bj < 2; ++bj) {
                const int cc = col0 + bj * HALF;
                const f32x4 g0 = *(const f32x4*)(g + cc), g1 = *(const f32x4*)(g + cc + 4), b0 = *(const f32x4*)(b + cc), b1 = *(const f32x4*)(b + cc + 4);
#pragma unroll
                for (int ai = 0; ai < 2; ++ai) {
                    f32x4 r0[4], r1[4]; f32x2 ms[4];
#pragma unroll
                    for (int m = 0; m < 4; ++m) { const size_t p = (size_t)(row0 + ai * HALF + m * 16) * 2048 + cc; r0[m] = *(const f32x4*)(res + p); r1[m] = *(const f32x4*)(res + p + 4); }
#pragma unroll
                    for (int m = 0; m < 4; ++m) ms[m] = *(const f32x2*)(st + 2 * (row0 + ai * HALF + m * 16));
#pragma unroll
                    for (int m = 0; m < 4; ++m) {
                        const size_t p = (size_t)(row0 + ai * HALF + m * 16) * 2048 + cc; const float mu = ms[m][0], rr = ms[m][1];
                        const f32x4 x0 = (r0[m] - mu) * rr * g0 + b0, x1 = (r1[m] - mu) * rr * g1 + b1;
                        *(f32x4*)(out + p) = x0 * ALPHA_RES + acc[ai][bj][m][0] * s; *(f32x4*)(out + p + 4) = x1 * ALPHA_RES + acc[ai][bj][m][1] * s;
                    }
                }
            }
        } else {
            f32x4 r0[4], r1[4];
#define EPIRES_LOAD(k) { const int cc = col0 + ((k) >> 1) * HALF, rb = row0 + ((k) & 1) * HALF; \
                _Pragma("unroll") for (int m = 0; m < 4; ++m) { const size_t p = (size_t)(rb + m * 16) * 2048 + cc; r0[m] = *(const f32x4*)(res + p); r1[m] = *(const f32x4*)(res + p + 4); } }
            EPIRES_LOAD(0)
#pragma unroll
            for (int k = 0; k < 4; ++k) {
                const int bj = k >> 1, ai = k & 1, cc = col0 + bj * HALF, rb = row0 + ai * HALF;
                f32x4 o0[4], o1[4];
#pragma unroll
                for (int m = 0; m < 4; ++m) { o0[m] = r0[m] * ALPHA_RES + acc[ai][bj][m][0] * s; o1[m] = r1[m] * ALPHA_RES + acc[ai][bj][m][1] * s; }
                if (k < 3) EPIRES_LOAD(k + 1)
#pragma unroll
                for (int m = 0; m < 4; ++m) { const size_t p = (size_t)(rb + m * 16) * 2048 + cc; *(f32x4*)(out + p) = o0[m]; *(f32x4*)(out + p + 4) = o1[m]; }
            }
#undef EPIRES_LOAD
        }
    }
};

struct EpiSwiglu {
    static constexpr bool PERM = true, AFTER_DRAIN = false;
    bf16_t* O; int ldc; int row_off; float s;
    __device__ __forceinline__ f32x4 sw(f32x4 g, f32x4 uu) const { f32x4 r;
#pragma unroll
        for (int j = 0; j < 4; ++j) { const float gg = g[j] * s; r[j] = gg * __builtin_amdgcn_rcpf(1.0f + __builtin_amdgcn_exp2f(-1.4426950408889634f * gg)) * (uu[j] * s); }
        return r; }
    __device__ __forceinline__ void operator()(const f32x4 (&acc)[2][2][4][2], const Unit& u, int wr, int wc, int fr, int fq) const {
        const int row0 = u.pm * BM + wr * 64 + fr - row_off, col0 = u.pn * HALF + wc * 32 + 8 * fq;
#pragma unroll
        for (int ai = 0; ai < 2; ++ai)
#pragma unroll
            for (int m = 0; m < 4; ++m)
                *(u32x4*)(O + (size_t)(row0 + ai * HALF + m * 16) * ldc + col0) = pack8(sw(acc[ai][0][m][0], acc[ai][1][m][0]), sw(acc[ai][0][m][1], acc[ai][1][m][1]));
    }
};

struct EpiPlain {
    static constexpr bool PERM = true, AFTER_DRAIN = false;
    bf16_t* O; int ldc; int split_cols; size_t split_stride; float s;
    unsigned* maxp;
    __device__ __forceinline__ void operator()(const f32x4 (&acc)[2][2][4][2], const Unit& u, int wr, int wc, int fr, int fq) const {
        const int row0 = u.pm * BM + wr * 64 + fr; int colt = u.pn * BM; bf16_t* base = O;
        if (split_cols) { const int t = colt / split_cols; base += (size_t)t * split_stride; colt -= t * split_cols; }
        const int col0 = colt + wc * 32 + 8 * fq;
        float mx0 = 0.f, mx1 = 0.f; unsigned* const mp = maxp; const bool domax = (mp != nullptr) && split_cols != 0 && (u.pn * BM) < 2 * split_cols;
#pragma unroll
        for (int ai = 0; ai < 2; ++ai)
#pragma unroll
            for (int m = 0; m < 4; ++m) {
                { const f32x4 a = acc[ai][0][m][0] * s, b = acc[ai][0][m][1] * s;
                  *(u32x4*)(base + (size_t)(row0 + ai * HALF + m * 16) * ldc + col0) = pack8(a, b);
                  if (domax) { float q = sq4(a) + sq4(b); q += __shfl_xor(q, 16); q += __shfl_xor(q, 32); mx0 = fmaxf(mx0, q); } }
                { const f32x4 a = acc[ai][1][m][0] * s, b = acc[ai][1][m][1] * s;
                  *(u32x4*)(base + (size_t)(row0 + ai * HALF + m * 16) * ldc + col0 + HALF) = pack8(a, b);
                  if (domax) { float q = sq4(a) + sq4(b); q += __shfl_xor(q, 16); q += __shfl_xor(q, 32); mx1 = fmaxf(mx1, q); } }
            }
        if (domax) {
            const int t = (u.pn * BM) / split_cols;
#pragma unroll
            for (int o = 1; o < 16; o <<= 1) { mx0 = fmaxf(mx0, __shfl_xor(mx0, o)); mx1 = fmaxf(mx1, __shfl_xor(mx1, o)); }
            if (fr == 0 && fq == 0) { unsigned* d = mp + (t * 2 + (u.pm * BM) / 8192) * 16 + (colt / 128);
                atomicMax(d, __float_as_uint(mx0)); atomicMax(d + 1, __float_as_uint(mx1)); }
        }
    }
};

constexpr float W8_SCALE = 64.f, H8_SCALE = 16.f;
__device__ __forceinline__ unsigned pk4_fp8(float a, float b, float c, float d) { int p = __builtin_amdgcn_cvt_pk_fp8_f32(a, b, 0, false); p = __builtin_amdgcn_cvt_pk_fp8_f32(c, d, p, true); return (unsigned)p; }
struct EpiSwiglu8 {
    static constexpr bool PERM = true, AFTER_DRAIN = false;
    unsigned char* O; int ldc;
    __device__ __forceinline__ f32x4 sw(f32x4 g, f32x4 uu) const { f32x4 r;
#pragma unroll
        for (int j = 0; j < 4; ++j) { const float gg = g[j] * (1.f / W8_SCALE); r[j] = gg * __builtin_amdgcn_rcpf(1.0f + __builtin_amdgcn_exp2f(-1.4426950408889634f * gg)) * (uu[j] * (H8_SCALE / W8_SCALE)); }
        return r; }
    __device__ __forceinline__ void operator()(const f32x4 (&acc)[2][2][4][2], const Unit& u, int wr, int wc, int fr, int fq) const {
        const int row0 = u.pm * BM + wr * 64 + fr, col0 = u.pn * HALF + wc * 32 + 8 * fq;
#pragma unroll
        for (int ai = 0; ai < 2; ++ai)
#pragma unroll
            for (int m = 0; m < 4; ++m) { const f32x4 a = sw(acc[ai][0][m][0], acc[ai][1][m][0]), b = sw(acc[ai][0][m][1], acc[ai][1][m][1]);
                typedef unsigned u32x2 __attribute__((ext_vector_type(2)));
                u32x2 w; w.x = pk4_fp8(a[0], a[1], a[2], a[3]); w.y = pk4_fp8(b[0], b[1], b[2], b[3]);
                *(u32x2*)(O + (size_t)(row0 + ai * HALF + m * 16) * ldc + col0) = w; }
    }
};
struct EpiPlainS {
    static constexpr bool PERM = true, AFTER_DRAIN = false;
    bf16_t* O; int ldc; float s; bf16_t* O2; int row2;
    __device__ __forceinline__ void operator()(const f32x4 (&acc)[2][2][4][2], const Unit& u, int wr, int wc, int fr, int fq) const {
        const int row0 = u.pm * BM + wr * 64 + fr - (u.kh ? row2 : 0), col0 = u.pn * BM + wc * 32 + 8 * fq; bf16_t* const O = u.kh ? this->O2 : this->O;
#pragma unroll
        for (int ai = 0; ai < 2; ++ai)
#pragma unroll
            for (int m = 0; m < 4; ++m)
#pragma unroll
                for (int bj = 0; bj < 2; ++bj) *(u32x4*)(O + (size_t)(row0 + ai * HALF + m * 16) * ldc + col0 + bj * HALF) = pack8(acc[ai][bj][m][0] * s, acc[ai][bj][m][1] * s);
    }
};
template <class Epi, class Sched, bool ALIGN_EPI = false, bool SP2 = false, bool F8 = false>
__device__ __forceinline__ void gemm_phase(PG8_LAS unsigned char* lds, const Gemm g, const Sched& S, const Epi& E) {
    const int tid = threadIdx.x, wid = __builtin_amdgcn_readfirstlane(tid >> 6), lane = tid & 63, wr = wid >> 2, wc = wid & 3, fr = lane & 15, fq = lane >> 4;
    const int K = g.K, nt = (g.Kl ? g.Kl : K) / BK;
    unsigned voffA[2], voffB[2];
#pragma unroll
    for (int i = 0; i < 2; ++i) { int R, C; stage_rc(tid * 16 + i * 8192, R, C); const int Rb = Epi::PERM ? ((R & ~31) + perm32(R & 31)) : R;
        voffA[i] = (unsigned)(R * K + C) * 2u; voffB[i] = (unsigned)(Rb * K + C) * 2u; }
    const size_t kstep = (size_t)(BK * 2);
    const size_t hstep = (size_t)HALF * K * 2;
    const size_t tstep = 2 * hstep;
    const unsigned ldsw = (unsigned)wid * 1024u;
    const int aoff = lds_byte(wr * 64 + fr, fq * 8), boff = lds_byte(wc * 32 + fr, fq * 8);
#define PG8_SA(b, h) (((b) * 2 + (h)) * HTB)
#define PG8_SB(b, h) ((4 + (b) * 2 + (h)) * HTB)
#define PG8_STAGE(bufoff, gbase, voff) do { _Pragma("unroll") for (int _i = 0; _i < 2; ++_i) \
        __builtin_amdgcn_global_load_lds((const unsigned*)((const char*)(gbase) + (voff)[_i]), (PG8_LAS unsigned*)(lds + (bufoff) + ldsw + _i * 8192), 16, 0, 0); } while (0)
#define PG8_LDA(dst, b, h) do { _Pragma("unroll") for (int m = 0; m < 4; ++m) _Pragma("unroll") for (int k = 0; k < 2; ++k) dst[m][k] = *(const PG8_LAS bf16x8*)(lds + PG8_SA(b, h) + aoff + m * 2048 + k * 1024); } while (0)
#define PG8_LDB(dst, b, h) do { _Pragma("unroll") for (int n = 0; n < 2; ++n) _Pragma("unroll") for (int k = 0; k < 2; ++k) dst[n][k] = *(const PG8_LAS bf16x8*)(lds + PG8_SB(b, h) + boff + n * 2048 + k * 1024); } while (0)
#define PG8_MMA(ai, bj, At, Bt) do { __builtin_amdgcn_s_setprio(1); if constexpr (F8) { _Pragma("unroll") for (int m = 0; m < 4; ++m) _Pragma("unroll") for (int n = 0; n < 2; ++n) \
        mfma8(acc[ai][bj][m][n], cat8(Bt[n][0], Bt[n][1]), cat8(At[m][0], At[m][1])); } else { \
        _Pragma("unroll") for (int m = 0; m < 4; ++m) _Pragma("unroll") for (int n = 0; n < 2; ++n) _Pragma("unroll") for (int k = 0; k < 2; ++k) \
        acc[ai][bj][m][n] = __builtin_amdgcn_mfma_f32_16x16x32_bf16(Bt[n][k], At[m][k], acc[ai][bj][m][n], 0, 0, 0); } __builtin_amdgcn_s_setprio(0); } while (0)
#define PG8_WAIT_V(n) asm volatile("s_waitcnt vmcnt(" #n ")" ::: "memory")
#define PG8_WAIT_L(n) asm volatile("s_waitcnt lgkmcnt(" #n ")" ::: "memory")
#define PG8_BAR __builtin_amdgcn_s_barrier()
#define PG8_SCHED __builtin_amdgcn_sched_barrier(0)
    Unit cur, nxt; int ui = 0;
    if (!S.next(0, cur)) return;
    f32x4 acc[2][2][4][2];
#pragma unroll
    for (int a = 0; a < 2; ++a)
#pragma unroll
        for (int b = 0; b < 2; ++b)
#pragma unroll
            for (int m = 0; m < 4; ++m)
#pragma unroll
                for (int n = 0; n < 2; ++n) acc[a][b][m][n] = (f32x4){0.f, 0.f, 0.f, 0.f};
    bf16x8 At[4][2], B0[2][2], B1[2][2];
    const char* cA = (const char*)g.A + (size_t)cur.pm * tstep + S.aoff(cur); const char* cB = S.bbase(g, cur) + (size_t)cur.pn * tstep;
    S.a_ready(cur);
    if constexpr (SP2) {
        PG8_STAGE(PG8_SB(0, 0), cB, voffB); PG8_STAGE(PG8_SB(0, 1), cB + hstep, voffB); PG8_STAGE(PG8_SA(0, 0), cA, voffA); PG8_STAGE(PG8_SA(0, 1), cA + hstep, voffA);
        if (wr == 1) PG8_BAR;
        PG8_WAIT_V(2); PG8_BAR;
        PG8_STAGE(PG8_SB(1, 0), cB + kstep, voffB); PG8_STAGE(PG8_SA(1, 0), cA + kstep, voffA); PG8_STAGE(PG8_SB(1, 1), cB + hstep + kstep, voffB);
        PG8_WAIT_V(6); PG8_BAR;
    } else {
        PG8_STAGE(PG8_SB(0, 0), cB, voffB); PG8_STAGE(PG8_SA(0, 0), cA, voffA); PG8_STAGE(PG8_SB(0, 1), cB + hstep, voffB); PG8_STAGE(PG8_SA(0, 1), cA + hstep, voffA);
        if (wr == 1) PG8_BAR;
        PG8_WAIT_V(4); PG8_BAR;
        PG8_STAGE(PG8_SB(1, 0), cB + kstep, voffB); PG8_STAGE(PG8_SA(1, 0), cA + kstep, voffA); PG8_STAGE(PG8_SB(1, 1), cB + hstep + kstep, voffB);
        PG8_WAIT_V(6); PG8_BAR;
    }
    for (;;) {
        const bool has_next = S.next(ui + 1, nxt);
        const char* nA = has_next ? (const char*)g.A + (size_t)nxt.pm * tstep + S.aoff(nxt) : cA; const char* nB = has_next ? S.bbase(g, nxt) + (size_t)nxt.pn * tstep : cB;
        for (int t = 0; t < nt; t += 2) {
            const bool last = (t == nt - 2);
            const char* a1 = cA + (size_t)(t + 1) * kstep;
            const char* a2 = last ? nA : cA + (size_t)(t + 2) * kstep; const char* b2 = last ? nB : cB + (size_t)(t + 2) * kstep;
            const char* a3 = a2 + kstep; const char* b3 = b2 + kstep;
            if (last && has_next) S.a_ready(nxt);
            if constexpr (SP2) {
            PG8_LDB(B0, 0, 0); PG8_LDB(B1, 0, 1); PG8_SCHED; PG8_LDA(At, 0, 0); PG8_STAGE(PG8_SA(1, 1), a1 + hstep, voffA);
            PG8_WAIT_V(8); PG8_WAIT_L(0); PG8_BAR; PG8_MMA(0, 0, At, B0); PG8_MMA(0, 1, At, B1); PG8_BAR; PG8_SCHED;
            PG8_LDA(At, 0, 1); PG8_STAGE(PG8_SB(0, 0), b2, voffB); PG8_STAGE(PG8_SB(0, 1), b2 + hstep, voffB); PG8_STAGE(PG8_SA(0, 0), a2, voffA);
            PG8_WAIT_V(8); PG8_WAIT_L(0); PG8_BAR; PG8_MMA(1, 0, At, B0); PG8_MMA(1, 1, At, B1); PG8_BAR; PG8_SCHED;
            PG8_LDB(B0, 1, 0); PG8_LDB(B1, 1, 1); PG8_SCHED; PG8_LDA(At, 1, 0); PG8_STAGE(PG8_SA(0, 1), a2 + hstep, voffA);
            PG8_WAIT_V(8); PG8_WAIT_L(0); PG8_BAR; PG8_MMA(0, 0, At, B0); PG8_MMA(0, 1, At, B1); PG8_BAR; PG8_SCHED;
            PG8_LDA(At, 1, 1); PG8_STAGE(PG8_SB(1, 0), b3, voffB); PG8_STAGE(PG8_SB(1, 1), b3 + hstep, voffB); PG8_STAGE(PG8_SA(1, 0), a3, voffA);
            PG8_WAIT_V(8); PG8_WAIT_L(0); PG8_BAR; PG8_MMA(1, 0, At, B0); PG8_MMA(1, 1, At, B1); PG8_BAR; PG8_SCHED;
            } else {
            PG8_LDB(B0, 0, 0); PG8_SCHED; PG8_LDA(At, 0, 0); PG8_STAGE(PG8_SA(1, 1), a1 + hstep, voffA);
            PG8_WAIT_L(8); PG8_BAR; PG8_WAIT_L(0); PG8_MMA(0, 0, At, B0); PG8_BAR; PG8_SCHED;
            PG8_LDB(B1, 0, 1); PG8_STAGE(PG8_SB(0, 0), b2, voffB);
            PG8_BAR; PG8_WAIT_L(0); PG8_MMA(0, 1, At, B1); PG8_BAR;
            PG8_LDA(At, 0, 1); PG8_STAGE(PG8_SA(0, 0), a2, voffA);
            PG8_BAR; PG8_WAIT_L(0); PG8_MMA(1, 0, At, B0); PG8_BAR; PG8_SCHED;
            PG8_STAGE(PG8_SB(0, 1), b2 + hstep, voffB);
            PG8_WAIT_V(6); PG8_BAR; PG8_MMA(1, 1, At, B1); PG8_BAR;
            PG8_LDB(B0, 1, 0); PG8_SCHED; PG8_LDA(At, 1, 0); PG8_STAGE(PG8_SA(0, 1), a2 + hstep, voffA);
            PG8_WAIT_L(8); PG8_BAR; PG8_WAIT_L(0); PG8_MMA(0, 0, At, B0); PG8_BAR; PG8_SCHED;
            PG8_LDB(B1, 1, 1); PG8_STAGE(PG8_SB(1, 0), b3, voffB);
            PG8_BAR; PG8_WAIT_L(0); PG8_MMA(0, 1, At, B1); PG8_BAR;
            PG8_LDA(At, 1, 1); PG8_STAGE(PG8_SA(1, 0), a3, voffA);
            PG8_BAR; PG8_WAIT_L(0); PG8_MMA(1, 0, At, B0); PG8_BAR; PG8_SCHED;
            PG8_STAGE(PG8_SB(1, 1), b3 + hstep, voffB);
            PG8_WAIT_V(6); PG8_BAR; PG8_MMA(1, 1, At, B1); PG8_BAR;
            }
        }
        if constexpr (ALIGN_EPI) { if (wr == 0) PG8_BAR; }
        if constexpr (F8) asm volatile("s_nop 15\n\ts_nop 15" ::: "memory");
        if constexpr (!Epi::AFTER_DRAIN) { E(acc, cur, wr, wc, fr, fq); S.done(cur); }
        if (!has_next) break;
#pragma unroll
        for (int a = 0; a < 2; ++a)
#pragma unroll
            for (int b = 0; b < 2; ++b)
#pragma unroll
                for (int m = 0; m < 4; ++m)
#pragma unroll
                    for (int n = 0; n < 2; ++n) acc[a][b][m][n] = (f32x4){0.f, 0.f, 0.f, 0.f};
        cur = nxt; cA = nA; cB = nB; ++ui;
        if constexpr (ALIGN_EPI) { if (wr == 1) PG8_BAR; }
    }
    PG8_WAIT_V(0);
    if constexpr (!ALIGN_EPI) { if (wr == 0) PG8_BAR; }
    PG8_BAR;
    if constexpr (Epi::AFTER_DRAIN) { E.fused(acc, cur, wr, wc, fr, fq, lds, wid, lane); S.done(cur); }
#undef PG8_SA
#undef PG8_SB
#undef PG8_STAGE
#undef PG8_LDA
#undef PG8_LDB
#undef PG8_MMA
#undef PG8_WAIT_V
#undef PG8_WAIT_L
#undef PG8_BAR
#undef PG8_SCHED
}
}


namespace att {
typedef unsigned short bf16;
typedef short bf16x8 __attribute__((ext_vector_type(8)));
typedef short s16x4 __attribute__((ext_vector_type(4)));
typedef float f32x16 __attribute__((ext_vector_type(16)));
typedef float f32x4 __attribute__((ext_vector_type(4)));
typedef unsigned u32x4 __attribute__((ext_vector_type(4)));
constexpr int NW = 8, QBLK = 32, KVBLK = 64, QB = NW * QBLK, D = 128;
constexpr int SHM_V = KVBLK * D * 2, SHM_K = KVBLK * D * 2, K2P = 144, SHM_K2 = KVBLK * K2P;
constexpr int OFF_V = 0, OFF_K = 2 * SHM_V, OFF_K2 = OFF_K + 2 * SHM_K, OFF_KB = OFF_K2 + 2 * SHM_K2, OFF_WS = OFF_KB + 2 * 64 * 4, LDS_BYTES = OFF_WS + NW * 64 * 4;
constexpr float THR = 8.f;
#ifndef ATT_PRIO
#define ATT_PRIO 1
#endif
template <int MODE> struct Cfg { static constexpr float SCALE = (MODE == 2) ? 0.07216878364870322f : 0.08838834764831845f; static constexpr bool SK = (MODE == 0); };

#define KSWZ(row, colB) ((row) * 256 + ((colB) ^ (((row) & 7) << 4)))
#define SBAR() __builtin_amdgcn_sched_barrier(0)
__device__ __forceinline__ int v_st(int k, int c) { const int kk = (k & ~0xC) | ((k & 4) << 1) | ((k & 8) >> 1); return ((kk >> 3) * 4 + (c >> 5)) * 512 + ((kk & 7) * 32 + (c & 31)) * 2; }
__device__ __forceinline__ int v_rd_base(int lane) { return ((lane & 3) << 3) | (((lane >> 2) & 3) << 6) | (((lane >> 4) & 1) << 5) | (((lane >> 5) & 1) << 8); }
constexpr int v_rd_off(int d0, int ks, int half) { return d0 * 512 + ks * 4096 + half * 2048; }
__device__ __forceinline__ int crow(int r, int hi) { return (r & 3) + 8 * (r >> 2) + 4 * hi; }
__device__ __forceinline__ unsigned cvtpk(float lo, float hi) { unsigned r; asm volatile("v_cvt_pk_bf16_f32 %0, %1, %2" : "=v"(r) : "v"(lo), "v"(hi)); return r; }
__device__ __forceinline__ bf16x8 load8(const bf16* p) { return *reinterpret_cast<const bf16x8*>(p); }
__device__ __forceinline__ void mask_tile(f32x16& p0, f32x16& p1, int dq, unsigned W) {
    const float NEG = -__builtin_inff();
#pragma unroll
    for (int r = 0; r < 16; ++r) {
        const int c = (r & 3) + 8 * (r >> 2);
        if ((unsigned)(dq - c) >= W) p0[r] = NEG;
        if ((unsigned)(dq - c - 32) >= W) p1[r] = NEG;
    }
}
template <int MODE>
__device__ __forceinline__ void partialSM(f32x16& p0, f32x16& p1, float& m_reg, float& mn, float& alpha) {
    constexpr float SCALE = Cfg<MODE>::SCALE;
    float pmax = p0[0];
#pragma unroll
    for (int r = 1; r < 16; ++r) pmax = fmaxf(pmax, p0[r]);
#pragma unroll
    for (int r = 0; r < 16; ++r) pmax = fmaxf(pmax, p1[r]);
    { auto rr = __builtin_amdgcn_permlane32_swap(__float_as_uint(pmax), __float_as_uint(pmax), false, false);
      pmax = fmaxf(__uint_as_float(rr[0]), __uint_as_float(rr[1])); }
    constexpr float C2 = 1.4426950408889634f * SCALE;
    if (__builtin_expect(__all((pmax - m_reg) * SCALE <= THR), 1)) { mn = m_reg; alpha = 1.f; }
    else { mn = fmaxf(m_reg, pmax); alpha = __builtin_amdgcn_exp2f((m_reg - mn) * C2); m_reg = mn; }
    const float mnL = -mn * C2;
#pragma unroll
    for (int r = 0; r < 16; ++r) p0[r] = fmaf(p0[r], C2, mnL);
#pragma unroll
    for (int r = 0; r < 16; ++r) p1[r] = fmaf(p1[r], C2, mnL);
#pragma unroll
    for (int r = 0; r < 16; ++r) p0[r] = __builtin_amdgcn_exp2f(p0[r]);
}
__device__ __forceinline__ void finishSM(f32x16& p0, f32x16& p1, float alpha, float& l_reg, bf16x8& pa0, bf16x8& pa1, bf16x8& pa2, bf16x8& pa3) {
#pragma unroll
    for (int r = 0; r < 16; ++r) p1[r] = __builtin_amdgcn_exp2f(p1[r]);
    float ps = 0;
#pragma unroll
    for (int r = 0; r < 16; ++r) ps += p0[r];
#pragma unroll
    for (int r = 0; r < 16; ++r) ps += p1[r];
    { auto rr = __builtin_amdgcn_permlane32_swap(__float_as_uint(ps), __float_as_uint(ps), false, false);
      ps = __uint_as_float(rr[0]) + __uint_as_float(rr[1]); }
    l_reg = l_reg * alpha + ps;
#define PK4(P, B_, OUT) do { unsigned a0 = cvtpk(P[B_+0], P[B_+1]), a1 = cvtpk(P[B_+2], P[B_+3]);                          \
        unsigned b0 = cvtpk(P[B_+4], P[B_+5]), b1 = cvtpk(P[B_+6], P[B_+7]);                                             \
        auto r0 = __builtin_amdgcn_permlane32_swap(a0, b0, false, false); auto r1 = __builtin_amdgcn_permlane32_swap(a1, b1, false, false); \
        u32x4 w = {r0[0], r1[0], r0[1], r1[1]}; OUT = *reinterpret_cast<bf16x8*>(&w); } while (0)
    PK4(p0, 0, pa0); PK4(p0, 8, pa1); PK4(p1, 0, pa2); PK4(p1, 8, pa3);
#undef PK4
}
template <int KB, int MODE>
__device__ __forceinline__ void qkt(f32x16& p0, f32x16& p1, const char* lds, int r32, int hi, const bf16x8* qr, const bf16x8* qr2, bool act) {
    constexpr bool SK = Cfg<MODE>::SK;
    if (SK && !act) { const float NEG = -__builtin_inff();
#pragma unroll
        for (int r = 0; r < 16; ++r) { p0[r] = NEG; p1[r] = NEG; } return; }
    p0 = f32x16{}; p1 = f32x16{};
    const char* kb[4];
#pragma unroll
    for (int dd = 0; dd < 4; ++dd) kb[dd] = lds + OFF_K + KB * SHM_K + KSWZ(r32, (dd * 16 + hi * 8) * 2);
    __builtin_amdgcn_s_setprio(ATT_PRIO);
#pragma unroll
    for (int d0 = 0; d0 < 8; ++d0) { const char* a = kb[d0 & 3] + (d0 >> 2) * 128;
        bf16x8 b0 = *reinterpret_cast<const bf16x8*>(a);
        bf16x8 b1 = *reinterpret_cast<const bf16x8*>(a + 32 * 256);
        p0 = __builtin_amdgcn_mfma_f32_32x32x16_bf16(b0, qr[d0], p0, 0, 0, 0);
        p1 = __builtin_amdgcn_mfma_f32_32x32x16_bf16(b1, qr[d0], p1, 0, 0, 0); }
    if constexpr (MODE == 2) {
        const char* k2 = lds + OFF_K2 + KB * SHM_K2 + r32 * K2P + hi * 16;
#pragma unroll
        for (int d0 = 0; d0 < 4; ++d0) {
            bf16x8 b0 = *reinterpret_cast<const bf16x8*>(k2 + d0 * 32);
            bf16x8 b1 = *reinterpret_cast<const bf16x8*>(k2 + d0 * 32 + 32 * K2P);
            p0 = __builtin_amdgcn_mfma_f32_32x32x16_bf16(b0, qr2[d0], p0, 0, 0, 0);
            p1 = __builtin_amdgcn_mfma_f32_32x32x16_bf16(b1, qr2[d0], p1, 0, 0, 0); }
    }
    __builtin_amdgcn_s_setprio(0);
}
template <int VB, bool SK>
__device__ __forceinline__ void pv_tile(f32x16* o, int vb0, bf16x8 pa0, bf16x8 pa1, bf16x8 pa2, bf16x8 pa3, bool act) {
    if (SK && !act) return;
    __builtin_amdgcn_s_setprio(ATT_PRIO);
#define TRRD(dst, off) asm volatile("ds_read_b64_tr_b16 %0, %1 offset:%2" : "=&v"(dst) : "v"(vb0), "i"(off) : "memory")
#define PV_D0(d0) do { s16x4 l0, l1, l2, l3, h0, h1, h2, h3; constexpr int b_ = OFF_V + VB * SHM_V + v_rd_off(d0, 0, 0);   \
        TRRD(l0, b_); TRRD(h0, b_ + 2048); TRRD(l1, b_ + 4096); TRRD(h1, b_ + 6144); TRRD(l2, b_ + 8192); TRRD(h2, b_ + 10240); TRRD(l3, b_ + 12288); TRRD(h3, b_ + 14336); \
        asm volatile("s_waitcnt lgkmcnt(0)" ::: "memory"); SBAR();   \
        o[d0] = __builtin_amdgcn_mfma_f32_32x32x16_bf16(pa0, (bf16x8){l0[0], l0[1], l0[2], l0[3], h0[0], h0[1], h0[2], h0[3]}, o[d0], 0, 0, 0);   \
        o[d0] = __builtin_amdgcn_mfma_f32_32x32x16_bf16(pa1, (bf16x8){l1[0], l1[1], l1[2], l1[3], h1[0], h1[1], h1[2], h1[3]}, o[d0], 0, 0, 0);   \
        o[d0] = __builtin_amdgcn_mfma_f32_32x32x16_bf16(pa2, (bf16x8){l2[0], l2[1], l2[2], l2[3], h2[0], h2[1], h2[2], h2[3]}, o[d0], 0, 0, 0);   \
        o[d0] = __builtin_amdgcn_mfma_f32_32x32x16_bf16(pa3, (bf16x8){l3[0], l3[1], l3[2], l3[3], h3[0], h3[1], h3[2], h3[3]}, o[d0], 0, 0, 0); } while (0)
    PV_D0(0); PV_D0(1); PV_D0(2); PV_D0(3);
    __builtin_amdgcn_s_setprio(0);
#undef PV_D0
#undef TRRD
}

struct Item { const bf16* Q; const bf16* K; const bf16* V; bf16* O; const bf16* Q2; const bf16* K2; const float* C; float* L; int qp, kp, vp, op, qp2, kp2, lp, P0, skv, W, jlo; };
struct Seam { bf16x8 qr[8]; bf16x8 qr2[4]; bf16x8 st_v0, st_v1, st_k0, st_k1, st_k2; float st_c; };
template <int MODE> struct Geo {
    static __device__ __forceinline__ int qp(const Item& it) { return MODE == 1 ? 2048 : (MODE == 2 ? 1280 : it.qp); }
    static __device__ __forceinline__ int kp(const Item& it) { return MODE == 1 ? 2048 : (MODE == 2 ? 1280 : it.kp); }
    static __device__ __forceinline__ int vp(const Item& it) { return MODE == 1 ? 2048 : (MODE == 2 ? 1280 : it.vp); }
    static __device__ __forceinline__ int op(const Item& it) { return MODE == 0 ? it.op : 2048; }
    static __device__ __forceinline__ int qp2(const Item&) { return 640; }
    static __device__ __forceinline__ int kp2(const Item&) { return 64; }
    static __device__ __forceinline__ int skv(const Item& it) { return MODE == 0 ? it.skv : 8192; }
    static __device__ __forceinline__ int W(const Item& it) { return MODE == 0 ? it.W : 8192; }
    static __device__ __forceinline__ int jlo(const Item& it) { if (MODE == 1) return it.jlo; const int lowk = it.P0 - W(it) + 1; return lowk > 0 ? lowk / KVBLK : 0; }
};
__device__ __forceinline__ int swa_jlo(int P0, int W) { const int lowk = P0 - W + 1; return lowk > 0 ? lowk / KVBLK : 0; }
#define VMW() asm volatile("s_waitcnt vmcnt(0)" ::: "memory")
#define VMWN(n) asm volatile("s_waitcnt vmcnt(%0)" :: "i"(n) : "memory")
#define SLOAD_H(IT, k0) do { S.st_v0 = load8((IT).V + (size_t)((k0) + sr) * Geo<MODE>::vp(IT) + sc); S.st_v1 = load8((IT).V + (size_t)((k0) + 32 + sr) * Geo<MODE>::vp(IT) + sc);              \
                             S.st_k0 = load8((IT).K + (size_t)((k0) + sr) * Geo<MODE>::kp(IT) + sc); S.st_k1 = load8((IT).K + (size_t)((k0) + 32 + sr) * Geo<MODE>::kp(IT) + sc);              \
                             if constexpr (MODE == 2) S.st_k2 = load8((IT).K2 + (size_t)((k0) + (tid >> 3)) * Geo<MODE>::kp2(IT) + (tid & 7) * 8);                                  \
                             if constexpr (MODE == 1) S.st_c = (IT).C[(k0) + lane]; } while (0)
#define SWRITE_HK(bf, CREF) do { *(bf16x8*)(K_lds + (bf) * SHM_K + kws) = S.st_k0; *(bf16x8*)(K_lds + (bf) * SHM_K + kws + 32 * 256) = S.st_k1;                            \
                             if constexpr (MODE == 2) *(bf16x8*)(lds + OFF_K2 + (bf) * SHM_K2 + (tid >> 3) * K2P + (tid & 7) * 16) = S.st_k2;                             \
                             if constexpr (MODE == 1) { if (wid == 0) ((float*)(lds + OFF_KB))[(bf) * 64 + lane] = ((CREF) - S.st_c) * (1.0f / Cfg<MODE>::SCALE); } } while (0)
#define SWRITE_HV(bf) do { *(bf16x8*)(V_lds + (bf) * SHM_V + vst0) = S.st_v0; *(bf16x8*)(V_lds + (bf) * SHM_V + vst1) = S.st_v1; } while (0)
#define SWRITE_H(bf, CREF) do { SWRITE_HV(bf); SWRITE_HK(bf, CREF); } while (0)
#define QLOAD(IT) do { _Pragma("unroll") for (int d0 = 0; d0 < 8; ++d0) S.qr[d0] = load8((IT).Q + (size_t)(wid * QBLK + r32) * Geo<MODE>::qp(IT) + d0 * 16 + hi * 8);               \
                       if constexpr (MODE == 2) { _Pragma("unroll") for (int d0 = 0; d0 < 4; ++d0) S.qr2[d0] = load8((IT).Q2 + (size_t)(wid * QBLK + r32) * Geo<MODE>::qp2(IT) + d0 * 16 + hi * 8); } } while (0)
template <int MODE>
__device__ __forceinline__ void attn_prime(const Item& cur, char* lds, Seam& S) {
    const int tid = threadIdx.x, wid = __builtin_amdgcn_readfirstlane(tid >> 6), lane = tid & 63, r32 = lane & 31, hi = lane >> 5;
    const int sr = tid >> 4, sc = (tid & 15) * 8, kws = KSWZ(sr, sc * 2); char* K_lds = lds + OFF_K;
    const int kb0 = Geo<MODE>::jlo(cur) * KVBLK;
    float cref = 0.f; if constexpr (MODE == 1) cref = cur.C[cur.P0];
    QLOAD(cur);
    SLOAD_H(cur, kb0); VMW(); SWRITE_HK(0, cref);
    __syncthreads();
}
template <int MODE>
__device__ __forceinline__ void attn_block(const Item& cur, const Item& nxt, char* lds, Seam& S) {
    constexpr bool SK = Cfg<MODE>::SK; constexpr float SCALE = Cfg<MODE>::SCALE;
    const int tid = threadIdx.x, wid = __builtin_amdgcn_readfirstlane(tid >> 6), lane = tid & 63, r32 = lane & 31, hi = lane >> 5;
    const int W = Geo<MODE>::W(cur), skv = Geo<MODE>::skv(cur);
    const int j_lo = Geo<MODE>::jlo(cur);
    int j_hi = (cur.P0 + QB - 1) / KVBLK + 1; if (j_hi > skv / KVBLK) j_hi = skv / KVBLK;
    const int NT = j_hi - j_lo;
    const int kbn = Geo<MODE>::jlo(nxt) * KVBLK;
    const int qlo = cur.P0 + wid * QBLK, qm = qlo + r32 - 4 * hi;
    char* V_lds = lds + OFF_V; char* K_lds = lds + OFF_K;
    float* ws = (float*)(lds + OFF_WS) + wid * 64; float* li_l = ws, * al_l = ws + 32;
    float m_reg = -1e30f, l_reg = 0; f32x16 o[4] = {};
    const int sr = tid >> 4, sc = (tid & 15) * 8, vst0 = v_st(sr, sc), vst1 = v_st(32 + sr, sc), kws = KSWZ(sr, sc * 2);
    const int vb0 = (int)(uintptr_t)V_lds + v_rd_base(lane);
    float cref = 0.f, crefn = 0.f; if constexpr (MODE == 1) { cref = cur.C[cur.P0]; crefn = nxt.C[nxt.P0]; }
#define RESC(a) do { if (__any((a) < 1.f)) { if (hi == 0) al_l[r32] = (a); asm volatile("s_waitcnt lgkmcnt(0)" ::: "memory");              \
                     _Pragma("unroll") for (int d_ = 0; d_ < 4; ++d_) _Pragma("unroll") for (int r = 0; r < 16; ++r) o[d_][r] *= al_l[crow(r, hi)]; } } while (0)
#define KBASE(t) ((j_lo + (t)) * KVBLK)
#define ACT(t) (KBASE(t) <= qlo + QBLK - 1 && KBASE(t) + KVBLK - 1 >= qlo - W + 1)
#define MASKT(P0_, P1_, t) do { const int kb_ = KBASE(t); if ((!SK || ACT(t)) && (kb_ + KVBLK - 1 > qlo || kb_ <= qlo + QBLK - 1 - W)) mask_tile(P0_, P1_, qm - kb_, (unsigned)W); } while (0)
#define BIAS(P0_, P1_, bf) do { if constexpr (MODE == 1) { const float* kbp = (const float*)(lds + OFF_KB) + (bf) * 64 + 4 * hi;              \
        _Pragma("unroll") for (int q_ = 0; q_ < 4; ++q_) { const f32x4 b0_ = *(const f32x4*)(kbp + 8 * q_), b1_ = *(const f32x4*)(kbp + 32 + 8 * q_);          \
            _Pragma("unroll") for (int r_ = 0; r_ < 4; ++r_) { P0_[4 * q_ + r_] += b0_[r_]; P1_[4 * q_ + r_] += b1_[r_]; } asm volatile("" ::: "memory"); } } } while (0)
    constexpr int NQL = (MODE == 2) ? 12 : 8;
#define SEAM_K0() do { VMWN(NQL); SWRITE_HK(0, crefn); SBAR(); } while (0)
    f32x16 pA0, pA1, pB0, pB1; float mnA, mnB, alA, alB; bf16x8 pa0, pa1, pa2, pa3;
    SWRITE_HV(0); SBAR();
    if (NT > 1) SLOAD_H(cur, KBASE(1));
    SBAR(); qkt<0, MODE>(pA0, pA1, lds, r32, hi, S.qr, S.qr2, ACT(0));
    BIAS(pA0, pA1, 0); MASKT(pA0, pA1, 0); partialSM<MODE>(pA0, pA1, m_reg, mnA, alA);
    if (NT > 1) { VMW(); SWRITE_H(1, cref); }
    __syncthreads();
#define HALF_STEP(PX0, PX1, mnX, alX, PY0, PY1, alY, t, KB, VB, SB) do {                                                      \
        SBAR(); qkt<KB, MODE>(PX0, PX1, lds, r32, hi, S.qr, S.qr2, ACT(t));                                                   \
        finishSM(PY0, PY1, alY, l_reg, pa0, pa1, pa2, pa3); SBAR();                                                           \
        if ((t) + 1 < NT) { SLOAD_H(cur, KBASE((t) + 1)); SBAR(); }                                                           \
        pv_tile<VB, SK>(o, vb0, pa0, pa1, pa2, pa3, ACT((t) - 1)); BIAS(PX0, PX1, KB); MASKT(PX0, PX1, (t)); partialSM<MODE>(PX0, PX1, m_reg, mnX, alX); \
        __syncthreads();                                                                                                      \
        if ((t) + 1 < NT) { VMW(); SWRITE_H(SB, cref); }                                                                      \
        RESC(alX); __syncthreads(); } while (0)
    for (int t = 1; t + 1 < NT; t += 2) {
        HALF_STEP(pB0, pB1, mnB, alB, pA0, pA1, alA, t, 1, 0, 0);
        HALF_STEP(pA0, pA1, mnA, alA, pB0, pB1, alB, t + 1, 0, 1, 1);
    }
    const bool even = (NT & 1) == 0;
    if (even) { SBAR(); qkt<1, MODE>(pB0, pB1, lds, r32, hi, S.qr, S.qr2, ACT(NT - 1)); SBAR(); }
    SLOAD_H(nxt, kbn); SBAR();
    QLOAD(nxt);
    SBAR();
    finishSM(pA0, pA1, alA, l_reg, pa0, pa1, pa2, pa3); SBAR();
    pv_tile<0, SK>(o, vb0, pa0, pa1, pa2, pa3, ACT(even ? NT - 2 : NT - 1));
    if (even) { BIAS(pB0, pB1, 1); MASKT(pB0, pB1, NT - 1); partialSM<MODE>(pB0, pB1, m_reg, mnB, alB); __syncthreads(); RESC(alB);
        finishSM(pB0, pB1, alB, l_reg, pa0, pa1, pa2, pa3); SBAR(); pv_tile<1, SK>(o, vb0, pa0, pa1, pa2, pa3, ACT(NT - 1)); }
    SBAR(); SEAM_K0();
    if (hi == 0) li_l[r32] = l_reg; asm volatile("s_waitcnt lgkmcnt(0)" ::: "memory");
    if constexpr (MODE == 0) { if (hi == 0) cur.L[(size_t)(wid * QBLK + r32) * cur.lp] = m_reg * SCALE + __logf(l_reg); }
    float rli[16];
#pragma unroll
    for (int r = 0; r < 16; ++r) rli[r] = __builtin_amdgcn_rcpf(li_l[crow(r, hi)]);
    bf16* Ow = cur.O + (size_t)(wid * QBLK) * Geo<MODE>::op(cur);
#pragma unroll
    for (int r = 0; r < 16; ++r) { const int orow = crow(r, hi);
#pragma unroll
        for (int d0 = 0; d0 < 4; ++d0) { const float v = o[d0][r] * rli[r];
            const float vn = __shfl_xor(v, 1);
            if ((r32 & 1) == 0) *(unsigned*)(Ow + (size_t)orow * Geo<MODE>::op(cur) + d0 * 32 + r32) = cvtpk(v, vn); } }
    __syncthreads();
#undef RESC
#undef KBASE
#undef ACT
#undef MASKT
#undef BIAS
#undef SEAM_K0
#undef HALF_STEP
}

template <int MODE>
__device__ __forceinline__ void attn_item_simple(const Item& cur, char* lds) {
    constexpr bool SK = Cfg<MODE>::SK; constexpr float SCALE = Cfg<MODE>::SCALE;
    const int tid = threadIdx.x, wid = __builtin_amdgcn_readfirstlane(tid >> 6), lane = tid & 63, r32 = lane & 31, hi = lane >> 5;
    const int W = Geo<MODE>::W(cur), skv = Geo<MODE>::skv(cur);
    const int j_lo = Geo<MODE>::jlo(cur);
    int j_hi = (cur.P0 + QB - 1) / KVBLK + 1; if (j_hi > skv / KVBLK) j_hi = skv / KVBLK;
    const int NT = j_hi - j_lo;
    const int qlo = cur.P0 + wid * QBLK, qm = qlo + r32 - 4 * hi;
    char* V_lds = lds + OFF_V; char* K_lds = lds + OFF_K;
    float* ws = (float*)(lds + OFF_WS) + wid * 64; float* li_l = ws, * al_l = ws + 32;
    float m_reg = -1e30f, l_reg = 0; f32x16 o[4] = {};
    const int sr = tid >> 4, sc = (tid & 15) * 8, vst0 = v_st(sr, sc), vst1 = v_st(32 + sr, sc), kws = KSWZ(sr, sc * 2);
    const int vb0 = (int)(uintptr_t)V_lds + v_rd_base(lane);
    float cref = 0.f; if constexpr (MODE == 1) cref = cur.C[cur.P0];
    Seam S;
#define RESC(a) do { if (__any((a) < 1.f)) { if (hi == 0) al_l[r32] = (a); asm volatile("s_waitcnt lgkmcnt(0)" ::: "memory");              \
                     _Pragma("unroll") for (int d_ = 0; d_ < 4; ++d_) _Pragma("unroll") for (int r = 0; r < 16; ++r) o[d_][r] *= al_l[crow(r, hi)]; } } while (0)
#define KBASE(t) ((j_lo + (t)) * KVBLK)
#define ACT(t) (KBASE(t) <= qlo + QBLK - 1 && KBASE(t) + KVBLK - 1 >= qlo - W + 1)
#define MASKT(P0_, P1_, t) do { const int kb_ = KBASE(t); if ((!SK || ACT(t)) && (kb_ + KVBLK - 1 > qlo || kb_ <= qlo + QBLK - 1 - W)) mask_tile(P0_, P1_, qm - kb_, (unsigned)W); } while (0)
#define BIAS(P0_, P1_, bf) do { if constexpr (MODE == 1) { const float* kbp = (const float*)(lds + OFF_KB) + (bf) * 64 + 4 * hi;              \
        _Pragma("unroll") for (int q_ = 0; q_ < 4; ++q_) { const f32x4 b0_ = *(const f32x4*)(kbp + 8 * q_), b1_ = *(const f32x4*)(kbp + 32 + 8 * q_);          \
            _Pragma("unroll") for (int r_ = 0; r_ < 4; ++r_) { P0_[4 * q_ + r_] += b0_[r_]; P1_[4 * q_ + r_] += b1_[r_]; } asm volatile("" ::: "memory"); } } } while (0)
    QLOAD(cur);
    SLOAD_H(cur, KBASE(0)); VMW(); SWRITE_H(0, cref);
    f32x16 pA0, pA1; float mnA, alA; bf16x8 pa0, pa1, pa2, pa3;
#define STEP(t, B) do {                                                                                                       \
        __syncthreads();                                                                                                      \
        if ((t) + 1 < NT) { SLOAD_H(cur, KBASE((t) + 1)); } SBAR();                                                           \
        qkt<B, MODE>(pA0, pA1, lds, r32, hi, S.qr, S.qr2, ACT(t));                                                            \
        BIAS(pA0, pA1, B); MASKT(pA0, pA1, (t)); partialSM<MODE>(pA0, pA1, m_reg, mnA, alA); RESC(alA);                       \
        finishSM(pA0, pA1, alA, l_reg, pa0, pa1, pa2, pa3); SBAR();                                                           \
        pv_tile<B, SK>(o, vb0, pa0, pa1, pa2, pa3, ACT(t)); SBAR();                                                           \
        if ((t) + 1 < NT) { VMW(); SWRITE_H((B) ^ 1, cref); } } while (0)
    for (int t = 0; t < NT; t += 2) {
        STEP(t, 0);
        if (t + 1 < NT) STEP(t + 1, 1);
    }
    if (hi == 0) li_l[r32] = l_reg; asm volatile("s_waitcnt lgkmcnt(0)" ::: "memory");
    if constexpr (MODE == 0) { if (hi == 0) cur.L[(size_t)(wid * QBLK + r32) * cur.lp] = m_reg * SCALE + __logf(l_reg); }
    float rli[16];
#pragma unroll
    for (int r = 0; r < 16; ++r) rli[r] = __builtin_amdgcn_rcpf(li_l[crow(r, hi)]);
    bf16* Ow = cur.O + (size_t)(wid * QBLK) * Geo<MODE>::op(cur);
#pragma unroll
    for (int r = 0; r < 16; ++r) { const int orow = crow(r, hi);
#pragma unroll
        for (int d0 = 0; d0 < 4; ++d0) { const float v = o[d0][r] * rli[r];
            const float vn = __shfl_xor(v, 1);
            if ((r32 & 1) == 0) *(unsigned*)(Ow + (size_t)orow * Geo<MODE>::op(cur) + d0 * 32 + r32) = cvtpk(v, vn); } }
    __syncthreads();
#undef RESC
#undef KBASE
#undef ACT
#undef MASKT
#undef BIAS
#undef STEP
}
#ifndef ATT_SIMPLE
#define ATT_SIMPLE 1
#endif
template <int MODE, class List>
__device__ __forceinline__ void attn_run(char* lds, const List& L) {
    const int n = L.count(); if (n <= 0) return;
#ifndef ATT_PIPE_MASK
#define ATT_PIPE_MASK 1
#endif
    if constexpr (((ATT_PIPE_MASK >> MODE) & 1) == 0) {
        for (int i = 0; i < n; ++i) { const Item it = L.get(i); attn_item_simple<MODE>(it, lds); }
        return;
    }
    Item cur = L.get(0); Seam S;
    attn_prime<MODE>(cur, lds, S);
    for (int i = 0;; ++i) {
        const bool last = (i + 1 >= n);
        const Item nxt = last ? cur : L.get(i + 1);
        attn_block<MODE>(cur, nxt, lds, S);
        if (last) break;
        cur = nxt;
    }
    __syncthreads();
}
#undef VMW
#undef VMWN
#undef SLOAD_H
#undef SWRITE_HK
#undef SWRITE_HV
#undef SWRITE_H
#undef QLOAD
#undef KSWZ
#undef SBAR
}

constexpr int NWAVES = 8;
constexpr int SEQ = 8192, NB = 2, TOK = NB * SEQ, DM = 2048, DFF = 5632, NEXP = 8;
constexpr int N_IN = 4608, OFF_CKV_C = 448, OFF_KROPE_C = 576, OFF_DQ_C = 640, OFF_DK_C = 2944, OFF_DV_C = 3712, W_IN_COLS_C = 4480;
constexpr float LN_EPS_C = 1e-5f;
#ifndef MK_PER_PHASE
#define MK_PER_PHASE 0
#endif
constexpr int NPH = 19;

constexpr size_t MiB = 1u << 20;
constexpr size_t WS_CTL = 0, CTL_ZERO_BYTES = 1 * MiB;
constexpr size_t WS_COS128 = 1 * MiB, WS_SIN128 = 3 * MiB, WS_COS64 = 5 * MiB, WS_SIN64 = 6 * MiB;
constexpr size_t WS_SSQ = 7 * MiB, WS_LSE = 8 * MiB, WS_LOGF = 10 * MiB, WS_CUM = 11 * MiB, WS_ROUTE = 12 * MiB;
constexpr size_t WS_STATS = WS_SSQ + 800 * 1024;
constexpr size_t WS_W = 13 * MiB;
constexpr size_t WB_IN = WS_W, WB_QB = WB_IN + 18 * MiB, WB_KVB = WB_QB + 2 * MiB, WB_O0 = WB_KVB + 2 * MiB, WB_GU = WB_O0 + 8 * MiB, WB_DN = WB_GU + 44 * MiB,
                 WB_QKV = WB_DN + 22 * MiB, WB_O1 = WB_QKV + 24 * MiB, WB_EGU = WB_O1 + 8 * MiB  , WB_EDN = WB_EGU + 176 * MiB  , WS_XB = WB_EDN + 88 * MiB;
constexpr size_t WS_XR = WS_XB + 64 * MiB, WS_R = WS_XR + 128 * MiB, WS_S = WS_R + 286 * MiB, WS_END = WS_S + 136 * MiB;
constexpr size_t R_CQ = WS_R, R_CKV = R_CQ + 16 * MiB, R_KR = R_CKV + 8 * MiB, R_DQ = R_KR + 2 * MiB, R_DK = R_DQ + 72 * MiB, R_DV = R_DK + 24 * MiB,
                 R_QN = R_DV + 24 * MiB, R_QR = R_QN + 40 * MiB, R_KN = R_QR + 20 * MiB, R_VV = R_KN + 40 * MiB;
static_assert(R_VV + 40 * MiB == WS_S, "region R map");
constexpr size_t R_HF = WS_R, R_Q1 = WS_R, R_K1 = WS_R + 64 * MiB, R_V1 = WS_R + 128 * MiB, R_HE = WS_R, R_YPB = WS_R + 192 * MiB;
constexpr int MOE_MAX_TILES = 136, MOE_MAIN_TILES = 128;
static_assert((size_t)MOE_MAX_TILES * 256 * DFF <= 192 * MiB && (size_t)(MOE_MAX_TILES - MOE_MAIN_TILES) * 256 * DM * 2 <= 94 * MiB && (size_t)TOK * DFF * 2 <= 286 * MiB, "overlays fit region R");
constexpr size_t S_MIX = WS_S, S_OG = WS_S + 64 * MiB, S_XP = WS_S;
static_assert((size_t)MOE_MAX_TILES * 256 * DM * 2 <= 136 * MiB, "XP fits region S");
constexpr size_t RT_E = WS_ROUTE, RT_W = WS_ROUTE + 128 * 1024, RT_SLOT = WS_ROUTE + 384 * 1024, RT_META = WS_ROUTE + 640 * 1024;
constexpr int CW_TMO = 0, CW_BAR = 4096, CW_QKMAX = 8192;

constexpr int RING_OFF = 0, RING_BYTES = 131072;
constexpr int LDSCTL_OFF = RING_BYTES, MISC_OFF = LDSCTL_OFF + 320;
constexpr int LDS_BYTES = 147456;
static_assert(att::LDS_BYTES <= RING_BYTES && pg8::STAGE_BYTES <= RING_BYTES, "phase scratch fits the ring region");

#define GAS __attribute__((address_space(1)))
#define LAS __attribute__((address_space(3)))
typedef unsigned short bf16;
typedef unsigned v4u __attribute__((ext_vector_type(4)));
typedef unsigned v2u __attribute__((ext_vector_type(2)));
typedef float f32x4 __attribute__((ext_vector_type(4)));
typedef float f32x2 __attribute__((ext_vector_type(2)));
typedef GAS unsigned gu32;
#define RLX_AGENT __ATOMIC_RELAXED, __HIP_MEMORY_SCOPE_AGENT
__device__ __forceinline__ unsigned pk2(float lo, float hi) { return pg8::cvt_pk_bf16(lo, hi); }
__device__ __forceinline__ float bf2f(unsigned short h) { return __uint_as_float((unsigned)h << 16); }
__device__ __forceinline__ int ld_i(const int* p) { return __hip_atomic_load(p, RLX_AGENT); }
__device__ __forceinline__ float ld_f(const float* p) { return __hip_atomic_load(p, RLX_AGENT); }
#define XB_TMO      128
#define XB_XCNT(j)  (256  + 64 * (j))
#define XB_XSUB(j)  (1280 + 64 * (j))
#define XB_XGEN(j)  (2304 + 64 * (j))
#define XB_TOP      3328
#define XB_TOPGEN   3392
#define XCD_BAR_WORDS 3456
#define XB_SPIN_CAP (1u << 18)

__device__ __forceinline__ unsigned xb_ld(unsigned* p)              { return __hip_atomic_load(p, __ATOMIC_RELAXED, __HIP_MEMORY_SCOPE_AGENT); }
__device__ __forceinline__ unsigned xb_add(unsigned* p, unsigned v) { return __hip_atomic_fetch_add(p, v, __ATOMIC_RELAXED, __HIP_MEMORY_SCOPE_AGENT); }
__device__ __forceinline__ unsigned xb_xcc_id() { return (unsigned)__builtin_amdgcn_s_getreg((3 << 11) | 20) & 0xFu; }
#define XB_SPIN(cond, bar) do { unsigned _sp = 0; while (cond) { __builtin_amdgcn_s_sleep(1); \
    if ((++_sp & 255u) == 0u) { if (xb_ld(&(bar)[XB_TMO])) break; if (_sp > XB_SPIN_CAP) { atomicAdd(&(bar)[XB_TMO], 1u); break; } } } } while (0)

struct XcdBarrier {
    unsigned* bar; unsigned x;
    volatile LAS unsigned* st;
};

__device__ __forceinline__ XcdBarrier xcd_barrier_post(unsigned* bar, volatile LAS unsigned* st) {
    XcdBarrier b; b.bar = bar; b.x = xb_xcc_id(); b.st = st;
    if (threadIdx.x == 0) (void)xb_add(&bar[XB_XCNT(b.x)], 1u);
    return b;
}
__device__ __forceinline__ void xcd_barrier_complete(unsigned* bar, unsigned x, unsigned& nloc, unsigned& nx) {
    const unsigned G = gridDim.x * gridDim.y * gridDim.z;
    unsigned sum, cnt, mine, sp = 0u;
    for (;;) {
        sum = 0u; cnt = 0u; mine = 0u;
#pragma unroll
        for (unsigned j = 0; j < 16; ++j) { const unsigned c = xb_ld(&bar[XB_XCNT(j)]); sum += c; cnt += (c > 0u) ? 1u : 0u; mine = (j == x) ? c : mine; }
        if (sum == G) break;
        __builtin_amdgcn_s_sleep(1);
        if ((++sp & 255u) == 0u) { if (xb_ld(&bar[XB_TMO])) break; if (sp > XB_SPIN_CAP) { atomicAdd(&bar[XB_TMO], 1u); break; } }
    }
    nloc = mine > 0u ? mine : 1u; nx = cnt > 0u ? cnt : 1u;
}

__device__ __forceinline__ void xcd_barrier(const XcdBarrier& b) {
    asm volatile("s_waitcnt vmcnt(0)" ::: "memory");
    __syncthreads();
    if (threadIdx.x == 0) {
        unsigned* bar = b.bar;
        __builtin_amdgcn_s_waitcnt(0);
        unsigned nloc = b.st[0], nx = b.st[1];
        if (nloc == 0u) { xcd_barrier_complete(bar, b.x, nloc, nx); b.st[0] = nloc; b.st[1] = nx; }
        const unsigned old = xb_add(&bar[XB_XSUB(b.x)], 1u);
        const unsigned gen = old / nloc;
        if (old + 1u == (gen + 1u) * nloc) {
            __builtin_amdgcn_fence(__ATOMIC_RELEASE, "agent");
            asm volatile("s_waitcnt vmcnt(0)" ::: "memory");
            const unsigned og = xb_add(&bar[XB_TOP], 1u);
            const unsigned tg = og / nx;
            if (og + 1u == (tg + 1u) * nx) xb_add(&bar[XB_TOPGEN], 1u);
            else XB_SPIN(xb_ld(&bar[XB_TOPGEN]) == tg, bar);
            __builtin_amdgcn_fence(__ATOMIC_ACQUIRE, "agent");
            xb_add(&bar[XB_XGEN(b.x)], 1u);
            asm volatile("s_waitcnt vmcnt(0)" ::: "memory");
        } else {
            XB_SPIN(xb_ld(&bar[XB_XGEN(b.x)]) == gen, bar);
            __builtin_amdgcn_fence(__ATOMIC_ACQUIRE, "agent");
            asm volatile("s_waitcnt vmcnt(0)" ::: "memory");
        }
    }
    __syncthreads();
}


__device__ __forceinline__ float wave_sum(float v) {
#pragma unroll
    for (int o = 1; o < 64; o <<= 1) v += __shfl_xor(v, o);
    return v;
}
#ifndef QKV_F8
#define QKV_F8 0
#endif
#ifndef FFN_DN_F8
#define FFN_DN_F8 0
#endif
#ifndef FFN_GU_F8
#define FFN_GU_F8 1
#endif
struct Conv { const float* src; const float* src2; const float* kscale; unsigned char* dst; int K, N, Kp, kind, f8; };
struct In { const float* p[27]; };
#define KA_CONST __attribute__((address_space(4)))
__device__ __forceinline__ const float* INP(int i) { return *(const float* const KA_CONST*)((const KA_CONST char*)__builtin_amdgcn_kernarg_segment_ptr() + 8 * i); }
constexpr int T_IN = (N_IN / 256) * (DM / 64), T_QB = (2048 / 256) * (512 / 64), T_KVB = (2560 / 256) * (256 / 64), T_O = (DM / 256) * (DM / 64), T_GU = (2 * DFF / 256) * (DM / 64), T_DN = (DM / 256) * (DFF / 64),
              T_QKV = (3 * DM / 256) * (DM / 64);
constexpr int T_TOTAL = T_IN + T_QB + T_KVB + T_O + T_GU + T_DN + T_QKV + T_O + NEXP * T_GU + NEXP * T_DN;
__device__ __forceinline__ Conv conv_decode(unsigned char* ws, int it, int& r) {
    r = it; Conv c;
    if (r < T_IN) { c = Conv{INP(1), nullptr, nullptr, ws + WB_IN, DM, W_IN_COLS_C, DM, 1, 0}; }
    else if ((r -= T_IN) < T_QB) { c = Conv{INP(3), nullptr, INP(2), ws + WB_QB, 448, 1920, 512, 2, 0}; }
    else if ((r -= T_QB) < T_KVB) { c = Conv{INP(5), nullptr, INP(4), ws + WB_KVB, 128, 2560, 256, 0, 0}; }
    else if ((r -= T_KVB) < T_O) { c = Conv{INP(6), nullptr, nullptr, ws + WB_O0, DM, DM, DM, 0, 0}; }
    else if ((r -= T_O) < T_GU) { c = Conv{INP(9), INP(10), nullptr, ws + WB_GU, DM, DFF, DM, 3, FFN_GU_F8}; }
    else if ((r -= T_GU) < T_DN) { c = Conv{INP(11), nullptr, nullptr, ws + WB_DN, DFF, DM, DFF, 0, FFN_DN_F8}; }
    else if ((r -= T_DN) < T_QKV) { c = Conv{INP(14), nullptr, nullptr, ws + WB_QKV, DM, 3 * DM, DM, 0, QKV_F8}; }
    else if ((r -= T_QKV) < T_O) { c = Conv{INP(17), nullptr, nullptr, ws + WB_O1, DM, DM, DM, 0, 0}; }
    else if ((r -= T_O) < NEXP * T_GU) { const int e = r / T_GU; r -= e * T_GU;
        c = Conv{INP(22) + (size_t)e * DM * DFF, INP(23) + (size_t)e * DM * DFF, nullptr, ws + WB_EGU + (size_t)e * 2 * DFF * DM, DM, DFF, DM, 3, 1}; }
    else { r -= NEXP * T_GU; const int e = r / T_DN; r -= e * T_DN;
        c = Conv{INP(24) + (size_t)e * DFF * DM, nullptr, nullptr, ws + WB_EDN + (size_t)e * DM * DFF, DFF, DM, DFF, 0, 1}; }
    return c;
}
__device__ __forceinline__ int conv_col(const Conv& c, int np, const float*& sp) {
    sp = c.src; int col = -1;
    if (c.kind == 0) { col = np < c.N ? np : -1; }
    else if (c.kind == 1) {
        const int t = np >> 8, w = np & 255, bj = w >> 7, ch = w & 127;
        if (t < 9) col = OFF_DQ_C + (2 * t + (ch >> 6)) * 128 + bj * 64 + (ch & 63);
        else if (t < 12) col = OFF_DK_C + (2 * (t - 9) + (ch >> 6)) * 128 + bj * 64 + (ch & 63);
        else if (t < 15) col = OFF_DV_C + (t - 12) * 256 + w;
        else if (t == 15) col = w;
        else if (t == 16) col = (256 + w < 448) ? 256 + w : -1;
        else col = ch < 64 ? OFF_CKV_C + bj * 64 + ch : (ch < 96 ? OFF_KROPE_C + bj * 32 + (ch - 64) : -1);
    } else if (c.kind == 2) {
        const int t = np >> 8;
        if (t < 5) col = (np >> 7) * 192 + (np & 127);
        else { const int w = np & 255, bj = w >> 7, ch = w & 127, head = 4 * (t - 5) + (ch >> 5); col = head < 10 ? head * 192 + 128 + bj * 32 + (ch & 31) : -1; }
    } else {
        const int t = np >> 8, w = np & 255, bj = w >> 7, ch = w & 127; const long long d2 = (const char*)c.src2 - (const char*)c.src; sp = (const float*)((const char*)c.src + (bj ? d2 : 0ll)); col = t * 128 + ch;
    }
    return col;
}
__device__ __forceinline__ void conv_load(const Conv& c, int r, int tid, f32x4 (&v)[8]) {
    const int nkb = c.Kp >> 6, rb = r / nkb, kb = r - rb * nkb, np = rb * 256 + (tid & 63) * 4, kl = tid >> 6, k0 = kb * 64;
    const float* sp; const int col = conv_col(c, np, sp);
#pragma unroll
    for (int i = 0; i < 8; ++i) { const int k = k0 + (c.f8 ? 4 * kl + 32 * (i >> 2) + (i & 3) : 2 * kl + 16 * (i >> 1) + (i & 1));
        v[i] = (col >= 0 && k < c.K) ? *(const f32x4*)(sp + (size_t)k * c.N + col) : (f32x4){0.f, 0.f, 0.f, 0.f}; }
    if (c.kscale) {
#pragma unroll
        for (int i = 0; i < 8; ++i) { const int k = k0 + 2 * kl + 16 * (i >> 1) + (i & 1); v[i] = v[i] * ((k < c.K) ? c.kscale[k] : 0.f); }
    }
}
constexpr int CV_PITCH = 1040;
__device__ __forceinline__ void conv_stage(const Conv& c, int tid, const f32x4 (&v)[8], LAS unsigned char* sm) {
    const int kl = tid >> 6, nl = (tid & 63) * 4;
    if (c.f8) {
#pragma unroll
        for (int j = 0; j < 2; ++j) { const int kg = kl + 8 * j, row = (kg & 3) * 4 + (kg >> 2); v4u o;
#pragma unroll
            for (int n = 0; n < 4; ++n) o[n] = pg8::pk4_fp8(v[4 * j][n] * pg8::W8_SCALE, v[4 * j + 1][n] * pg8::W8_SCALE, v[4 * j + 2][n] * pg8::W8_SCALE, v[4 * j + 3][n] * pg8::W8_SCALE);
            *(LAS v4u*)(sm + row * CV_PITCH + nl * 4) = o; }
    } else {
#pragma unroll
        for (int j = 0; j < 4; ++j) { const int kg = kl + 8 * j, row = (kg & 3) * 8 + (kg >> 2); v4u o;
#pragma unroll
            for (int n = 0; n < 4; ++n) o[n] = pk2(v[2 * j][n], v[2 * j + 1][n]);
            *(LAS v4u*)(sm + row * CV_PITCH + nl * 4) = o; }
    }
}
__device__ __forceinline__ void conv_store(const Conv& c, int r, int tid, const LAS unsigned char* sm) {
    const int nkb = c.Kp >> 6, rb = r / nkb, kb = r - rb * nkb;
    if (c.f8) {
        unsigned char* d = c.dst + (size_t)rb * 256 * c.Kp + kb * 64;
#pragma unroll
        for (int j = 0; j < 2; ++j) { const int idx = tid + 512 * j, n = idx >> 2, kc = idx & 3; v4u w;
#pragma unroll
            for (int q = 0; q < 4; ++q) w[q] = *(const LAS unsigned*)(sm + (q * 4 + kc) * CV_PITCH + n * 4);
            *(v4u*)(d + (size_t)n * c.Kp + 16 * kc) = w; }
    } else {
        unsigned char* d = c.dst + ((size_t)rb * 256 * c.Kp + kb * 64) * 2;
#pragma unroll
        for (int j = 0; j < 4; ++j) { const int idx = tid + 512 * j, n = idx >> 3, kc = idx & 7; v4u w;
#pragma unroll
            for (int q = 0; q < 4; ++q) w[q] = *(const LAS unsigned*)(sm + (q * 8 + kc) * CV_PITCH + n * 4);
            *(v4u*)(d + ((size_t)n * c.Kp + 8 * kc) * 2) = w; }
    }
}
__device__ __forceinline__ void conv_run(unsigned char* ws, LAS unsigned char* sm, int tid, int t_begin, int t_end, int nw, int w) {
    {
        const int CH = (t_end - t_begin + nw - 1) / nw, lim = t_begin + (w + 1) * CH < t_end ? t_begin + (w + 1) * CH : t_end;
        int it = t_begin + w * CH; f32x4 vA[8], vB[8];
        bool hasA = it < lim, hasB = it + 1 < lim;
        if (hasA) { int r; const Conv c = conv_decode(ws, it, r); conv_load(c, r, tid, vA); }
        if (hasB) { int r; const Conv c = conv_decode(ws, it + 1, r); conv_load(c, r, tid, vB); }
        while (hasA) {
            { int r; const Conv c = conv_decode(ws, it, r); conv_stage(c, tid, vA, sm); }
            const bool hasA2 = it + 2 < lim;
            if (hasA2) { int r; const Conv c = conv_decode(ws, it + 2, r); conv_load(c, r, tid, vA); }
            __syncthreads(); { int r; const Conv c = conv_decode(ws, it, r); conv_store(c, r, tid, sm); } __syncthreads();
            if (!hasB) break;
            { int r; const Conv c = conv_decode(ws, it + 1, r); conv_stage(c, tid, vB, sm); }
            const bool hasB2 = it + 3 < lim;
            if (hasB2) { int r; const Conv c = conv_decode(ws, it + 3, r); conv_load(c, r, tid, vB); }
            __syncthreads(); { int r; const Conv c = conv_decode(ws, it + 1, r); conv_store(c, r, tid, sm); } __syncthreads();
            it += 2; hasA = hasA2; hasB = hasB2;
        }
    }
}
constexpr int XT_GU = (2 * DFF / 128) * (DM / 64), XT_DN = (DM / 128) * (DFF / 64), XT_E = XT_GU + XT_DN, XT_TOTAL = NEXP * XT_E;
struct XTile { const float* src; unsigned char* dst; int N, Kp; };
__device__ __forceinline__ XTile xtile_decode(unsigned char* ws, int it) {
    const int e = it / XT_E; int r = it - e * XT_E; XTile x;
    if (r < XT_GU) { const int rb = r / (DM / 64), kb = r - rb * (DM / 64);
        x.src = (rb & 1 ? INP(23) : INP(22)) + (size_t)e * DM * DFF + (size_t)(kb * 64) * DFF + (rb >> 1) * 128; x.N = DFF; x.Kp = DM;
        x.dst = ws + WB_EGU + (size_t)e * 2 * DFF * DM + (size_t)(rb * 128) * DM + kb * 64; }
    else { r -= XT_GU; const int rb = r / (DFF / 64), kb = r - rb * (DFF / 64);
        x.src = INP(24) + (size_t)e * DFF * DM + (size_t)(kb * 64) * DM + rb * 128; x.N = DM; x.Kp = DFF;
        x.dst = ws + WB_EDN + (size_t)e * DM * DFF + (size_t)(rb * 128) * DFF + kb * 64; }
    return x;
}
__device__ __forceinline__ void xtile_dma(const XTile& x, LAS unsigned char* slot, int wave, int lane) {
#pragma unroll
    for (int j = 0; j < 4; ++j) { const int k = wave * 8 + 2 * j;
        __builtin_amdgcn_global_load_lds((const unsigned*)(x.src + (size_t)(k + (lane >> 5)) * x.N + (lane & 31) * 4), (LAS unsigned*)(slot + k * 512), 16, 0, 0); }
}
__device__ __forceinline__ void xtile_emit(const XTile& x, const LAS unsigned char* slot, int tid) {
    const int n = tid >> 2, kc = tid & 3; const LAS float* f = (const LAS float*)slot + (16 * kc) * 128 + n; v4u o;
#pragma unroll
    for (int q = 0; q < 4; ++q) o[q] = pg8::pk4_fp8(f[(4 * q) * 128] * pg8::W8_SCALE, f[(4 * q + 1) * 128] * pg8::W8_SCALE, f[(4 * q + 2) * 128] * pg8::W8_SCALE, f[(4 * q + 3) * 128] * pg8::W8_SCALE);
    *(v4u*)(x.dst + (size_t)n * x.Kp + 16 * kc) = o;
}
__device__ __forceinline__ void conv_run_dma(unsigned char* ws, LAS unsigned char* sm, int tid, int nw, int w) {
    const int wave = __builtin_amdgcn_readfirstlane(tid >> 6), lane = tid & 63;
    const int CH = (XT_TOTAL + nw - 1) / nw, beg = w * CH, lim = beg + CH < XT_TOTAL ? beg + CH : XT_TOTAL;
    if (beg >= lim) return;
#pragma unroll
    for (int d = 0; d < 3; ++d) { const int t = beg + d < lim ? beg + d : lim - 1; const XTile x = xtile_decode(ws, t); xtile_dma(x, sm + d * 32768, wave, lane); }
    for (int it = beg; it < lim; ++it) {
        asm volatile("s_waitcnt vmcnt(8)" ::: "memory");
        __builtin_amdgcn_s_barrier(); asm volatile("" ::: "memory");
        { const int t = it + 3 < lim ? it + 3 : lim - 1; const XTile x = xtile_decode(ws, t); xtile_dma(x, sm + ((it + 3 - beg) & 3) * 32768, wave, lane); }
        { const XTile x = xtile_decode(ws, it); xtile_emit(x, sm + ((it - beg) & 3) * 32768, tid); }
        asm volatile("s_waitcnt lgkmcnt(0)" ::: "memory");
    }
    asm volatile("s_waitcnt vmcnt(0)" ::: "memory"); __builtin_amdgcn_s_barrier();
}
#ifndef CONV_CUS
#define CONV_CUS 56
#endif
constexpr int T_NONEXP = T_IN + T_QB + T_KVB + T_O + T_GU + T_DN + T_QKV + T_O;
constexpr int T_EARLY = T_IN + T_QB + T_KVB + T_O;
__device__ __forceinline__ void p0_prologue(unsigned char* ws, LAS unsigned char* sm, int bx, int G, int gw, int NGW, int lane, int tid) {
    conv_run(ws, sm, tid, 0, CONV_CUS ? T_EARLY : T_TOTAL, G, bx);
    { const float* x = INP(0); bf16* xb = (bf16*)(ws + WS_XB); const int gt = gw * 64 + lane, NGT = NGW * 64;
      for (int i = gt; i < TOK * DM / 8; i += NGT) { const f32x4 a = *(const f32x4*)(x + (size_t)i * 8), b = *(const f32x4*)(x + (size_t)i * 8 + 4);
          *(v4u*)(xb + (size_t)i * 8) = pg8::pack8(a, b); } }
    { const int gt = gw * 64 + lane, NGT = NGW * 64;
      for (int i = gt; i < SEQ * 96; i += NGT) {
          const int pos = i / 96, f = i - pos * 96; const bool big = f < 64; const int fi = big ? f : f - 64;
          const double ex = -13.287712379549449 * (big ? (double)fi / 64.0 : (double)fi / 32.0);
          const double inv = ::exp2(ex);
          const double rev = (double)pos * inv * 0.15915494309189535;
          const float fr = (float)(rev - __builtin_rint(rev));
          const float cs = __builtin_amdgcn_cosf(fr), sn = __builtin_amdgcn_sinf(fr);
          if (big) { ((float*)(ws + WS_COS128))[pos * 64 + fi] = cs; ((float*)(ws + WS_SIN128))[pos * 64 + fi] = sn; }
          else { ((float*)(ws + WS_COS64))[pos * 32 + fi] = cs; ((float*)(ws + WS_SIN64))[pos * 32 + fi] = sn; }
      } }
}

__device__ __forceinline__ void ln_core(f32x4 (&v)[8], const float* g, const float* b, int lane, float* mean_out = nullptr, float* rstd_out = nullptr) {
    float s = 0.f;
#pragma unroll
    for (int j = 0; j < 8; ++j) s += (v[j][0] + v[j][1]) + (v[j][2] + v[j][3]);
    const float mean = wave_sum(s) * (1.f / DM); float s2 = 0.f;
#pragma unroll
    for (int j = 0; j < 8; ++j) { v[j] = v[j] - mean; s2 += (v[j][0] * v[j][0] + v[j][1] * v[j][1]) + (v[j][2] * v[j][2] + v[j][3] * v[j][3]); }
    const float rstd = 1.f / sqrtf(wave_sum(s2) * (1.f / DM) + LN_EPS_C);
    if (mean_out) { *mean_out = mean; *rstd_out = rstd; }
#pragma unroll
    for (int j = 0; j < 8; ++j) { const f32x4 gg = *(const f32x4*)(g + 4 * (lane + 64 * j)), bb = *(const f32x4*)(b + 4 * (lane + 64 * j)); v[j] = v[j] * rstd * gg + bb; }
}
template <int EXTRA, bool OUT8 = false, bool WRITE_XB = true>
__device__ __forceinline__ void ln_phase(float* XR, bf16* XB, const float* g, const float* b, const float* ew, const float* eb, unsigned char* ws, LAS float* sm, int gw, int NGW, int lane, int tid, float* XRo = nullptr) {
    constexpr int NH = EXTRA == 1 ? 16 : (EXTRA == 2 ? 8 : 0);
    if constexpr (EXTRA != 0) {
        for (int k = tid; k < DM; k += NWAVES * 64)
#pragma unroll
            for (int q = 0; q < NH / 4; ++q) { const f32x4 w4 = *(const f32x4*)(ew + (size_t)k * NH + 4 * q);
#pragma unroll
                for (int cc = 0; cc < 4; ++cc) sm[(4 * q + cc) * DM + k] = w4[cc]; }
        __syncthreads();
    }
    for (int row0 = gw; row0 < TOK; row0 += 2 * NGW) {
        const int row1 = row0 + NGW; const bool two = row1 < TOK; const int r1 = two ? row1 : row0;
        f32x4 v0[8], v1[8];
#pragma unroll
        for (int j = 0; j < 8; ++j) { v0[j] = *(const f32x4*)(XR + (size_t)row0 * DM + 4 * (lane + 64 * j)); v1[j] = *(const f32x4*)(XR + (size_t)r1 * DM + 4 * (lane + 64 * j)); }
        float mu0, rs0, mu1, rs1;
        ln_core(v0, g, b, lane, &mu0, &rs0); ln_core(v1, g, b, lane, &mu1, &rs1);
        if (lane == 0) { f32x2* ST = (f32x2*)(ws + WS_STATS); ST[row0] = (f32x2){mu0, rs0}; if (two) ST[row1] = (f32x2){mu1, rs1}; }
        if constexpr (WRITE_XB) {
#pragma unroll
        for (int j = 0; j < 8; ++j) {
            if constexpr (OUT8) { *(unsigned*)((unsigned char*)XB + (size_t)row0 * DM + 4 * (lane + 64 * j)) = pg8::pk4_fp8(v0[j][0], v0[j][1], v0[j][2], v0[j][3]); }
            else { v2u o; o.x = pk2(v0[j][0], v0[j][1]); o.y = pk2(v0[j][2], v0[j][3]); *(v2u*)(XB + (size_t)row0 * DM + 4 * (lane + 64 * j)) = o; } }
        if (two) {
#pragma unroll
            for (int j = 0; j < 8; ++j) {
                if constexpr (OUT8) { *(unsigned*)((unsigned char*)XB + (size_t)row1 * DM + 4 * (lane + 64 * j)) = pg8::pk4_fp8(v1[j][0], v1[j][1], v1[j][2], v1[j][3]); }
                else { v2u o; o.x = pk2(v1[j][0], v1[j][1]); o.y = pk2(v1[j][2], v1[j][3]); *(v2u*)(XB + (size_t)row1 * DM + 4 * (lane + 64 * j)) = o; } }
        }
        }
        if constexpr (EXTRA != 0) {
            float m0 = 0.f, m1 = 0.f;
#pragma unroll 2
            for (int h = 0; h < NH; ++h) { float s0 = 0.f, s1 = 0.f;
#pragma unroll
                for (int j = 0; j < 8; ++j) { const f32x4 w4 = *(const LAS f32x4*)(sm + h * DM + 4 * (lane + 64 * j));
                    s0 += (v0[j][0] * w4[0] + v0[j][1] * w4[1]) + (v0[j][2] * w4[2] + v0[j][3] * w4[3]);
                    s1 += (v1[j][0] * w4[0] + v1[j][1] * w4[1]) + (v1[j][2] * w4[2] + v1[j][3] * w4[3]); }
                s0 = wave_sum(s0); s1 = wave_sum(s1);
                if (lane == h) { m0 = s0; m1 = s1; } }
            if constexpr (EXTRA == 1) {
                if (lane < 16) { const float bb = eb[lane]; float z = m0 + bb;
                    ((float*)(ws + WS_LOGF))[(size_t)row0 * 16 + lane] = fminf(z, 0.f) - log1pf(__expf(-fabsf(z)));
                    z = m1 + bb;
                    if (two) ((float*)(ws + WS_LOGF))[(size_t)row1 * 16 + lane] = fminf(z, 0.f) - log1pf(__expf(-fabsf(z))); }
            } else {
                const float bb = lane < 8 ? eb[lane] : 0.f; m0 += bb; m1 += bb;
#pragma unroll
                for (int rr = 0; rr < 2; ++rr) {
                    float a[8];
#pragma unroll
                    for (int h = 0; h < 8; ++h) a[h] = __shfl(rr ? m1 : m0, h);
                    int e0 = 0; float l0 = a[0];
#pragma unroll
                    for (int h = 1; h < 8; ++h) if (a[h] > l0) { l0 = a[h]; e0 = h; }
                    int e1 = -1; float l1 = -__builtin_inff();
#pragma unroll
                    for (int h = 0; h < 8; ++h) if (h != e0 && a[h] > l1) { l1 = a[h]; e1 = h; }
                    const int row = rr ? row1 : row0;
                    if (lane == 0 && (rr == 0 || two)) { const float w0 = 1.f / (1.f + __expf(l1 - l0));
                        ((int*)(ws + RT_E))[row] = e0 | (e1 << 8);
                        ((f32x2*)(ws + RT_W))[row] = (f32x2){w0, 1.f - w0}; }
                }
            }
        }
    }
    if constexpr (EXTRA != 0) __syncthreads();
}
__device__ __forceinline__ void merge_phase(unsigned char* ws, int gw, int NGW, int lane) {
    const bf16* OG = (const bf16*)(ws + S_OG); const float* LSE = (const float*)(ws + WS_LSE); bf16* MIX = (bf16*)(ws + S_MIX);
    for (int tok = gw; tok < TOK; tok += NGW) {
#pragma unroll
        for (int h = 0; h < 6; ++h) {
            const float l0 = LSE[(size_t)tok * 6 + h], l1 = LSE[(size_t)TOK * 6 + (size_t)tok * 6 + h], l2 = LSE[(size_t)2 * TOK * 6 + (size_t)tok * 6 + h];
            const float mx = fmaxf(l0, fmaxf(l1, l2)); const float e0 = __expf(l0 - mx), e1 = __expf(l1 - mx), e2 = __expf(l2 - mx); const float inv = 1.f / (e0 + e1 + e2);
            const unsigned a = *(const unsigned*)(OG + (size_t)tok * 768 + h * 128 + 2 * lane), b = *(const unsigned*)(OG + (size_t)TOK * 768 + (size_t)tok * 768 + h * 128 + 2 * lane),
                           c = *(const unsigned*)(OG + (size_t)2 * TOK * 768 + (size_t)tok * 768 + h * 128 + 2 * lane);
            const float lo = (e0 * bf2f(a & 0xffff) + e1 * bf2f(b & 0xffff) + e2 * bf2f(c & 0xffff)) * inv, hi = (e0 * bf2f(a >> 16) + e1 * bf2f(b >> 16) + e2 * bf2f(c >> 16)) * inv;
            *(unsigned*)(MIX + (size_t)tok * DM + 1280 + h * 128 + 2 * lane) = pk2(lo, hi);
        }
    }
}
__device__ __forceinline__ void scan_phase(unsigned char* ws, LAS float* sm, int bh, int tid) {
    const int b = bh >> 4, h = bh & 15; const float* LOGF = (const float*)(ws + WS_LOGF); float* CUM = (float*)(ws + WS_CUM) + (size_t)bh * SEQ;
    float v[16]; float run = 0.f;
#pragma unroll
    for (int i = 0; i < 16; ++i) { run += LOGF[((size_t)b * SEQ + tid * 16 + i) * 16 + h]; v[i] = run; }
    const int lane = tid & 63, wave = tid >> 6;
    float inc = run;
#pragma unroll
    for (int o = 1; o < 64; o <<= 1) { const float t = __shfl_up(inc, o); if (lane >= o) inc += t; }
    if (lane == 63) sm[wave] = inc;
    __syncthreads();
    float base = inc - run;
#pragma unroll
    for (int w = 0; w < 8; ++w) if (w < wave) base += sm[w];
#pragma unroll
    for (int i = 0; i < 16; ++i) CUM[tid * 16 + i] = base + v[i];
    __syncthreads();
}
__device__ __forceinline__ void dispatch_phase(unsigned char* ws, LAS int* sm, int tid) {
    const int* E = (const int*)(ws + RT_E); int* SLOT = (int*)(ws + RT_SLOT); int* META = (int*)(ws + RT_META);
    int c[8]; LAS int* ev = sm + 8192 + tid * 33;
#pragma unroll
    for (int e = 0; e < 8; ++e) c[e] = 0;
#pragma unroll
    for (int i = 0; i < 8; ++i) { const v4u q = *(const v4u*)(E + tid * 32 + 4 * i); ev[4 * i] = (int)q.x; ev[4 * i + 1] = (int)q.y; ev[4 * i + 2] = (int)q.z; ev[4 * i + 3] = (int)q.w; }
#pragma unroll 2
    for (int i = 0; i < 32; ++i) { const int e0 = ev[i] & 255, e1 = ev[i] >> 8;
#pragma unroll
        for (int e = 0; e < 8; ++e) c[e] += (e0 == e) + (e1 == e); }
#pragma unroll
    for (int e = 0; e < 8; ++e) sm[tid * 8 + e] = c[e];
    __syncthreads();
    { const int wave = tid >> 6, lane = tid & 63;
      int loc[8]; int s = 0;
#pragma unroll
      for (int i = 0; i < 8; ++i) { loc[i] = s; s += sm[(lane * 8 + i) * 8 + wave]; }
      int inc = s;
#pragma unroll
      for (int o = 1; o < 64; o <<= 1) { const int t = __shfl_up(inc, o); if (lane >= o) inc += t; }
      const int exc = inc - s;
      __syncthreads();
#pragma unroll
      for (int i = 0; i < 8; ++i) sm[(lane * 8 + i) * 8 + wave] = exc + loc[i];
      if (lane == 63) sm[4096 + wave] = inc; }
    __syncthreads();
    if (tid == 0) { int off = 0;
        for (int e = 0; e < 8; ++e) { const int n = sm[4096 + e], np = (n + 255) & ~255; META[8 + e] = n; META[16 + e] = off; sm[4104 + e] = off;
            for (int t = off >> 8; t < (off + np) >> 8; ++t) META[32 + t] = e;
            off += np; }
        META[0] = off >> 8; }
    __syncthreads();
    int base[8];
#pragma unroll
    for (int e = 0; e < 8; ++e) base[e] = sm[4104 + e] + sm[tid * 8 + e];
#pragma unroll 2
    for (int i = 0; i < 32; ++i) { const int e0 = ev[i] & 255, e1 = ev[i] >> 8; int s0 = 0, s1 = 0;
#pragma unroll
        for (int e = 0; e < 8; ++e) { if (e0 == e) { s0 = base[e]; base[e]++; } if (e1 == e) { s1 = base[e]; base[e]++; } }
        *(v2u*)(SLOT + (tid * 32 + i) * 2) = (v2u){(unsigned)s0, (unsigned)s1}; }
    __syncthreads();
}
__device__ __forceinline__ void gather_phase(unsigned char* ws, const float* lg, const float* lb, int gw, int NGW, int lane) {
    const float* XR = (const float*)(ws + WS_XR); unsigned char* XP = ws + S_XP; const int* SLOT = (const int*)(ws + RT_SLOT); const int* META = (const int*)(ws + RT_META);
    for (int tok = gw; tok < TOK; tok += NGW) {
        const v2u sl = *(const v2u*)(SLOT + 2 * tok); const int s0 = (int)sl.x, s1 = (int)sl.y;
        const f32x2 st = ((const f32x2*)(ws + WS_STATS))[tok];
#pragma unroll
        for (int j = 0; j < 2; ++j) { const float* xp = XR + (size_t)tok * DM + 16 * (lane + 64 * j); const float* gp = lg + 16 * (lane + 64 * j); const float* bp = lb + 16 * (lane + 64 * j);
            const f32x4 a = (*(const f32x4*)xp - st[0]) * st[1] * *(const f32x4*)gp + *(const f32x4*)bp, b = (*(const f32x4*)(xp + 4) - st[0]) * st[1] * *(const f32x4*)(gp + 4) + *(const f32x4*)(bp + 4),
                        c = (*(const f32x4*)(xp + 8) - st[0]) * st[1] * *(const f32x4*)(gp + 8) + *(const f32x4*)(bp + 8), d = (*(const f32x4*)(xp + 12) - st[0]) * st[1] * *(const f32x4*)(gp + 12) + *(const f32x4*)(bp + 12);
            v4u x; x.x = pg8::pk4_fp8(a[0], a[1], a[2], a[3]); x.y = pg8::pk4_fp8(b[0], b[1], b[2], b[3]); x.z = pg8::pk4_fp8(c[0], c[1], c[2], c[3]); x.w = pg8::pk4_fp8(d[0], d[1], d[2], d[3]);
            *(v4u*)(XP + (size_t)s0 * DM + 16 * (lane + 64 * j)) = x; *(v4u*)(XP + (size_t)s1 * DM + 16 * (lane + 64 * j)) = x; }
    }
    for (int e = 0; e < 8; ++e) { const int n = META[8 + e], off = META[16 + e], np = (n + 255) & ~255; const v4u z = {0u, 0u, 0u, 0u};
        for (int r = n + gw; r < np; r += NGW)
#pragma unroll
            for (int j = 0; j < 2; ++j) *(v4u*)(XP + (size_t)(off + r) * DM + 16 * (lane + 64 * j)) = z; }
}
__device__ __forceinline__ void final_phase(unsigned char* ws, float* out, const float* lg, const float* lb, const float* g, const float* b, int gw, int NGW, int lane) {
    const float* XR = (const float*)(ws + WS_XR); const bf16* YP = (const bf16*)(ws + S_XP); const bf16* YPB = (const bf16*)(ws + R_YPB); const int* SLOT = (const int*)(ws + RT_SLOT); const f32x2* RW = (const f32x2*)(ws + RT_W);
    for (int row = gw; row < TOK; row += NGW) {
        const v2u sl = *(const v2u*)(SLOT + 2 * row); const int s0 = (int)sl.x, s1 = (int)sl.y; const f32x2 w = RW[row]; const f32x2 st = ((const f32x2*)(ws + WS_STATS))[row];
        f32x4 v[8];
#pragma unroll
        for (int j = 0; j < 8; ++j) { const f32x4 x = (*(const f32x4*)(XR + (size_t)row * DM + 4 * (lane + 64 * j)) - st[0]) * st[1] * *(const f32x4*)(lg + 4 * (lane + 64 * j)) + *(const f32x4*)(lb + 4 * (lane + 64 * j));
            const v2u a = *(const v2u*)(YP + (size_t)s0 * DM + 4 * (lane + 64 * j)), c = *(const v2u*)(YP + (size_t)s1 * DM + 4 * (lane + 64 * j));
            f32x4 ya = {bf2f(a.x & 0xffff), bf2f(a.x >> 16), bf2f(a.y & 0xffff), bf2f(a.y >> 16)}, yc = {bf2f(c.x & 0xffff), bf2f(c.x >> 16), bf2f(c.y & 0xffff), bf2f(c.y >> 16)};
            if (s0 >= MOE_MAIN_TILES * 256) { const v2u q = *(const v2u*)(YPB + (size_t)(s0 - MOE_MAIN_TILES * 256) * DM + 4 * (lane + 64 * j)); ya += (f32x4){bf2f(q.x & 0xffff), bf2f(q.x >> 16), bf2f(q.y & 0xffff), bf2f(q.y >> 16)}; }
            if (s1 >= MOE_MAIN_TILES * 256) { const v2u q = *(const v2u*)(YPB + (size_t)(s1 - MOE_MAIN_TILES * 256) * DM + 4 * (lane + 64 * j)); yc += (f32x4){bf2f(q.x & 0xffff), bf2f(q.x >> 16), bf2f(q.y & 0xffff), bf2f(q.y >> 16)}; }
            const f32x4 m = ya * w[0] + yc * w[1];
            v[j] = x * pg8::ALPHA_RES + m; }
        ln_core(v, g, b, lane);
#pragma unroll
        for (int j = 0; j < 8; ++j) *(f32x4*)(out + (size_t)row * DM + 4 * (lane + 64 * j)) = v[j];
    }
}

__device__ __forceinline__ int snake_k(int i, int G, int c) { return (i & 1) ? i * G + (G - 1 - c) : i * G + c; }
__device__ __forceinline__ int snake_count(int total, int G, int c) { int n = 0; while (snake_k(n, G, c) < total) ++n; return n; }
struct FoxList {
    int G, c; unsigned char* ws; int j0, j1, j2, j3, n;
    __device__ __forceinline__ int first_tile(int i) const {
        const int k = snake_k(i, G, c), qb = 31 - (k >> 5), bh = k & 31, b = bh >> 4, h = bh & 15;
        const float* C = (const float*)(ws + WS_CUM) + (size_t)bh * SEQ;
        const unsigned* MP = (const unsigned*)(ws + WS_CTL) + CW_QKMAX;
        const float qm = __uint_as_float(MP[(0 * 2 + b) * 16 + h]), km = __uint_as_float(MP[(1 * 2 + b) * 16 + h]);
        const float S = 1.1f * 0.08838834764831845f * 4.0f * sqrtf(qm * km), thr = -(2.0f * S + 110.0f);
        const int lane = threadIdx.x & 63, nt0 = qb * 4;
        const float c0 = C[qb * 256];
        const bool keep0 = (lane < nt0) ? (c0 - C[64 * lane + 63] >= thr) : true, keep1 = (lane + 64 < nt0) ? (c0 - C[64 * (lane + 64) + 63] >= thr) : true;
        const unsigned long long m0 = __ballot(keep0), m1 = __ballot(keep1);
        int j = m0 ? __builtin_ctzll(m0) : 64 + (m1 ? __builtin_ctzll(m1) : 0);
        return j > nt0 ? nt0 : j; }
    __device__ __forceinline__ void init(int G_, int c_, unsigned char* ws_) { G = G_; c = c_; ws = ws_; n = snake_count(1024, G, c); j0 = j1 = j2 = j3 = 0;
        if (n > 0) j0 = first_tile(0); if (n > 1) j1 = first_tile(1); if (n > 2) j2 = first_tile(2); if (n > 3) j3 = first_tile(3); }
    __device__ __forceinline__ int count() const { return n; }
    __device__ __forceinline__ att::Item get(int i) const {
        const int k = snake_k(i, G, c), qb = 31 - (k >> 5), bh = k & 31, b = bh >> 4, h = bh & 15; att::Item it{};
        const bf16* Q1 = (const bf16*)(ws + R_Q1); const bf16* K1 = (const bf16*)(ws + R_K1); const bf16* V1 = (const bf16*)(ws + R_V1); bf16* MIX = (bf16*)(ws + S_MIX);
        it.Q = Q1 + ((size_t)b * SEQ + qb * 256) * DM + h * 128; it.K = K1 + (size_t)b * SEQ * DM + h * 128; it.V = V1 + (size_t)b * SEQ * DM + h * 128;
        it.O = MIX + ((size_t)b * SEQ + qb * 256) * DM + h * 128; it.C = (const float*)(ws + WS_CUM) + (size_t)bh * SEQ;
        it.Q2 = nullptr; it.K2 = nullptr; it.L = nullptr; it.qp = DM; it.kp = DM; it.vp = DM; it.op = DM; it.qp2 = 0; it.kp2 = 0; it.lp = 0; it.P0 = qb * 256; it.skv = SEQ; it.W = SEQ;
        it.jlo = i == 0 ? j0 : (i == 1 ? j1 : (i == 2 ? j2 : (i == 3 ? j3 : 0)));
        return it; }
};
struct MlaList {
    int G, c; unsigned char* ws;
    __device__ __forceinline__ int count() const { return snake_count(640, G, c); }
    __device__ __forceinline__ att::Item get(int i) const {
        const int k = snake_k(i, G, c), qb = 31 - k / 20, bh = k % 20, b = bh / 10, h = bh % 10; att::Item it{};
        const size_t r0 = (size_t)b * SEQ + qb * 256, k0 = (size_t)b * SEQ;
        it.Q = (const bf16*)(ws + R_QN) + r0 * 1280 + h * 128; it.Q2 = (const bf16*)(ws + R_QR) + r0 * 640 + h * 64;
        it.K = (const bf16*)(ws + R_KN) + k0 * 1280 + h * 128; it.K2 = (const bf16*)(ws + R_KR) + k0 * 64; it.V = (const bf16*)(ws + R_VV) + k0 * 1280 + h * 128;
        it.O = (bf16*)(ws + S_MIX) + r0 * DM + h * 128; it.C = nullptr; it.L = nullptr;
        it.qp = 1280; it.kp = 1280; it.vp = 1280; it.op = DM; it.qp2 = 640; it.kp2 = 64; it.lp = 0; it.P0 = qb * 256; it.skv = SEQ; it.W = SEQ;
        return it; }
};
struct DilList {
    int start, n; unsigned char* ws;
    __device__ __forceinline__ void init(int G, int c) {
        const int tgt = (4224000 + 1152 * 970 + G / 2) / G;
        int acc = 0, prev = 0, cur = 0;
        for (int j = 0; j <= c; ++j) {
            int s = 0; for (int i = 0; snake_k(i, G, j) < 640; ++i) s += 4 * (32 - snake_k(i, G, j) / 20);
            int d = tgt - 100 * s; if (d < 0) d = 0;
            acc += d; prev = cur; cur = (acc + 485) / 970; if (cur > 1152) cur = 1152; }
        if (c == G - 1) cur = 1152;
        if (prev > cur) prev = cur;
        start = prev; n = cur - prev;
    }
    __device__ __forceinline__ int count() const { return n; }
    __device__ __forceinline__ att::Item get(int i) const {
        const int k = start + i, j = k & 31, rest = k >> 5, g = rest % 3, h = (rest / 3) % 6, b = rest / 18, d = 1 << (2 * g), r = j & (d - 1), sb = j >> (2 * g); att::Item it{};
        const size_t t0 = (size_t)b * SEQ + (size_t)sb * 256 * d + r, tk = (size_t)b * SEQ + r;
        it.Q = (const bf16*)(ws + R_DQ) + t0 * 2304 + (g * 6 + h) * 128; it.K = (const bf16*)(ws + R_DK) + tk * 768 + h * 128; it.V = (const bf16*)(ws + R_DV) + tk * 768 + h * 128;
        it.O = (bf16*)(ws + S_OG) + (size_t)g * TOK * 768 + t0 * 768 + h * 128; it.L = (float*)(ws + WS_LSE) + (size_t)g * TOK * 6 + t0 * 6 + h;
        it.Q2 = nullptr; it.K2 = nullptr; it.C = nullptr; it.qp = 2304 * d; it.kp = 768 * d; it.vp = 768 * d; it.op = 768 * d; it.qp2 = 0; it.kp2 = 0; it.lp = 6 * d;
        it.P0 = sb * 256; it.skv = SEQ / d; it.W = 129;
        return it; }
};

struct Args { In in; float* out; unsigned char* ws; int ph_lo, ph_hi; };
static_assert(sizeof(Args) == 240, "kernarg layout");
__global__ void __launch_bounds__(NWAVES * 64, 2) mega_fwd(Args args) {
    extern __shared__ __attribute__((aligned(16))) unsigned char lds[];
    LAS unsigned char* ldsl = (LAS unsigned char*)lds;
    volatile LAS unsigned* MISC = (volatile LAS unsigned*)(ldsl + MISC_OFF);
    const int tid = threadIdx.x, lane = tid & 63, wave = __builtin_amdgcn_readfirstlane(tid >> 6);
    const int G = gridDim.x, bx = blockIdx.x, gw = bx * NWAVES + wave, NGW = G * NWAVES;
    unsigned char* ws = *(unsigned char* const KA_CONST*)((const KA_CONST char*)__builtin_amdgcn_kernarg_segment_ptr() + 224);
    gu32* ctl = (gu32*)(ws + WS_CTL);
    for (int u = tid; u < (LDS_BYTES - LDSCTL_OFF) / 4; u += NWAVES * 64) ((LAS unsigned*)(ldsl + LDSCTL_OFF))[u] = 0u;
    __syncthreads();
#if MK_PER_PHASE
#define GRID_BAR() do { } while (0)
#else
    XcdBarrier bar = xcd_barrier_post((unsigned*)(ctl + CW_BAR), MISC + 8);
#define GRID_BAR() xcd_barrier(bar)
#endif
    const int lo = *(const KA_CONST int*)((const KA_CONST char*)__builtin_amdgcn_kernarg_segment_ptr() + 232), hi = *(const KA_CONST int*)((const KA_CONST char*)__builtin_amdgcn_kernarg_segment_ptr() + 236);
#ifndef PH_MASK
#define PH_MASK 0x7ffff
#endif
#define IN(k) ((((PH_MASK) >> (k)) & 1) && lo <= (k) && (k) < hi)
#define BOTH(k) (IN(k) && IN((k) + 1))
#ifndef REP_MASK
#define REP_MASK 0
#endif
#define REP(k) (((REP_MASK) >> (k)) & 1)
#define XB ((bf16*)(ws + WS_XB))
#define XR ((float*)(ws + WS_XR))
#define MIX ((bf16*)(ws + S_MIX))
#define COS128 ((const float*)(ws + WS_COS128))
#define SIN128 ((const float*)(ws + WS_SIN128))
#define COS64 ((const float*)(ws + WS_COS64))
#define SIN64 ((const float*)(ws + WS_SIN64))
#define SSQ ((float*)(ws + WS_SSQ))

    if (IN(0)) {
#if REP(0)
        p0_prologue(ws, ldsl + RING_OFF, bx, G, gw, NGW, lane, tid); GRID_BAR();
#endif
        p0_prologue(ws, ldsl + RING_OFF, bx, G, gw, NGW, lane, tid); if (BOTH(0)) GRID_BAR(); }
    if (IN(1)) {
        pg8::Gemm g{XB, (const bf16*)(ws + WB_IN), TOK, N_IN, DM}; pg8::StaticOrder S; S.init(TOK, N_IN, G, bx);
        pg8::EpiIn E{(bf16*)(ws + R_DQ), (bf16*)(ws + R_DK), (bf16*)(ws + R_DV), (bf16*)(ws + R_CQ), (bf16*)(ws + R_CKV), (bf16*)(ws + R_KR), SSQ, COS128, SIN128, COS64, SIN64};
#if REP(1)
        pg8::gemm_phase<pg8::EpiIn, pg8::StaticOrder, true, true>(ldsl + RING_OFF, g, S, E); GRID_BAR();
#endif
        pg8::gemm_phase<pg8::EpiIn, pg8::StaticOrder, true, true>(ldsl + RING_OFF, g, S, E);
        if (BOTH(1)) GRID_BAR();
    }
    if (IN(2)) {
        { pg8::Gemm g{(const bf16*)(ws + R_CQ), (const bf16*)(ws + WB_QB), TOK, 2048, 512}; pg8::StaticOrder S; S.init(TOK, 2048, G, bx);
          pg8::EpiQb E{(bf16*)(ws + R_QN), (bf16*)(ws + R_QR), SSQ, COS64, SIN64};
          pg8::gemm_phase<pg8::EpiQb, pg8::StaticOrder, true, true>(ldsl + RING_OFF, g, S, E); }
        { pg8::Gemm g{(const bf16*)(ws + R_CKV), (const bf16*)(ws + WB_KVB), TOK, 2560, 256}; pg8::StaticOrder S; S.init(TOK, 2560, G, bx);
          pg8::EpiKvb E{(bf16*)(ws + R_KN), (bf16*)(ws + R_VV), SSQ};
          pg8::gemm_phase<pg8::EpiKvb, pg8::StaticOrder, true, true>(ldsl + RING_OFF, g, S, E); }
        if (BOTH(2)) GRID_BAR();
    }
    if (IN(3)) {
        if (CONV_CUS && bx < CONV_CUS) { conv_run_dma(ws, ldsl + RING_OFF, tid, CONV_CUS, bx); __syncthreads(); conv_run(ws, ldsl + RING_OFF, tid, T_EARLY, T_NONEXP, CONV_CUS, bx); }
        else {
            const int Ga = G - CONV_CUS, ca = bx - CONV_CUS;
            { MlaList L{Ga, ca, ws}; att::attn_run<2, MlaList>((char*)lds + RING_OFF, L); }
            { DilList L; L.ws = ws; L.init(Ga, ca); att::attn_run<0, DilList>((char*)lds + RING_OFF, L); }
        }
        if (BOTH(3)) GRID_BAR();
    }
    if (IN(4)) {
#ifdef THIN_PROBE
        merge_phase(ws, gw, NGW, lane); GRID_BAR();
#endif
        merge_phase(ws, gw, NGW, lane); if (BOTH(4)) GRID_BAR(); }
    if (IN(5)) {
        pg8::Gemm g{MIX, (const bf16*)(ws + WB_O0), TOK, DM, DM}; pg8::StaticOrder S; S.init(TOK, DM, G, bx);
        pg8::EpiRes E{INP(0), XR, 1.f, nullptr, nullptr, nullptr};
        pg8::gemm_phase<pg8::EpiRes, pg8::StaticOrder, true, true>(ldsl + RING_OFF, g, S, E);
        if (BOTH(5)) GRID_BAR();
    }
    if (IN(6)) {
        ln_phase<0, FFN_GU_F8 != 0>(XR, XB, INP(7), INP(8), nullptr, nullptr, ws, (LAS float*)(ldsl + RING_OFF), gw, NGW, lane, tid); if (BOTH(6)) GRID_BAR(); }
    if (IN(7)) {
        pg8::Gemm g{XB, (const bf16*)(ws + WB_GU), TOK, 2 * DFF, FFN_GU_F8 ? DM / 2 : DM}; pg8::StaticOrder S; S.init(TOK, 2 * DFF, G, bx);
#if FFN_DN_F8
        pg8::EpiSwiglu8 E{ws + R_HF, DFF};
        pg8::gemm_phase<pg8::EpiSwiglu8, pg8::StaticOrder, true, true, true>(ldsl + RING_OFF, g, S, E);
#else
        pg8::EpiSwiglu E{(bf16*)(ws + R_HF), DFF, 0, FFN_GU_F8 ? 1.f / pg8::W8_SCALE : 1.f};
        pg8::gemm_phase<pg8::EpiSwiglu, pg8::StaticOrder, true, true, FFN_GU_F8 != 0>(ldsl + RING_OFF, g, S, E);
#endif
        if (BOTH(7)) GRID_BAR();
    }
    if (IN(8)) {
        pg8::Gemm g{(const bf16*)(ws + R_HF), (const bf16*)(ws + WB_DN), TOK, DM, FFN_DN_F8 ? DFF / 2 : DFF}; pg8::StaticOrder S; S.init(TOK, DM, G, bx);
        pg8::EpiRes E{XR, XR, FFN_DN_F8 ? 1.f / (pg8::W8_SCALE * pg8::H8_SCALE) : 1.f, (const float*)(ws + WS_STATS), INP(7), INP(8)};
        pg8::gemm_phase<pg8::EpiRes, pg8::StaticOrder, true, true, FFN_DN_F8 != 0>(ldsl + RING_OFF, g, S, E);
        if (BOTH(8)) GRID_BAR();
    }
    if (IN(9)) {
        ln_phase<1, QKV_F8 != 0>(XR, XB, INP(12), INP(13), INP(15), INP(16), ws, (LAS float*)(ldsl + RING_OFF), gw, NGW, lane, tid); if (BOTH(9)) GRID_BAR(); }
    if (IN(10)) {
        if (bx < 32) scan_phase(ws, (LAS float*)(ldsl + RING_OFF), bx, tid);
        pg8::Gemm g{XB, (const bf16*)(ws + WB_QKV), TOK, 3 * DM, QKV_F8 ? DM / 2 : DM}; pg8::StaticOrder S; S.init(TOK, 3 * DM, G, bx);
        pg8::EpiPlain E{(bf16*)(ws + R_Q1), DM, DM, (size_t)TOK * DM, QKV_F8 ? 1.f / pg8::W8_SCALE : 1.f, (unsigned*)(ws + WS_CTL) + CW_QKMAX};
#if REP(10)
        pg8::gemm_phase<pg8::EpiPlain, pg8::StaticOrder, true, true, QKV_F8 != 0>(ldsl + RING_OFF, g, S, E); GRID_BAR();
#endif
        pg8::gemm_phase<pg8::EpiPlain, pg8::StaticOrder, true, true, QKV_F8 != 0>(ldsl + RING_OFF, g, S, E);
        if (BOTH(10)) GRID_BAR();
    }
    if (IN(11)) {
#if REP(11)
        for (int rep_ = 0; rep_ < 2; ++rep_) { FoxList L; L.init(G, bx, ws); att::attn_run<1, FoxList>((char*)lds + RING_OFF, L); GRID_BAR(); }
#else
        { FoxList L; L.init(G, bx, ws); att::attn_run<1, FoxList>((char*)lds + RING_OFF, L); } if (BOTH(11)) GRID_BAR();
#endif
    }
    if (IN(12)) {
        pg8::Gemm g{MIX, (const bf16*)(ws + WB_O1), TOK, DM, DM}; pg8::StaticOrder S; S.init(TOK, DM, G, bx);
        pg8::EpiRes E{XR, XR, 1.f, (const float*)(ws + WS_STATS), INP(12), INP(13)};
        pg8::gemm_phase<pg8::EpiRes, pg8::StaticOrder, true, true>(ldsl + RING_OFF, g, S, E);
        if (BOTH(12)) GRID_BAR();
    }
    if (IN(13)) {
        ln_phase<2, false, false>(XR, XB, INP(18), INP(19), INP(20), INP(21), ws, (LAS float*)(ldsl + RING_OFF), gw, NGW, lane, tid); if (BOTH(13)) GRID_BAR(); }
    if (IN(14)) {
#ifdef THIN_PROBE
        if (bx == 0) dispatch_phase(ws, (LAS int*)(ldsl + RING_OFF), tid); GRID_BAR();
#endif
        if (bx == 0) dispatch_phase(ws, (LAS int*)(ldsl + RING_OFF), tid); if (BOTH(14)) GRID_BAR(); }
    if (IN(15)) {
#ifdef THIN_PROBE
        gather_phase(ws, INP(18), INP(19), gw, NGW, lane); GRID_BAR();
#endif
        gather_phase(ws, INP(18), INP(19), gw, NGW, lane); if (BOTH(15)) GRID_BAR(); }
    if (IN(16) || IN(17)) {
        const int* META = (const int*)(ws + RT_META);
        const int ntiles = __builtin_amdgcn_readfirstlane(ld_i(META));
        if (IN(16)) {
            pg8::Gemm g{(const bf16*)(ws + S_XP), (const bf16*)(ws + WB_EGU), 0, 2 * DFF, DM / 2}; pg8::MoeOrder S; S.init(ntiles, 2 * DFF, G, bx, 0, META + 32, (size_t)2 * DFF * DM);
            pg8::EpiSwiglu8 E{ws + R_HE, DFF};
#if REP(16)
            pg8::gemm_phase<pg8::EpiSwiglu8, pg8::MoeOrder, true, true, true>(ldsl + RING_OFF, g, S, E); GRID_BAR();
#endif
            pg8::gemm_phase<pg8::EpiSwiglu8, pg8::MoeOrder, true, true, true>(ldsl + RING_OFF, g, S, E);
            if (BOTH(16)) GRID_BAR();
        }
        if (IN(17)) {
            const int nmain = ntiles < MOE_MAIN_TILES ? ntiles : MOE_MAIN_TILES;
            { pg8::Gemm g{(const bf16*)(ws + R_HE), (const bf16*)(ws + WB_EDN), 0, DM, DFF / 2}; pg8::MoeOrder S; S.init(nmain, DM, G, bx, 0, META + 32, (size_t)DM * DFF);
              pg8::EpiPlainS E{(bf16*)(ws + S_XP), DM, 1.f / (pg8::W8_SCALE * pg8::H8_SCALE), nullptr, 0};
              pg8::gemm_phase<pg8::EpiPlainS, pg8::MoeOrder, true, true, true>(ldsl + RING_OFF, g, S, E); }
            if (ntiles > MOE_MAIN_TILES) {
              pg8::Gemm g{(const bf16*)(ws + R_HE), (const bf16*)(ws + WB_EDN), 0, DM, DFF / 2, DFF / 4}; pg8::TailOrder S{MOE_MAIN_TILES, ntiles - MOE_MAIN_TILES, G, bx, META + 32, (size_t)DM * DFF, (size_t)DFF / 2};
              pg8::EpiPlainS E{(bf16*)(ws + S_XP), DM, 1.f / (pg8::W8_SCALE * pg8::H8_SCALE), (bf16*)(ws + R_YPB), MOE_MAIN_TILES * 256};
              pg8::gemm_phase<pg8::EpiPlainS, pg8::TailOrder, true, true, true>(ldsl + RING_OFF, g, S, E); }
            if (BOTH(17)) GRID_BAR();
        }
    }
    if (IN(18)) {
#ifdef THIN_PROBE
        final_phase(ws, *(float* const KA_CONST*)((const KA_CONST char*)__builtin_amdgcn_kernarg_segment_ptr() + 216), INP(18), INP(19), INP(25), INP(26), gw, NGW, lane); GRID_BAR();
#endif
#ifdef BAR_PROBE
        for (int i_ = 0; i_ < 20; ++i_) GRID_BAR();
#endif
        final_phase(ws, *(float* const KA_CONST*)((const KA_CONST char*)__builtin_amdgcn_kernarg_segment_ptr() + 216), INP(18), INP(19), INP(25), INP(26), gw, NGW, lane); }
#undef IN
#undef BOTH
#undef GRID_BAR
#undef XB
#undef XR
#undef MIX
#undef COS128
#undef SIN128
#undef COS64
#undef SIN64
#undef SSQ
}

extern "C" void kernel_launch(void* const* d_in, const int* in_sizes, int n_in, void* d_out, int out_size, void* d_ws, size_t ws_size, hipStream_t stream) {
    static int grid = 0;
    if (grid == 0) {
        if (n_in != 27 || in_sizes[0] != TOK * DM || out_size != TOK * DM || ws_size < WS_END) {
            fprintf(stderr, "kernel_launch: built for 27 inputs, x/out of %d floats, >= %zu bytes of workspace; got n_in %d, in0 %d, out %d, ws %zu; nothing launched\n", TOK * DM, (size_t)WS_END, n_in, n_in > 0 ? in_sizes[0] : -1, out_size, ws_size);
            grid = -1; return; }
        int dev = 0, cus = 0, per_cu = 0;
        if (hipGetDevice(&dev) != hipSuccess || hipDeviceGetAttribute(&cus, hipDeviceAttributeMultiprocessorCount, dev) != hipSuccess) { fprintf(stderr, "kernel_launch: device query failed\n"); grid = -1; return; }
        if (hipFuncSetAttribute((const void*)mega_fwd, hipFuncAttributeMaxDynamicSharedMemorySize, LDS_BYTES) != hipSuccess) { fprintf(stderr, "kernel_launch: hipFuncSetAttribute failed\n"); grid = -1; return; }
        if (hipOccupancyMaxActiveBlocksPerMultiprocessor(&per_cu, (const void*)mega_fwd, NWAVES * 64, LDS_BYTES) != hipSuccess || per_cu < 1)
            fprintf(stderr, "kernel_launch: note: occupancy query reports %d workgroups per CU\n", per_cu);
        (void)hipGetLastError();
        grid = cus;
    }
    if (grid < 0) return;
    if (hipMemsetAsync((char*)d_ws + WS_CTL, 0, CTL_ZERO_BYTES, stream) != hipSuccess) { fprintf(stderr, "kernel_launch: memset failed\n"); return; }
    Args a{};
    for (int i = 0; i < 27; ++i) a.in.p[i] = (const float*)d_in[i];
    a.out = (float*)d_out; a.ws = (unsigned char*)d_ws;
#if MK_PER_PHASE
    for (int ph = 0; ph < NPH; ++ph) { a.ph_lo = ph; a.ph_hi = ph + 1; hipLaunchKernelGGL(mega_fwd, dim3(grid), dim3(NWAVES * 64), LDS_BYTES, stream, a); }
#else
    a.ph_lo = 0; a.ph_hi = NPH; hipLaunchKernelGGL(mega_fwd, dim3(grid), dim3(NWAVES * 64), LDS_BYTES, stream, a);
#endif
    const hipError_t le = hipPeekAtLastError();
    if (le != hipSuccess) fprintf(stderr, "kernel_launch: launch failed: %s\n", hipGetErrorName(le));
}
```

```cpp
#include <hip/hip_runtime.h>
#include <cstdio>
#include <cstdint>
namespace pg8 {
#define PG8_LAS __attribute__((address_space(3)))
typedef unsigned short bf16_t;
typedef short bf16x8 __attribute__((ext_vector_type(8)));
typedef float f32x4 __attribute__((ext_vector_type(4)));
typedef unsigned u32x4 __attribute__((ext_vector_type(4)));
constexpr int BM = 256, BK = 64, HALF = 128, HTB = HALF * BK * 2  , STAGE_BYTES = 8 * HTB, NXCD = 8, WGM = 8;

__host__ __device__ __forceinline__ int lds_byte(int r, int c) { const int st = (r >> 4) * 2 + (c >> 5), rr = r & 15, cc = c & 31, ob = rr * 64 + cc * 2; return st * 1024 + (ob ^ (((ob >> 9) & 1) << 5)); }
__host__ __device__ __forceinline__ void stage_rc(int b, int& R, int& C) { const int st = b / 1024, sb = b % 1024, swz = sb ^ (((sb >> 9) & 1) << 5); R = (st >> 1) * 16 + swz / 64; C = (st & 1) * 32 + (swz % 64) / 2; }
__host__ __device__ __forceinline__ int perm32(int rho) { const int n = rho >> 4, i = rho & 15; return 8 * (i >> 2) + 4 * n + (i & 3); }

struct Unit { int pm, pn, kh; };
struct Gemm { const bf16_t* A; const bf16_t* Bt; int M, N, K; int Kl = 0; };

struct StaticOrder {
    static constexpr bool GATHER = false;
    int nM, nN, nwg, G, c;
    __host__ __device__ void init(int M, int N, int G_, int c_) { nM = M / BM; nN = N / BM; nwg = nM * nN; G = G_; c = c_; }
    __host__ __device__ bool next(int i, Unit& u) const {
        const long L = (long)i * G + c; if (L >= nwg) return false;
        int wgid = (int)L; { const int q = nwg / NXCD, r = nwg % NXCD, xcd = wgid % NXCD, off = wgid / NXCD; wgid = (xcd < r ? xcd * (q + 1) : r * (q + 1) + (xcd - r) * q) + off; }
        const int nig = WGM * nN, gid = wgid / nig, fm = gid * WGM, gsz = (nM - fm) < WGM ? (nM - fm) : WGM;
        u.pm = fm + ((wgid % nig) % gsz); u.pn = (wgid % nig) / gsz; u.kh = 0; return true;
    }
    __device__ __forceinline__ const char* bbase(const Gemm& g, const Unit&) const { return (const char*)g.Bt; }
    __device__ __forceinline__ size_t aoff(const Unit&) const { return 0; }
    __device__ __forceinline__ void a_ready(const Unit&) const {}
    __device__ __forceinline__ void done(const Unit&) const {}
};

__device__ __forceinline__ unsigned cvt_pk_bf16(float lo, float hi) { unsigned r; asm volatile("v_cvt_pk_bf16_f32 %0, %1, %2" : "=v"(r) : "v"(lo), "v"(hi)); return r; }
__device__ __forceinline__ u32x4 pack8(f32x4 a, f32x4 b) { u32x4 w; w.x = cvt_pk_bf16(a[0], a[1]); w.y = cvt_pk_bf16(a[2], a[3]); w.z = cvt_pk_bf16(b[0], b[1]); w.w = cvt_pk_bf16(b[2], b[3]); return w; }
__device__ __forceinline__ float sq4(f32x4 v) { return (v[0] * v[0] + v[1] * v[1]) + (v[2] * v[2] + v[3] * v[3]); }
typedef int i32x8 __attribute__((ext_vector_type(8)));
typedef int i32x4 __attribute__((ext_vector_type(4)));
typedef float f32x2 __attribute__((ext_vector_type(2)));
#ifndef XR_BF16
#define XR_BF16 2
#endif
#if XR_BF16
typedef bf16_t res_t;
#else
typedef float res_t;
#endif
typedef _Float16 f16x2 __attribute__((ext_vector_type(2)));
typedef unsigned u32x2s __attribute__((ext_vector_type(2)));
template <int CTRL> __device__ __forceinline__ float dpp_f(float v) { return __builtin_bit_cast(float, __builtin_amdgcn_update_dpp(0, __builtin_bit_cast(int, v), CTRL, 0xf, 0xf, false)); }
__device__ __forceinline__ float row16_sum(float v) { v += dpp_f<0xB1>(v); v += dpp_f<0x4E>(v); v += dpp_f<0x141>(v); v += dpp_f<0x140>(v); return v; }
__device__ __forceinline__ float row16_max(float v) { v = fmaxf(v, dpp_f<0xB1>(v)); v = fmaxf(v, dpp_f<0x4E>(v)); v = fmaxf(v, dpp_f<0x141>(v)); v = fmaxf(v, dpp_f<0x140>(v)); return v; }
__device__ __forceinline__ float xsum16(float v) { float a = v, b = v; asm("s_nop 1\n\tv_permlane16_swap_b32 %0, %1" : "+v"(a), "+v"(b)); return a + b; }
__device__ __forceinline__ float xsum32(float v) { float a = v, b = v; asm("s_nop 1\n\tv_permlane32_swap_b32 %0, %1" : "+v"(a), "+v"(b)); return a + b; }
__device__ __forceinline__ f32x4 bf4(unsigned lo, unsigned hi) { return (f32x4){__builtin_bit_cast(float, lo << 16), __builtin_bit_cast(float, lo & 0xffff0000u), __builtin_bit_cast(float, hi << 16), __builtin_bit_cast(float, hi & 0xffff0000u)}; }
#if XR_BF16 == 2
__device__ __forceinline__ f32x4 res4(unsigned lo, unsigned hi) { const f16x2 a = __builtin_bit_cast(f16x2, lo), b = __builtin_bit_cast(f16x2, hi); return (f32x4){(float)a[0], (float)a[1], (float)b[0], (float)b[1]}; }
__device__ __forceinline__ unsigned res_pk2(float a, float b) { const f16x2 h = {(_Float16)a, (_Float16)b}; return __builtin_bit_cast(unsigned, h); }
__device__ __forceinline__ u32x4 res_pack8(f32x4 a, f32x4 b) { u32x4 w; w.x = res_pk2(a[0], a[1]); w.y = res_pk2(a[2], a[3]); w.z = res_pk2(b[0], b[1]); w.w = res_pk2(b[2], b[3]); return w; }
#else
__device__ __forceinline__ f32x4 res4(unsigned lo, unsigned hi) { return bf4(lo, hi); }
__device__ __forceinline__ u32x4 res_pack8(f32x4 a, f32x4 b) { return pack8(a, b); }
#endif
__device__ __forceinline__ i32x8 cat8(bf16x8 lo, bf16x8 hi) { const i32x4 a = __builtin_bit_cast(i32x4, lo), b = __builtin_bit_cast(i32x4, hi); return __builtin_shufflevector(a, b, 0, 1, 2, 3, 4, 5, 6, 7); }
__device__ __forceinline__ void mfma8(f32x4& c, const i32x8 a, const i32x8 b) { asm volatile("v_mfma_f32_16x16x128_f8f6f4 %0, %1, %2, %0" : "+v"(c) : "v"(a), "v"(b)); }
constexpr float ALPHA_RES = 1.41421356237309515f;

struct MoeOrder {
    static constexpr bool GATHER = false;
    StaticOrder so; int t0; const int* texp; size_t estride;
    __device__ __forceinline__ void init(int ntiles, int N, int G_, int c_, int t0_, const int* texp_, size_t estride_) { so.init(ntiles * BM, N, G_, c_); t0 = t0_; texp = texp_; estride = estride_; }
    __device__ __forceinline__ bool next(int i, Unit& u) const { if (!so.next(i, u)) return false; u.pm += t0; return true; }
    __device__ __forceinline__ const char* bbase(const Gemm& g, const Unit& u) const {
        const int e = __builtin_amdgcn_readfirstlane(__hip_atomic_load(texp + u.pm, __ATOMIC_RELAXED, __HIP_MEMORY_SCOPE_AGENT));
        return (const char*)g.Bt + (size_t)e * estride; }
    __device__ __forceinline__ size_t aoff(const Unit&) const { return 0; }
    __device__ __forceinline__ void a_ready(const Unit&) const {}
    __device__ __forceinline__ void done(const Unit&) const {}
};
struct MoeGatherOrder : MoeOrder { static constexpr bool GATHER = true; const int* rowidx; };
struct TailOrder {
    static constexpr bool GATHER = false;
    int t0, nrt, G, c; const int* texp; size_t estride, khbytes;
    __device__ __forceinline__ bool next(int i, Unit& u) const { const int L = i * G + c; if (L >= nrt * 16) return false; u.kh = L & 1; u.pn = (L >> 1) & 7; u.pm = t0 + (L >> 4); return true; }
    __device__ __forceinline__ const char* bbase(const Gemm& g, const Unit& u) const {
        const int e = __builtin_amdgcn_readfirstlane(__hip_atomic_load(texp + u.pm, __ATOMIC_RELAXED, __HIP_MEMORY_SCOPE_AGENT));
        return (const char*)g.Bt + (size_t)e * estride + (size_t)u.kh * khbytes; }
    __device__ __forceinline__ size_t aoff(const Unit& u) const { return (size_t)u.kh * khbytes; }
    __device__ __forceinline__ void a_ready(const Unit&) const {}
    __device__ __forceinline__ void done(const Unit&) const {}
};

struct EpiIn {
    static constexpr bool PERM = true, AFTER_DRAIN = false;
    bf16_t *DQ, *DK, *DV, *CQ, *CKV, *KR; float* SSQ; const float *cos128, *sin128, *cos64, *sin64;
    __device__ __forceinline__ void rope_tile(const f32x4 (&acc)[2][2][4][2], bf16_t* base, int pitch, int head, int i0, int row0) const {
        f32x4 c0[2], c1[2], s0[2], s1[2];
#define EPIIN_LOAD(k) _Pragma("unroll") for (int q = 0; q < 2; ++q) { const int it = 2 * (k) + q, pos = (row0 + (it >> 2) * HALF + (it & 3) * 16) & 8191; \
            c0[q] = *(const f32x4*)(cos128 + pos * 64 + i0); c1[q] = *(const f32x4*)(cos128 + pos * 64 + i0 + 4); s0[q] = *(const f32x4*)(sin128 + pos * 64 + i0); s1[q] = *(const f32x4*)(sin128 + pos * 64 + i0 + 4); }
        EPIIN_LOAD(0)
#pragma unroll
        for (int k = 0; k < 4; ++k) {
            u32x4 w0[2], w1[2];
#pragma unroll
            for (int q = 0; q < 2; ++q) { const int it = 2 * k + q, ai = it >> 2, m = it & 3;
                const f32x4 a0 = acc[ai][0][m][0], a1 = acc[ai][0][m][1], b0 = acc[ai][1][m][0], b1 = acc[ai][1][m][1];
                w0[q] = pack8(a0 * c0[q] - b0 * s0[q], a1 * c1[q] - b1 * s1[q]); w1[q] = pack8(b0 * c0[q] + a0 * s0[q], b1 * c1[q] + a1 * s1[q]); }
            if (k < 3) { EPIIN_LOAD(k + 1) }
#pragma unroll
            for (int q = 0; q < 2; ++q) { const int it = 2 * k + q, row = row0 + (it >> 2) * HALF + (it & 3) * 16;
                bf16_t* p = base + (size_t)row * pitch + head * 128 + i0; *(u32x4*)p = w0[q]; *(u32x4*)(p + 64) = w1[q]; }
        }
#undef EPIIN_LOAD
    }
    __device__ __forceinline__ void operator()(const f32x4 (&acc)[2][2][4][2], const Unit& u, int wr, int wc, int fr, int fq) const {
        const int t = u.pn, row0 = u.pm * BM + wr * 64 + fr;
        if (t < 12) {
            bf16_t* base; int pitch, head0;
            if (t < 9) { base = DQ; pitch = 2304; head0 = 2 * t; } else { base = DK; pitch = 768; head0 = 2 * (t - 9); }
            const int ch = wc * 32 + 8 * fq, head = head0 + (ch >> 6), i0 = ch & 63;
            rope_tile(acc, base, pitch, head, i0, row0);
        } else if (t < 15) {
#pragma unroll
            for (int ai = 0; ai < 2; ++ai)
#pragma unroll
                for (int m = 0; m < 4; ++m) {
                    const int row = row0 + ai * HALF + m * 16;
#pragma unroll
                    for (int bj = 0; bj < 2; ++bj) *(u32x4*)(DV + (size_t)row * 768 + (t - 12) * 256 + bj * HALF + wc * 32 + 8 * fq) = pack8(acc[ai][bj][m][0], acc[ai][bj][m][1]);
                }
        } else if (t < 17) {
#pragma unroll
            for (int ai = 0; ai < 2; ++ai)
#pragma unroll
                for (int m = 0; m < 4; ++m) {
                    const int row = row0 + ai * HALF + m * 16; float s = 0.f;
#pragma unroll
                    for (int bj = 0; bj < 2; ++bj) { *(u32x4*)(CQ + (size_t)row * 512 + (t - 15) * 256 + bj * HALF + wc * 32 + 8 * fq) = pack8(acc[ai][bj][m][0], acc[ai][bj][m][1]);
                        s += sq4(acc[ai][bj][m][0]) + sq4(acc[ai][bj][m][1]); }
                    s = xsum16(s); s = xsum32(s);
                    if (fq == 0) SSQ[(size_t)row * 12 + (t - 15) * 4 + wc] = s;
                }
        } else {
#pragma unroll
            for (int ai = 0; ai < 2; ++ai)
#pragma unroll
                for (int m = 0; m < 4; ++m) {
                    const int row = row0 + ai * HALF + m * 16, pos = row & 8191;
                    if (wc < 2) {
                        float s = 0.f;
#pragma unroll
                        for (int bj = 0; bj < 2; ++bj) { *(u32x4*)(CKV + (size_t)row * 256 + bj * 64 + wc * 32 + 8 * fq) = pack8(acc[ai][bj][m][0], acc[ai][bj][m][1]);
                            s += sq4(acc[ai][bj][m][0]) + sq4(acc[ai][bj][m][1]); }
                        s = xsum16(s); s = xsum32(s);
                        if (fq == 0) SSQ[(size_t)row * 12 + 8 + wc] = s;
                    } else {
                        const u32x4 z = {0u, 0u, 0u, 0u};
#pragma unroll
                        for (int bj = 0; bj < 2; ++bj) *(u32x4*)(CKV + (size_t)row * 256 + 128 + (wc - 2) * 64 + bj * 32 + 8 * fq) = z;
                        if (wc == 2) {
                            const int i0 = 8 * fq;
                            const f32x4 c0 = *(const f32x4*)(cos64 + pos * 32 + i0), c1 = *(const f32x4*)(cos64 + pos * 32 + i0 + 4);
                            const f32x4 s0 = *(const f32x4*)(sin64 + pos * 32 + i0), s1 = *(const f32x4*)(sin64 + pos * 32 + i0 + 4);
                            const f32x4 a0 = acc[ai][0][m][0], a1 = acc[ai][0][m][1], b0 = acc[ai][1][m][0], b1 = acc[ai][1][m][1];
                            bf16_t* p = KR + (size_t)row * 64 + i0;
                            *(u32x4*)p = pack8(a0 * c0 - b0 * s0, a1 * c1 - b1 * s1);
                            *(u32x4*)(p + 32) = pack8(b0 * c0 + a0 * s0, b1 * c1 + a1 * s1);
                        }
                    }
                }
        }
    }
};

struct EpiQb {
    static constexpr bool PERM = true, AFTER_DRAIN = false;
    bf16_t *QN, *QR; const float* SSQ; const float *cos64, *sin64;
    __device__ __forceinline__ void rope_tile(const f32x4 (&acc)[2][2][4][2], const float (&rs)[8], int head, int i0, int row0) const {
        f32x4 c0[2], c1[2], s0[2], s1[2];
#define EPIQB_LOAD(k) _Pragma("unroll") for (int q = 0; q < 2; ++q) { const int it = 2 * (k) + q, pos = (row0 + (it >> 2) * HALF + (it & 3) * 16) & 8191; \
            c0[q] = *(const f32x4*)(cos64 + pos * 32 + i0); c1[q] = *(const f32x4*)(cos64 + pos * 32 + i0 + 4); s0[q] = *(const f32x4*)(sin64 + pos * 32 + i0); s1[q] = *(const f32x4*)(sin64 + pos * 32 + i0 + 4); }
        EPIQB_LOAD(0)
#pragma unroll
        for (int k = 0; k < 4; ++k) {
            u32x4 w0[2], w1[2];
#pragma unroll
            for (int q = 0; q < 2; ++q) { const int it = 2 * k + q, ai = it >> 2, m = it & 3; const float r = rs[it];
                const f32x4 a0 = acc[ai][0][m][0] * r, a1 = acc[ai][0][m][1] * r, b0 = acc[ai][1][m][0] * r, b1 = acc[ai][1][m][1] * r;
                w0[q] = pack8(a0 * c0[q] - b0 * s0[q], a1 * c1[q] - b1 * s1[q]); w1[q] = pack8(b0 * c0[q] + a0 * s0[q], b1 * c1[q] + a1 * s1[q]); }
            if (k < 3) { EPIQB_LOAD(k + 1) }
#pragma unroll
            for (int q = 0; q < 2; ++q) { const int it = 2 * k + q, row = row0 + (it >> 2) * HALF + (it & 3) * 16;
                bf16_t* p = QR + (size_t)row * 640 + head * 64 + i0; *(u32x4*)p = w0[q]; *(u32x4*)(p + 32) = w1[q]; }
        }
#undef EPIQB_LOAD
    }
    __device__ __forceinline__ void operator()(const f32x4 (&acc)[2][2][4][2], const Unit& u, int wr, int wc, int fr, int fq) const {
        const int t = u.pn, row0 = u.pm * BM + wr * 64 + fr;
        float rs[8];
#pragma unroll
        for (int h = 0; h < 2; ++h) { f32x4 q0[4], q1[4];
#pragma unroll
            for (int m = 0; m < 4; ++m) { const int row = row0 + h * HALF + m * 16; q0[m] = *(const f32x4*)(SSQ + (size_t)row * 12); q1[m] = *(const f32x4*)(SSQ + (size_t)row * 12 + 4); }
#pragma unroll
            for (int m = 0; m < 4; ++m) { const f32x4 a = q0[m], b = q1[m]; rs[h * 4 + m] = 1.0f / sqrtf((((a[0] + a[1]) + (a[2] + a[3])) + ((b[0] + b[1]) + (b[2] + b[3]))) * (1.0f / 448.0f) + 1e-6f); } }
        if (t < 5) {
#pragma unroll
            for (int ai = 0; ai < 2; ++ai)
#pragma unroll
                for (int m = 0; m < 4; ++m) { const int row = row0 + ai * HALF + m * 16; const float r = rs[ai * 4 + m];
#pragma unroll
                    for (int bj = 0; bj < 2; ++bj) *(u32x4*)(QN + (size_t)row * 1280 + t * 256 + bj * HALF + wc * 32 + 8 * fq) = pack8(acc[ai][bj][m][0] * r, acc[ai][bj][m][1] * r); }
        } else {
            const int head = 4 * (t - 5) + wc, i0 = 8 * fq;
            if (head < 10) rope_tile(acc, rs, head, i0, row0);
        }
    }
};

struct EpiKvb {
    static constexpr bool PERM = true, AFTER_DRAIN = false;
    bf16_t *KN, *VV; const float* SSQ;
    __device__ __forceinline__ void operator()(const f32x4 (&acc)[2][2][4][2], const Unit& u, int wr, int wc, int fr, int fq) const {
        const int t = u.pn, row0 = u.pm * BM + wr * 64 + fr;
#pragma unroll
        for (int ai = 0; ai < 2; ++ai)
#pragma unroll
            for (int m = 0; m < 4; ++m) {
                const int row = row0 + ai * HALF + m * 16;
                const float rs = 1.0f / sqrtf((SSQ[(size_t)row * 12 + 8] + SSQ[(size_t)row * 12 + 9]) * (1.0f / 128.0f) + 1e-6f);
                *(u32x4*)(KN + (size_t)row * 1280 + t * 128 + wc * 32 + 8 * fq) = pack8(acc[ai][0][m][0] * rs, acc[ai][0][m][1] * rs);
                *(u32x4*)(VV + (size_t)row * 1280 + t * 128 + wc * 32 + 8 * fq) = pack8(acc[ai][1][m][0] * rs, acc[ai][1][m][1] * rs);
            }
    }
};

#if XR_BF16
struct EpiRes {
    static constexpr bool PERM = true, AFTER_DRAIN = false;
    const bf16_t* res; bf16_t* out; float s;
    const float* st; const float* g; const float* b;
    __device__ __forceinline__ void operator()(const f32x4 (&acc)[2][2][4][2], const Unit& u, int wr, int wc, int fr, int fq) const {
        const int row0 = u.pm * BM + wr * 64 + fr, col0 = u.pn * BM + wc * 32 + 8 * fq;
        if (st) {
            f32x2 ms[2][4];
#pragma unroll
            for (int ai = 0; ai < 2; ++ai)
#pragma unroll
                for (int m = 0; m < 4; ++m) ms[ai][m] = *(const f32x2*)(st + 2 * (row0 + ai * HALF + m * 16));
#pragma unroll
            for (int bj = 0; bj < 2; ++bj) {
                const int cc = col0 + bj * HALF;
                const f32x4 g0 = *(const f32x4*)(g + cc), g1 = *(const f32x4*)(g + cc + 4), b0 = *(const f32x4*)(b + cc), b1 = *(const f32x4*)(b + cc + 4);
                u32x4 r[2][4];
#pragma unroll
                for (int ai = 0; ai < 2; ++ai)
#pragma unroll
                    for (int m = 0; m < 4; ++m) r[ai][m] = *(const u32x4*)(res + (size_t)(row0 + ai * HALF + m * 16) * 2048 + cc);
#pragma unroll
                for (int ai = 0; ai < 2; ++ai)
#pragma unroll
                    for (int m = 0; m < 4; ++m) { const float mu = ms[ai][m][0], rr = ms[ai][m][1];
                        const f32x4 x0 = (res4(r[ai][m].x, r[ai][m].y) - mu) * rr * g0 + b0, x1 = (res4(r[ai][m].z, r[ai][m].w) - mu) * rr * g1 + b1;
                        *(u32x4*)(out + (size_t)(row0 + ai * HALF + m * 16) * 2048 + cc) = res_pack8(x0 * ALPHA_RES + acc[ai][bj][m][0] * s, x1 * ALPHA_RES + acc[ai][bj][m][1] * s); }
            }
        } else {
            u32x4 r[2][2][4];
#pragma unroll
            for (int bj = 0; bj < 2; ++bj)
#pragma unroll
                for (int ai = 0; ai < 2; ++ai)
#pragma unroll
                    for (int m = 0; m < 4; ++m) r[bj][ai][m] = *(const u32x4*)(res + (size_t)(row0 + ai * HALF + m * 16) * 2048 + col0 + bj * HALF);
#pragma unroll
            for (int bj = 0; bj < 2; ++bj)
#pragma unroll
                for (int ai = 0; ai < 2; ++ai)
#pragma unroll
                    for (int m = 0; m < 4; ++m) { const u32x4 w = r[bj][ai][m];
                        *(u32x4*)(out + (size_t)(row0 + ai * HALF + m * 16) * 2048 + col0 + bj * HALF) = res_pack8(bf4(w.x, w.y) * ALPHA_RES + acc[ai][bj][m][0] * s, bf4(w.z, w.w) * ALPHA_RES + acc[ai][bj][m][1] * s); }
        }
    }
};
#else
struct EpiRes {
    static constexpr bool PERM = true, AFTER_DRAIN = false;
    const float* res; float* out; float s;
    const float* st; const float* g; const float* b;
    __device__ __forceinline__ void operator()(const f32x4 (&acc)[2][2][4][2], const Unit& u, int wr, int wc, int fr, int fq) const {
        const int row0 = u.pm * BM + wr * 64 + fr, col0 = u.pn * BM + wc * 32 + 8 * fq;
        if (st) {
#pragma unroll
            for (int bj = 0; bj < 2; ++bj) {
                const int cc = col0 + bj * HALF;
                const f32x4 g0 = *(const f32x4*)(g + cc), g1 = *(const f32x4*)(g + cc + 4), b0 = *(const f32x4*)(b + cc), b1 = *(const f32x4*)(b + cc + 4);
#pragma unroll
                for (int ai = 0; ai < 2; ++ai) {
                    f32x4 r0[4], r1[4]; f32x2 ms[4];
#pragma unroll
                    for (int m = 0; m < 4; ++m) { const size_t p = (size_t)(row0 + ai * HALF + m * 16) * 2048 + cc; r0[m] = *(const f32x4*)(res + p); r1[m] = *(const f32x4*)(res + p + 4); }
#pragma unroll
                    for (int m = 0; m < 4; ++m) ms[m] = *(const f32x2*)(st + 2 * (row0 + ai * HALF + m * 16));
#pragma unroll
                    for (int m = 0; m < 4; ++m) {
                        const size_t p = (size_t)(row0 + ai * HALF + m * 16) * 2048 + cc; const float mu = ms[m][0], rr = ms[m][1];
                        const f32x4 x0 = (r0[m] - mu) * rr * g0 + b0, x1 = (r1[m] - mu) * rr * g1 + b1;
                        *(f32x4*)(out + p) = x0 * ALPHA_RES + acc[ai][bj][m][0] * s; *(f32x4*)(out + p + 4) = x1 * ALPHA_RES + acc[ai][bj][m][1] * s;
                    }
                }
            }
        } else {
            f32x4 r0[4], r1[4];
#define EPIRES_LOAD(k) { const int cc = col0 + ((k) >> 1) * HALF, rb = row0 + ((k) & 1) * HALF; \
                _Pragma("unroll") for (int m = 0; m < 4; ++m) { const size_t p = (size_t)(rb + m * 16) * 2048 + cc; r0[m] = *(const f32x4*)(res + p); r1[m] = *(const f32x4*)(res + p + 4); } }
            EPIRES_LOAD(0)
#pragma unroll
            for (int k = 0; k < 4; ++k) {
                const int bj = k >> 1, ai = k & 1, cc = col0 + bj * HALF, rb = row0 + ai * HALF;
                f32x4 o0[4], o1[4];
#pragma unroll
                for (int m = 0; m < 4; ++m) { o0[m] = r0[m] * ALPHA_RES + acc[ai][bj][m][0] * s; o1[m] = r1[m] * ALPHA_RES + acc[ai][bj][m][1] * s; }
                if (k < 3) EPIRES_LOAD(k + 1)
#pragma unroll
                for (int m = 0; m < 4; ++m) { const size_t p = (size_t)(rb + m * 16) * 2048 + cc; *(f32x4*)(out + p) = o0[m]; *(f32x4*)(out + p + 4) = o1[m]; }
            }
#undef EPIRES_LOAD
        }
    }
};

#endif

struct EpiSwiglu {
    static constexpr bool PERM = true, AFTER_DRAIN = false;
    bf16_t* O; int ldc; int row_off; float s;
    __device__ __forceinline__ f32x4 sw(f32x4 g, f32x4 uu) const {
        const float c1 = -1.4426950408889634f * s, K = 1.0f / (s * s);
        const f32x4 t = g * c1; f32x4 e, r;
#pragma unroll
        for (int j = 0; j < 4; ++j) e[j] = __builtin_amdgcn_exp2f(t[j]);
        const f32x4 d = e * K + K;
#pragma unroll
        for (int j = 0; j < 4; ++j) r[j] = __builtin_amdgcn_rcpf(d[j]);
        return (g * uu) * r; }
    __device__ __forceinline__ void operator()(const f32x4 (&acc)[2][2][4][2], const Unit& u, int wr, int wc, int fr, int fq) const {
        const int row0 = u.pm * BM + wr * 64 + fr - row_off, col0 = u.pn * HALF + wc * 32 + 8 * fq;
#pragma unroll
        for (int ai = 0; ai < 2; ++ai)
#pragma unroll
            for (int m = 0; m < 4; ++m)
                *(u32x4*)(O + (size_t)(row0 + ai * HALF + m * 16) * ldc + col0) = pack8(sw(acc[ai][0][m][0], acc[ai][1][m][0]), sw(acc[ai][0][m][1], acc[ai][1][m][1]));
    }
};

struct EpiPlain {
    static constexpr bool PERM = true, AFTER_DRAIN = false;
    bf16_t* O; int ldc; int split_cols; size_t split_stride; float s;
    unsigned* maxp;
    __device__ __forceinline__ void operator()(const f32x4 (&acc)[2][2][4][2], const Unit& u, int wr, int wc, int fr, int fq) const {
        const int row0 = u.pm * BM + wr * 64 + fr; int colt = u.pn * BM; bf16_t* base = O;
        if (split_cols) { const int t = colt / split_cols; base += (size_t)t * split_stride; colt -= t * split_cols; }
        const int col0 = colt + wc * 32 + 8 * fq;
        float mx0 = 0.f, mx1 = 0.f; unsigned* const mp = maxp; const bool domax = (mp != nullptr) && split_cols != 0 && (u.pn * BM) < 2 * split_cols;
#pragma unroll
        for (int ai = 0; ai < 2; ++ai)
#pragma unroll
            for (int m = 0; m < 4; ++m) {
                { const f32x4 a = acc[ai][0][m][0] * s, b = acc[ai][0][m][1] * s;
                  *(u32x4*)(base + (size_t)(row0 + ai * HALF + m * 16) * ldc + col0) = pack8(a, b);
                  if (domax) { float q = sq4(a) + sq4(b); q = xsum16(q); q = xsum32(q); mx0 = fmaxf(mx0, q); } }
                { const f32x4 a = acc[ai][1][m][0] * s, b = acc[ai][1][m][1] * s;
                  *(u32x4*)(base + (size_t)(row0 + ai * HALF + m * 16) * ldc + col0 + HALF) = pack8(a, b);
                  if (domax) { float q = sq4(a) + sq4(b); q = xsum16(q); q = xsum32(q); mx1 = fmaxf(mx1, q); } }
            }
        if (domax) {
            const int t = (u.pn * BM) / split_cols;
            mx0 = row16_max(mx0); mx1 = row16_max(mx1);
            if (fr == 0 && fq == 0) { unsigned* d = mp + (t * 2 + (u.pm * BM) / 8192) * 16 + (colt / 128);
                atomicMax(d, __float_as_uint(mx0)); atomicMax(d + 1, __float_as_uint(mx1)); }
        }
    }
};

constexpr float W8_SCALE = 64.f, H8_SCALE = 16.f;
__device__ __forceinline__ unsigned pk4_fp8(float a, float b, float c, float d) { int p = __builtin_amdgcn_cvt_pk_fp8_f32(a, b, 0, false); p = __builtin_amdgcn_cvt_pk_fp8_f32(c, d, p, true); return (unsigned)p; }
struct EpiSwiglu8 {
    static constexpr bool PERM = true, AFTER_DRAIN = false;
    unsigned char* O; int ldc;
#ifdef OLD_SW
    __device__ __forceinline__ f32x4 sw(f32x4 g, f32x4 uu) const { f32x4 r;
#pragma unroll
        for (int j = 0; j < 4; ++j) { const float gg = g[j] * (1.f / W8_SCALE); r[j] = gg * __builtin_amdgcn_rcpf(1.0f + __builtin_amdgcn_exp2f(-1.4426950408889634f * gg)) * (uu[j] * (H8_SCALE / W8_SCALE)); }
        return r; }
#else
    static __device__ __forceinline__ f32x2 pk_mul2(f32x2 a, f32x2 b) { f32x2 d; asm("v_pk_mul_f32 %0, %1, %2" : "=v"(d) : "v"(a), "v"(b)); return d; }
    __device__ __forceinline__ f32x4 sw(f32x4 g, f32x4 uu) const {
        constexpr float C1 = -1.4426950408889634f / W8_SCALE, K = W8_SCALE * W8_SCALE / H8_SCALE;
        const f32x2 c1 = {C1, C1}; const f32x2 t0 = pk_mul2(g.xy, c1), t1 = pk_mul2(g.zw, c1);
        const f32x4 e = {__builtin_amdgcn_exp2f(t0[0]), __builtin_amdgcn_exp2f(t0[1]), __builtin_amdgcn_exp2f(t1[0]), __builtin_amdgcn_exp2f(t1[1])};
        const f32x4 d = e * K + K; f32x4 r;
#pragma unroll
        for (int j = 0; j < 4; ++j) r[j] = __builtin_amdgcn_rcpf(d[j]);
        return (g * uu) * r; }
#endif
    __device__ __forceinline__ void operator()(const f32x4 (&acc)[2][2][4][2], const Unit& u, int wr, int wc, int fr, int fq) const {
        const int row0 = u.pm * BM + wr * 64 + fr, col0 = u.pn * HALF + wc * 32 + 8 * fq;
#pragma unroll
        for (int ai = 0; ai < 2; ++ai)
#pragma unroll
            for (int m = 0; m < 4; ++m) { const f32x4 a = sw(acc[ai][0][m][0], acc[ai][1][m][0]), b = sw(acc[ai][0][m][1], acc[ai][1][m][1]);
                typedef unsigned u32x2 __attribute__((ext_vector_type(2)));
                u32x2 w; w.x = pk4_fp8(a[0], a[1], a[2], a[3]); w.y = pk4_fp8(b[0], b[1], b[2], b[3]);
                *(u32x2*)(O + (size_t)(row0 + ai * HALF + m * 16) * ldc + col0) = w; }
    }
};
struct EpiPlainS {
    static constexpr bool PERM = true, AFTER_DRAIN = false;
    bf16_t* O; int ldc; float s; bf16_t* O2; int row2;
    __device__ __forceinline__ void operator()(const f32x4 (&acc)[2][2][4][2], const Unit& u, int wr, int wc, int fr, int fq) const {
        const int row0 = u.pm * BM + wr * 64 + fr - (u.kh ? row2 : 0), col0 = u.pn * BM + wc * 32 + 8 * fq; bf16_t* const O = u.kh ? this->O2 : this->O;
#pragma unroll
        for (int ai = 0; ai < 2; ++ai)
#pragma unroll
            for (int m = 0; m < 4; ++m)
#pragma unroll
                for (int bj = 0; bj < 2; ++bj) *(u32x4*)(O + (size_t)(row0 + ai * HALF + m * 16) * ldc + col0 + bj * HALF) = pack8(acc[ai][bj][m][0] * s, acc[ai][bj][m][1] * s);
    }
};
template <class Epi, class Sched, bool ALIGN_EPI = false, bool SP2 = false, bool F8 = false, int PROBE = 0>
__device__ __forceinline__ void gemm_phase(PG8_LAS unsigned char* lds, const Gemm g, const Sched& S, const Epi& E) {
    const int tid = threadIdx.x, wid = __builtin_amdgcn_readfirstlane(tid >> 6), lane = tid & 63, wr = wid >> 2, wc = wid & 3, fr = lane & 15, fq = lane >> 4;
    const int K = g.K, nt = (g.Kl ? g.Kl : K) / BK;
    unsigned voffA[2], voffB[2];
    constexpr bool GATHER = Sched::GATHER; static_assert(!GATHER || SP2, "the gathered A operand is written for the SP2 loop only");
    int rowA[2]; unsigned colA[2];
#pragma unroll
    for (int i = 0; i < 2; ++i) { int R, C; stage_rc(tid * 16 + i * 8192, R, C); const int Rb = Epi::PERM ? ((R & ~31) + perm32(R & 31)) : R;
        voffA[i] = (unsigned)(R * K + C) * 2u; voffB[i] = (unsigned)(Rb * K + C) * 2u; rowA[i] = R; colA[i] = (unsigned)C * 2u; }
    unsigned gA[2][2] = {{0u, 0u}, {0u, 0u}}, gN[2][2] = {{0u, 0u}, {0u, 0u}}; const unsigned rowbytes = (unsigned)K * 2u;
    constexpr int IDX_OFF = 131072 + 8192;
#define PG8_STAGE_A(bufoff, h, base_, gk_, goffs_) do { if constexpr (GATHER) { PG8_STAGE(bufoff, (const char*)g.A + (gk_), goffs_[h]); } else { PG8_STAGE(bufoff, base_, voffA); } } while (0)
    const size_t kstep = (size_t)(BK * 2);
    const size_t hstep = (size_t)HALF * K * 2;
    const size_t tstep = 2 * hstep;
    const unsigned ldsw = (unsigned)wid * 1024u;
    const int aoff = lds_byte(wr * 64 + fr, fq * 8), boff = lds_byte(wc * 32 + fr, fq * 8);
#define PG8_SA(b, h) (((b) * 2 + (h)) * HTB)
#define PG8_SB(b, h) ((4 + (b) * 2 + (h)) * HTB)
#define PG8_STAGE(bufoff, gbase, voff) do { _Pragma("unroll") for (int _i = 0; _i < 2; ++_i) \
        __builtin_amdgcn_global_load_lds((const unsigned*)((const char*)(gbase) + (voff)[_i]), (PG8_LAS unsigned*)(lds + (bufoff) + ldsw + _i * 8192), 16, 0, 0); } while (0)
#define PG8_LDA(dst, b, h) do { _Pragma("unroll") for (int m = 0; m < 4; ++m) _Pragma("unroll") for (int k = 0; k < 2; ++k) dst[m][k] = *(const PG8_LAS bf16x8*)(lds + PG8_SA(b, h) + aoff + m * 2048 + k * 1024); } while (0)
#define PG8_LDB(dst, b, h) do { _Pragma("unroll") for (int n = 0; n < 2; ++n) _Pragma("unroll") for (int k = 0; k < 2; ++k) dst[n][k] = *(const PG8_LAS bf16x8*)(lds + PG8_SB(b, h) + boff + n * 2048 + k * 1024); } while (0)
#define PG8_MMA(ai, bj, At, Bt) do { __builtin_amdgcn_s_setprio(1); if constexpr (F8) { _Pragma("unroll") for (int m = 0; m < 4; ++m) _Pragma("unroll") for (int n = 0; n < 2; ++n) \
        mfma8(acc[ai][bj][m][n], cat8(Bt[n][0], Bt[n][1]), cat8(At[m][0], At[m][1])); } else { \
        _Pragma("unroll") for (int m = 0; m < 4; ++m) _Pragma("unroll") for (int n = 0; n < 2; ++n) _Pragma("unroll") for (int k = 0; k < 2; ++k) \
        acc[ai][bj][m][n] = __builtin_amdgcn_mfma_f32_16x16x32_bf16(Bt[n][k], At[m][k], acc[ai][bj][m][n], 0, 0, 0); } __builtin_amdgcn_s_setprio(0); } while (0)
#define PG8_WAIT_V(n) asm volatile("s_waitcnt vmcnt(" #n ")" ::: "memory")
#define PG8_WAIT_L(n) asm volatile("s_waitcnt lgkmcnt(" #n ")" ::: "memory")
#define PG8_BAR __builtin_amdgcn_s_barrier()
#define PG8_SCHED __builtin_amdgcn_sched_barrier(0)
    Unit cur, nxt; int ui = 0;
    if (!S.next(0, cur)) return;
    f32x4 acc[2][2][4][2];
#pragma unroll
    for (int a = 0; a < 2; ++a)
#pragma unroll
        for (int b = 0; b < 2; ++b)
#pragma unroll
            for (int m = 0; m < 4; ++m)
#pragma unroll
                for (int n = 0; n < 2; ++n) acc[a][b][m][n] = (f32x4){0.f, 0.f, 0.f, 0.f};
    bf16x8 At[4][2], B0[2][2], B1[2][2];
    unsigned pb_t = 0u, pb_acc = 0u; bool pb_open = false;
    if constexpr (PROBE == 2) pb_t = (unsigned)__builtin_amdgcn_s_memrealtime();
    const char* cA = (const char*)g.A + (size_t)cur.pm * tstep + S.aoff(cur); const char* cB = S.bbase(g, cur) + (size_t)cur.pn * tstep;
    S.a_ready(cur);
    if constexpr (GATHER) {
#pragma unroll
        for (int h = 0; h < 2; ++h)
#pragma unroll
            for (int i = 0; i < 2; ++i) gA[h][i] = (unsigned)S.rowidx[cur.pm * 256 + h * HALF + rowA[i]] * rowbytes + colA[i];
    }
    if constexpr (SP2) {
        PG8_STAGE(PG8_SB(0, 0), cB, voffB); PG8_STAGE(PG8_SB(0, 1), cB + hstep, voffB); PG8_STAGE_A(PG8_SA(0, 0), 0, cA, (size_t)0, gA); PG8_STAGE_A(PG8_SA(0, 1), 1, cA + hstep, (size_t)0, gA);
        if (wr == 1) PG8_BAR;
        PG8_WAIT_V(2); PG8_BAR;
        PG8_STAGE(PG8_SB(1, 0), cB + kstep, voffB); PG8_STAGE_A(PG8_SA(1, 0), 0, cA + kstep, kstep, gA); PG8_STAGE(PG8_SB(1, 1), cB + hstep + kstep, voffB);
        PG8_WAIT_V(6); PG8_BAR;
    } else {
        PG8_STAGE(PG8_SB(0, 0), cB, voffB); PG8_STAGE(PG8_SA(0, 0), cA, voffA); PG8_STAGE(PG8_SB(0, 1), cB + hstep, voffB); PG8_STAGE(PG8_SA(0, 1), cA + hstep, voffA);
        if (wr == 1) PG8_BAR;
        PG8_WAIT_V(4); PG8_BAR;
        PG8_STAGE(PG8_SB(1, 0), cB + kstep, voffB); PG8_STAGE(PG8_SA(1, 0), cA + kstep, voffA); PG8_STAGE(PG8_SB(1, 1), cB + hstep + kstep, voffB);
        PG8_WAIT_V(6); PG8_BAR;
    }
    for (;;) {
        const bool has_next = S.next(ui + 1, nxt);
        if constexpr (GATHER) { if (has_next && wid == 0) __builtin_amdgcn_global_load_lds((const unsigned*)(S.rowidx + nxt.pm * 256 + lane * 4), (PG8_LAS unsigned*)(lds + IDX_OFF + ((ui + 1) & 1) * 1024), 16, 0, 0); }
        const char* nA = has_next ? (const char*)g.A + (size_t)nxt.pm * tstep + S.aoff(nxt) : cA; const char* nB = has_next ? S.bbase(g, nxt) + (size_t)nxt.pn * tstep : cB;
        for (int t = 0; t < nt; t += 2) {
            const bool last = (t == nt - 2);
            const char* a1 = cA + (size_t)(t + 1) * kstep;
            const char* a2 = last ? nA : cA + (size_t)(t + 2) * kstep; const char* b2 = last ? nB : cB + (size_t)(t + 2) * kstep;
            const char* a3 = a2 + kstep; const char* b3 = b2 + kstep;
            if (last && has_next) S.a_ready(nxt);
            unsigned g2[2][2]; size_t gk2 = 0;
            if constexpr (GATHER) {
                if (last) {
                    if (has_next) { const PG8_LAS int* ib = (const PG8_LAS int*)(lds + IDX_OFF + ((ui + 1) & 1) * 1024);
#pragma unroll
                        for (int h = 0; h < 2; ++h)
#pragma unroll
                            for (int i = 0; i < 2; ++i) gN[h][i] = (unsigned)ib[h * HALF + rowA[i]] * rowbytes + colA[i]; }
                    else {
#pragma unroll
                        for (int h = 0; h < 2; ++h)
#pragma unroll
                            for (int i = 0; i < 2; ++i) gN[h][i] = gA[h][i]; }
                }
                gk2 = last ? (size_t)0 : (size_t)(t + 2) * kstep;
#pragma unroll
                for (int h = 0; h < 2; ++h)
#pragma unroll
                    for (int i = 0; i < 2; ++i) g2[h][i] = last ? gN[h][i] : gA[h][i];
            }
            if constexpr (SP2) {
            PG8_LDB(B0, 0, 0); PG8_LDB(B1, 0, 1); PG8_SCHED; PG8_LDA(At, 0, 0); PG8_STAGE_A(PG8_SA(1, 1), 1, a1 + hstep, (size_t)(t + 1) * kstep, gA);
            PG8_WAIT_V(8); PG8_WAIT_L(0); PG8_BAR;
            if constexpr (PROBE == 1) { if (t == 0 && pb_open) { pb_acc += (unsigned)__builtin_amdgcn_s_memrealtime() - pb_t; pb_open = false; } }
            PG8_MMA(0, 0, At, B0); PG8_MMA(0, 1, At, B1); PG8_BAR; PG8_SCHED;
            PG8_LDA(At, 0, 1); PG8_STAGE(PG8_SB(0, 0), b2, voffB); PG8_STAGE(PG8_SB(0, 1), b2 + hstep, voffB); PG8_STAGE_A(PG8_SA(0, 0), 0, a2, gk2, g2);
            PG8_WAIT_V(8); PG8_WAIT_L(0); PG8_BAR; PG8_MMA(1, 0, At, B0); PG8_MMA(1, 1, At, B1); PG8_BAR; PG8_SCHED;
            PG8_LDB(B0, 1, 0); PG8_LDB(B1, 1, 1); PG8_SCHED; PG8_LDA(At, 1, 0); PG8_STAGE_A(PG8_SA(0, 1), 1, a2 + hstep, gk2, g2);
            PG8_WAIT_V(8); PG8_WAIT_L(0); PG8_BAR; PG8_MMA(0, 0, At, B0); PG8_MMA(0, 1, At, B1); PG8_BAR; PG8_SCHED;
            PG8_LDA(At, 1, 1); PG8_STAGE(PG8_SB(1, 0), b3, voffB); PG8_STAGE(PG8_SB(1, 1), b3 + hstep, voffB); PG8_STAGE_A(PG8_SA(1, 0), 0, a3, gk2 + kstep, g2);
            PG8_WAIT_V(8); PG8_WAIT_L(0); PG8_BAR; PG8_MMA(1, 0, At, B0); PG8_MMA(1, 1, At, B1); PG8_BAR; PG8_SCHED;
            } else {
            PG8_LDB(B0, 0, 0); PG8_SCHED; PG8_LDA(At, 0, 0); PG8_STAGE(PG8_SA(1, 1), a1 + hstep, voffA);
            PG8_WAIT_L(8); PG8_BAR; PG8_WAIT_L(0); PG8_MMA(0, 0, At, B0); PG8_BAR; PG8_SCHED;
            PG8_LDB(B1, 0, 1); PG8_STAGE(PG8_SB(0, 0), b2, voffB);
            PG8_BAR; PG8_WAIT_L(0); PG8_MMA(0, 1, At, B1); PG8_BAR;
            PG8_LDA(At, 0, 1); PG8_STAGE(PG8_SA(0, 0), a2, voffA);
            PG8_BAR; PG8_WAIT_L(0); PG8_MMA(1, 0, At, B0); PG8_BAR; PG8_SCHED;
            PG8_STAGE(PG8_SB(0, 1), b2 + hstep, voffB);
            PG8_WAIT_V(6); PG8_BAR; PG8_MMA(1, 1, At, B1); PG8_BAR;
            PG8_LDB(B0, 1, 0); PG8_SCHED; PG8_LDA(At, 1, 0); PG8_STAGE(PG8_SA(0, 1), a2 + hstep, voffA);
            PG8_WAIT_L(8); PG8_BAR; PG8_WAIT_L(0); PG8_MMA(0, 0, At, B0); PG8_BAR; PG8_SCHED;
            PG8_LDB(B1, 1, 1); PG8_STAGE(PG8_SB(1, 0), b3, voffB);
            PG8_BAR; PG8_WAIT_L(0); PG8_MMA(0, 1, At, B1); PG8_BAR;
            PG8_LDA(At, 1, 1); PG8_STAGE(PG8_SA(1, 0), a3, voffA);
            PG8_BAR; PG8_WAIT_L(0); PG8_MMA(1, 0, At, B0); PG8_BAR; PG8_SCHED;
            PG8_STAGE(PG8_SB(1, 1), b3 + hstep, voffB);
            PG8_WAIT_V(6); PG8_BAR; PG8_MMA(1, 1, At, B1); PG8_BAR;
            }
        }
        if constexpr (PROBE == 1) { pb_t = (unsigned)__builtin_amdgcn_s_memrealtime(); pb_open = true; }
        if constexpr (ALIGN_EPI) { if (wr == 0) PG8_BAR; }
        if constexpr (F8) { asm volatile("s_nop 15\n\ts_nop 15" ::: "memory"); PG8_SCHED; }
        if constexpr (PROBE == 3) pb_t = (unsigned)__builtin_amdgcn_s_memrealtime();
        if constexpr (!Epi::AFTER_DRAIN) { E(acc, cur, wr, wc, fr, fq); S.done(cur); }
        if constexpr (PROBE == 3) { asm volatile("" ::: "memory"); pb_acc += (unsigned)__builtin_amdgcn_s_memrealtime() - pb_t; }
        if (!has_next) break;
#pragma unroll
        for (int a = 0; a < 2; ++a)
#pragma unroll
            for (int b = 0; b < 2; ++b)
#pragma unroll
                for (int m = 0; m < 4; ++m)
#pragma unroll
                    for (int n = 0; n < 2; ++n) acc[a][b][m][n] = (f32x4){0.f, 0.f, 0.f, 0.f};
        cur = nxt; cA = nA; cB = nB; ++ui;
        if constexpr (GATHER) {
#pragma unroll
            for (int h = 0; h < 2; ++h)
#pragma unroll
                for (int i = 0; i < 2; ++i) gA[h][i] = gN[h][i]; }
        if constexpr (ALIGN_EPI) { if (wr == 1) PG8_BAR; }
    }
    PG8_WAIT_V(0);
    if constexpr (!ALIGN_EPI) { if (wr == 0) PG8_BAR; }
    PG8_BAR;
    if constexpr (Epi::AFTER_DRAIN) { E.fused(acc, cur, wr, wc, fr, fq, lds, wid, lane); S.done(cur); }
    if constexpr (PROBE != 0) { const unsigned now = (unsigned)__builtin_amdgcn_s_memrealtime(); if (PROBE == 2 || (PROBE == 1 && pb_open)) pb_acc += now - pb_t;
        if (tid == 0) *(volatile PG8_LAS unsigned*)(lds + 131072 + 320 + 128) = pb_acc; }
#undef PG8_SA
#undef PG8_SB
#undef PG8_STAGE
#undef PG8_STAGE_A
#undef PG8_LDA
#undef PG8_LDB
#undef PG8_MMA
#undef PG8_WAIT_V
#undef PG8_WAIT_L
#undef PG8_BAR
#undef PG8_SCHED
}
}


namespace att {
typedef unsigned short bf16;
typedef short bf16x8 __attribute__((ext_vector_type(8)));
typedef short s16x4 __attribute__((ext_vector_type(4)));
typedef float f32x16 __attribute__((ext_vector_type(16)));
typedef float f32x4 __attribute__((ext_vector_type(4)));
typedef unsigned u32x4 __attribute__((ext_vector_type(4)));
constexpr int NW = 8, QBLK = 32, KVBLK = 64, QB = NW * QBLK, D = 128;
constexpr int SHM_V = KVBLK * D * 2, SHM_K = KVBLK * D * 2, K2P = 144, SHM_K2 = KVBLK * K2P;
constexpr int OFF_V = 0, OFF_K = 2 * SHM_V, OFF_K2 = OFF_K + 2 * SHM_K, OFF_KB = OFF_K2 + 2 * SHM_K2, OFF_WS = OFF_KB + 2 * 64 * 4, LDS_BYTES = OFF_WS + NW * 64 * 4;
constexpr float THR = 8.f;
#ifndef ATT_PRIO
#define ATT_PRIO 1
#endif
template <int MODE> struct Cfg { static constexpr float SCALE = (MODE == 2) ? 0.07216878364870322f : 0.08838834764831845f; static constexpr bool SK = (MODE == 0); };

#define KSWZ(row, colB) ((row) * 256 + ((colB) ^ (((row) & 7) << 4)))
#define SBAR() __builtin_amdgcn_sched_barrier(0)
__device__ __forceinline__ int v_st(int k, int c) { const int kk = (k & ~0xC) | ((k & 4) << 1) | ((k & 8) >> 1); return ((kk >> 3) * 4 + (c >> 5)) * 512 + ((kk & 7) * 32 + (c & 31)) * 2; }
__device__ __forceinline__ int v_rd_base(int lane) { return ((lane & 3) << 3) | (((lane >> 2) & 3) << 6) | (((lane >> 4) & 1) << 5) | (((lane >> 5) & 1) << 8); }
constexpr int v_rd_off(int d0, int ks, int half) { return d0 * 512 + ks * 4096 + half * 2048; }
__device__ __forceinline__ int crow(int r, int hi) { return (r & 3) + 8 * (r >> 2) + 4 * hi; }
__device__ __forceinline__ unsigned cvtpk(float lo, float hi) { unsigned r; asm volatile("v_cvt_pk_bf16_f32 %0, %1, %2" : "=v"(r) : "v"(lo), "v"(hi)); return r; }
__device__ __forceinline__ bf16x8 load8(const bf16* p) { return *reinterpret_cast<const bf16x8*>(p); }
__device__ __forceinline__ void mask_tile(f32x16& p0, f32x16& p1, int dq, unsigned W) {
    const float NEG = -__builtin_inff();
#pragma unroll
    for (int r = 0; r < 16; ++r) {
        const int c = (r & 3) + 8 * (r >> 2);
        if ((unsigned)(dq - c) >= W) p0[r] = NEG;
        if ((unsigned)(dq - c - 32) >= W) p1[r] = NEG;
    }
}
template <int MODE>
__device__ __forceinline__ void partialSM(f32x16& p0, f32x16& p1, float& m_reg, float& mn, float& alpha) {
    constexpr float SCALE = Cfg<MODE>::SCALE;
    float pmax = p0[0];
#pragma unroll
    for (int r = 1; r < 16; ++r) pmax = fmaxf(pmax, p0[r]);
#pragma unroll
    for (int r = 0; r < 16; ++r) pmax = fmaxf(pmax, p1[r]);
    { auto rr = __builtin_amdgcn_permlane32_swap(__float_as_uint(pmax), __float_as_uint(pmax), false, false);
      pmax = fmaxf(__uint_as_float(rr[0]), __uint_as_float(rr[1])); }
    constexpr float C2 = 1.4426950408889634f * SCALE;
    if (__builtin_expect(__all((pmax - m_reg) * SCALE <= THR), 1)) { mn = m_reg; alpha = 1.f; }
    else { mn = fmaxf(m_reg, pmax); alpha = __builtin_amdgcn_exp2f((m_reg - mn) * C2); m_reg = mn; }
    const float mnL = -mn * C2;
    p0 = p0 * C2 + mnL; p1 = p1 * C2 + mnL;
#pragma unroll
    for (int r = 0; r < 16; ++r) p0[r] = __builtin_amdgcn_exp2f(p0[r]);
}
__device__ __forceinline__ void finishSM(f32x16& p0, f32x16& p1, float alpha, float& l_reg, bf16x8& pa0, bf16x8& pa1, bf16x8& pa2, bf16x8& pa3) {
#pragma unroll
    for (int r = 0; r < 16; ++r) p1[r] = __builtin_amdgcn_exp2f(p1[r]);
    float ps;
    { typedef float f32x8 __attribute__((ext_vector_type(8))); typedef float f32x4_ __attribute__((ext_vector_type(4))); typedef float f32x2_ __attribute__((ext_vector_type(2)));
      const f32x16 s16 = p0 + p1; const f32x8 s8 = s16.lo + s16.hi; const f32x4_ s4 = s8.lo + s8.hi; const f32x2_ s2 = s4.lo + s4.hi; ps = s2[0] + s2[1]; }
    { auto rr = __builtin_amdgcn_permlane32_swap(__float_as_uint(ps), __float_as_uint(ps), false, false);
      ps = __uint_as_float(rr[0]) + __uint_as_float(rr[1]); }
    l_reg = l_reg * alpha + ps;
#define PK4(P, B_, OUT) do { unsigned a0 = cvtpk(P[B_+0], P[B_+1]), a1 = cvtpk(P[B_+2], P[B_+3]);                          \
        unsigned b0 = cvtpk(P[B_+4], P[B_+5]), b1 = cvtpk(P[B_+6], P[B_+7]);                                             \
        auto r0 = __builtin_amdgcn_permlane32_swap(a0, b0, false, false); auto r1 = __builtin_amdgcn_permlane32_swap(a1, b1, false, false); \
        u32x4 w = {r0[0], r1[0], r0[1], r1[1]}; OUT = *reinterpret_cast<bf16x8*>(&w); } while (0)
    PK4(p0, 0, pa0); PK4(p0, 8, pa1); PK4(p1, 0, pa2); PK4(p1, 8, pa3);
#undef PK4
}
template <int KB, int MODE>
__device__ __forceinline__ void qkt(f32x16& p0, f32x16& p1, const char* lds, int r32, int hi, const bf16x8* qr, const bf16x8* qr2, bool act) {
    constexpr bool SK = Cfg<MODE>::SK;
    if (SK && !act) { const float NEG = -__builtin_inff();
#pragma unroll
        for (int r = 0; r < 16; ++r) { p0[r] = NEG; p1[r] = NEG; } return; }
    p0 = f32x16{}; p1 = f32x16{};
    const char* kb[4];
#pragma unroll
    for (int dd = 0; dd < 4; ++dd) kb[dd] = lds + OFF_K + KB * SHM_K + KSWZ(r32, (dd * 16 + hi * 8) * 2);
    __builtin_amdgcn_s_setprio(ATT_PRIO);
#pragma unroll
    for (int d0 = 0; d0 < 8; ++d0) { const char* a = kb[d0 & 3] + (d0 >> 2) * 128;
        bf16x8 b0 = *reinterpret_cast<const bf16x8*>(a);
        bf16x8 b1 = *reinterpret_cast<const bf16x8*>(a + 32 * 256);
        p0 = __builtin_amdgcn_mfma_f32_32x32x16_bf16(b0, qr[d0], p0, 0, 0, 0);
        p1 = __builtin_amdgcn_mfma_f32_32x32x16_bf16(b1, qr[d0], p1, 0, 0, 0); }
    if constexpr (MODE == 2) {
        const char* k2 = lds + OFF_K2 + KB * SHM_K2 + r32 * K2P + hi * 16;
#pragma unroll
        for (int d0 = 0; d0 < 4; ++d0) {
            bf16x8 b0 = *reinterpret_cast<const bf16x8*>(k2 + d0 * 32);
            bf16x8 b1 = *reinterpret_cast<const bf16x8*>(k2 + d0 * 32 + 32 * K2P);
            p0 = __builtin_amdgcn_mfma_f32_32x32x16_bf16(b0, qr2[d0], p0, 0, 0, 0);
            p1 = __builtin_amdgcn_mfma_f32_32x32x16_bf16(b1, qr2[d0], p1, 0, 0, 0); }
    }
    __builtin_amdgcn_s_setprio(0);
}
template <int VB, bool SK>
__device__ __forceinline__ void pv_tile(f32x16* o, int vb0, bf16x8 pa0, bf16x8 pa1, bf16x8 pa2, bf16x8 pa3, bool act) {
    if (SK && !act) return;
    __builtin_amdgcn_s_setprio(ATT_PRIO);
#define TRRD(dst, off) asm volatile("ds_read_b64_tr_b16 %0, %1 offset:%2" : "=&v"(dst) : "v"(vb0), "i"(off) : "memory")
#define PV_D0(d0) do { s16x4 l0, l1, l2, l3, h0, h1, h2, h3; constexpr int b_ = OFF_V + VB * SHM_V + v_rd_off(d0, 0, 0);   \
        TRRD(l0, b_); TRRD(h0, b_ + 2048); TRRD(l1, b_ + 4096); TRRD(h1, b_ + 6144); TRRD(l2, b_ + 8192); TRRD(h2, b_ + 10240); TRRD(l3, b_ + 12288); TRRD(h3, b_ + 14336); \
        asm volatile("s_waitcnt lgkmcnt(0)" ::: "memory"); SBAR();   \
        o[d0] = __builtin_amdgcn_mfma_f32_32x32x16_bf16(pa0, (bf16x8){l0[0], l0[1], l0[2], l0[3], h0[0], h0[1], h0[2], h0[3]}, o[d0], 0, 0, 0);   \
        o[d0] = __builtin_amdgcn_mfma_f32_32x32x16_bf16(pa1, (bf16x8){l1[0], l1[1], l1[2], l1[3], h1[0], h1[1], h1[2], h1[3]}, o[d0], 0, 0, 0);   \
        o[d0] = __builtin_amdgcn_mfma_f32_32x32x16_bf16(pa2, (bf16x8){l2[0], l2[1], l2[2], l2[3], h2[0], h2[1], h2[2], h2[3]}, o[d0], 0, 0, 0);   \
        o[d0] = __builtin_amdgcn_mfma_f32_32x32x16_bf16(pa3, (bf16x8){l3[0], l3[1], l3[2], l3[3], h3[0], h3[1], h3[2], h3[3]}, o[d0], 0, 0, 0); } while (0)
    PV_D0(0); PV_D0(1); PV_D0(2); PV_D0(3);
    __builtin_amdgcn_s_setprio(0);
#undef PV_D0
#undef TRRD
}

struct Item { const bf16* Q; const bf16* K; const bf16* V; bf16* O; const bf16* Q2; const bf16* K2; const float* C; float* L; int qp, kp, vp, op, qp2, kp2, lp, P0, skv, W, jlo; };
struct Seam { bf16x8 qr[8]; bf16x8 qr2[4]; bf16x8 st_v0, st_v1, st_k0, st_k1, st_k2; float st_c; };
template <int MODE> struct Geo {
    static __device__ __forceinline__ int qp(const Item& it) { return MODE == 1 ? 2048 : (MODE == 2 ? 1280 : it.qp); }
    static __device__ __forceinline__ int kp(const Item& it) { return MODE == 1 ? 2048 : (MODE == 2 ? 1280 : it.kp); }
    static __device__ __forceinline__ int vp(const Item& it) { return MODE == 1 ? 2048 : (MODE == 2 ? 1280 : it.vp); }
    static __device__ __forceinline__ int op(const Item& it) { return MODE == 0 ? it.op : 2048; }
    static __device__ __forceinline__ int qp2(const Item&) { return 640; }
    static __device__ __forceinline__ int kp2(const Item&) { return 64; }
    static __device__ __forceinline__ int skv(const Item& it) { return MODE == 0 ? it.skv : 8192; }
    static __device__ __forceinline__ int W(const Item& it) { return MODE == 0 ? it.W : 8192; }
    static __device__ __forceinline__ int jlo(const Item& it) { if (MODE == 1) return it.jlo; const int lowk = it.P0 - W(it) + 1; return lowk > 0 ? lowk / KVBLK : 0; }
};
__device__ __forceinline__ int swa_jlo(int P0, int W) { const int lowk = P0 - W + 1; return lowk > 0 ? lowk / KVBLK : 0; }
#define VMW() asm volatile("s_waitcnt vmcnt(0)" ::: "memory")
#define VMWN(n) asm volatile("s_waitcnt vmcnt(%0)" :: "i"(n) : "memory")
#define SLOAD_H(IT, k0) do { S.st_v0 = load8((IT).V + (size_t)((k0) + sr) * Geo<MODE>::vp(IT) + sc); S.st_v1 = load8((IT).V + (size_t)((k0) + 32 + sr) * Geo<MODE>::vp(IT) + sc);              \
                             S.st_k0 = load8((IT).K + (size_t)((k0) + sr) * Geo<MODE>::kp(IT) + sc); S.st_k1 = load8((IT).K + (size_t)((k0) + 32 + sr) * Geo<MODE>::kp(IT) + sc);              \
                             if constexpr (MODE == 2) S.st_k2 = load8((IT).K2 + (size_t)((k0) + (tid >> 3)) * Geo<MODE>::kp2(IT) + (tid & 7) * 8);                                  \
                             if constexpr (MODE == 1) S.st_c = (IT).C[(k0) + lane]; } while (0)
#define SWRITE_HK(bf, CREF) do { *(bf16x8*)(K_lds + (bf) * SHM_K + kws) = S.st_k0; *(bf16x8*)(K_lds + (bf) * SHM_K + kws + 32 * 256) = S.st_k1;                            \
                             if constexpr (MODE == 2) *(bf16x8*)(lds + OFF_K2 + (bf) * SHM_K2 + (tid >> 3) * K2P + (tid & 7) * 16) = S.st_k2;                             \
                             if constexpr (MODE == 1) { if (wid == 0) ((float*)(lds + OFF_KB))[(bf) * 64 + lane] = ((CREF) - S.st_c) * (1.0f / Cfg<MODE>::SCALE); } } while (0)
#define SWRITE_HV(bf) do { *(bf16x8*)(V_lds + (bf) * SHM_V + vst0) = S.st_v0; *(bf16x8*)(V_lds + (bf) * SHM_V + vst1) = S.st_v1; } while (0)
#define SWRITE_H(bf, CREF) do { SWRITE_HV(bf); SWRITE_HK(bf, CREF); } while (0)
#define QLOAD(IT) do { _Pragma("unroll") for (int d0 = 0; d0 < 8; ++d0) S.qr[d0] = load8((IT).Q + (size_t)(wid * QBLK + r32) * Geo<MODE>::qp(IT) + d0 * 16 + hi * 8);               \
                       if constexpr (MODE == 2) { _Pragma("unroll") for (int d0 = 0; d0 < 4; ++d0) S.qr2[d0] = load8((IT).Q2 + (size_t)(wid * QBLK + r32) * Geo<MODE>::qp2(IT) + d0 * 16 + hi * 8); } } while (0)
template <int MODE>
__device__ __forceinline__ void attn_prime(const Item& cur, char* lds, Seam& S) {
    const int tid = threadIdx.x, wid = __builtin_amdgcn_readfirstlane(tid >> 6), lane = tid & 63, r32 = lane & 31, hi = lane >> 5;
    const int sr = tid >> 4, sc = (tid & 15) * 8, kws = KSWZ(sr, sc * 2); char* K_lds = lds + OFF_K;
    const int kb0 = Geo<MODE>::jlo(cur) * KVBLK;
    float cref = 0.f; if constexpr (MODE == 1) cref = cur.C[cur.P0];
    QLOAD(cur);
    SLOAD_H(cur, kb0); VMW(); SWRITE_HK(0, cref);
    __syncthreads();
}
template <int MODE>
__device__ __forceinline__ void attn_block(const Item& cur, const Item& nxt, char* lds, Seam& S) {
    constexpr bool SK = Cfg<MODE>::SK; constexpr float SCALE = Cfg<MODE>::SCALE;
    const int tid = threadIdx.x, wid = __builtin_amdgcn_readfirstlane(tid >> 6), lane = tid & 63, r32 = lane & 31, hi = lane >> 5;
    const int W = Geo<MODE>::W(cur), skv = Geo<MODE>::skv(cur);
    const int j_lo = Geo<MODE>::jlo(cur);
    int j_hi = (cur.P0 + QB - 1) / KVBLK + 1; if (j_hi > skv / KVBLK) j_hi = skv / KVBLK;
    const int NT = j_hi - j_lo;
    const int kbn = Geo<MODE>::jlo(nxt) * KVBLK;
    const int qlo = cur.P0 + wid * QBLK, qm = qlo + r32 - 4 * hi;
    char* V_lds = lds + OFF_V; char* K_lds = lds + OFF_K;
    float* ws = (float*)(lds + OFF_WS) + wid * 64; float* li_l = ws, * al_l = ws + 32;
    float m_reg = -1e30f, l_reg = 0; f32x16 o[4] = {};
    const int sr = tid >> 4, sc = (tid & 15) * 8, vst0 = v_st(sr, sc), vst1 = v_st(32 + sr, sc), kws = KSWZ(sr, sc * 2);
    const int vb0 = (int)(uintptr_t)V_lds + v_rd_base(lane);
    float cref = 0.f, crefn = 0.f; if constexpr (MODE == 1) { cref = cur.C[cur.P0]; crefn = nxt.C[nxt.P0]; }
#define RESC(a) do { if (__any((a) < 1.f)) { if (hi == 0) al_l[r32] = (a); asm volatile("s_waitcnt lgkmcnt(0)" ::: "memory");              \
                     _Pragma("unroll") for (int d_ = 0; d_ < 4; ++d_) _Pragma("unroll") for (int r = 0; r < 16; ++r) o[d_][r] *= al_l[crow(r, hi)]; } } while (0)
#define KBASE(t) ((j_lo + (t)) * KVBLK)
#define ACT(t) (KBASE(t) <= qlo + QBLK - 1 && KBASE(t) + KVBLK - 1 >= qlo - W + 1)
#define MASKT(P0_, P1_, t) do { const int kb_ = KBASE(t); if ((!SK || ACT(t)) && (kb_ + KVBLK - 1 > qlo || kb_ <= qlo + QBLK - 1 - W)) mask_tile(P0_, P1_, qm - kb_, (unsigned)W); } while (0)
#define BIAS(P0_, P1_, bf) do { if constexpr (MODE == 1) { const float* kbp = (const float*)(lds + OFF_KB) + (bf) * 64 + 4 * hi;              \
        _Pragma("unroll") for (int q_ = 0; q_ < 4; ++q_) { const f32x4 b0_ = *(const f32x4*)(kbp + 8 * q_), b1_ = *(const f32x4*)(kbp + 32 + 8 * q_);          \
            _Pragma("unroll") for (int r_ = 0; r_ < 4; ++r_) { P0_[4 * q_ + r_] += b0_[r_]; P1_[4 * q_ + r_] += b1_[r_]; } asm volatile("" ::: "memory"); } } } while (0)
    constexpr int NQL = (MODE == 2) ? 12 : 8;
#define SEAM_K0() do { VMWN(NQL); SWRITE_HK(0, crefn); SBAR(); } while (0)
    f32x16 pA0, pA1, pB0, pB1; float mnA, mnB, alA, alB; bf16x8 pa0, pa1, pa2, pa3;
    SWRITE_HV(0); SBAR();
    if (NT > 1) SLOAD_H(cur, KBASE(1));
    SBAR(); qkt<0, MODE>(pA0, pA1, lds, r32, hi, S.qr, S.qr2, ACT(0));
    BIAS(pA0, pA1, 0); MASKT(pA0, pA1, 0); partialSM<MODE>(pA0, pA1, m_reg, mnA, alA);
    if (NT > 1) { VMW(); SWRITE_H(1, cref); }
    __syncthreads();
#define HALF_STEP(PX0, PX1, mnX, alX, PY0, PY1, alY, t, KB, VB, SB) do {                                                      \
        SBAR(); qkt<KB, MODE>(PX0, PX1, lds, r32, hi, S.qr, S.qr2, ACT(t));                                                   \
        finishSM(PY0, PY1, alY, l_reg, pa0, pa1, pa2, pa3); SBAR();                                                           \
        if ((t) + 1 < NT) { SLOAD_H(cur, KBASE((t) + 1)); SBAR(); }                                                           \
        pv_tile<VB, SK>(o, vb0, pa0, pa1, pa2, pa3, ACT((t) - 1)); BIAS(PX0, PX1, KB); MASKT(PX0, PX1, (t)); partialSM<MODE>(PX0, PX1, m_reg, mnX, alX); \
        __syncthreads();                                                                                                      \
        if ((t) + 1 < NT) { VMW(); SWRITE_H(SB, cref); }                                                                      \
        RESC(alX); __syncthreads(); } while (0)
    for (int t = 1; t + 1 < NT; t += 2) {
        HALF_STEP(pB0, pB1, mnB, alB, pA0, pA1, alA, t, 1, 0, 0);
        HALF_STEP(pA0, pA1, mnA, alA, pB0, pB1, alB, t + 1, 0, 1, 1);
    }
    const bool even = (NT & 1) == 0;
    if (even) { SBAR(); qkt<1, MODE>(pB0, pB1, lds, r32, hi, S.qr, S.qr2, ACT(NT - 1)); SBAR(); }
    SLOAD_H(nxt, kbn); SBAR();
    QLOAD(nxt);
    SBAR();
    finishSM(pA0, pA1, alA, l_reg, pa0, pa1, pa2, pa3); SBAR();
    pv_tile<0, SK>(o, vb0, pa0, pa1, pa2, pa3, ACT(even ? NT - 2 : NT - 1));
    if (even) { BIAS(pB0, pB1, 1); MASKT(pB0, pB1, NT - 1); partialSM<MODE>(pB0, pB1, m_reg, mnB, alB); __syncthreads(); RESC(alB);
        finishSM(pB0, pB1, alB, l_reg, pa0, pa1, pa2, pa3); SBAR(); pv_tile<1, SK>(o, vb0, pa0, pa1, pa2, pa3, ACT(NT - 1)); }
    SBAR(); SEAM_K0();
    if (hi == 0) li_l[r32] = l_reg; asm volatile("s_waitcnt lgkmcnt(0)" ::: "memory");
    if constexpr (MODE == 0) { if (hi == 0) cur.L[(size_t)(wid * QBLK + r32) * cur.lp] = m_reg * SCALE + __logf(l_reg); }
    float rli[16];
#pragma unroll
    for (int r = 0; r < 16; ++r) rli[r] = __builtin_amdgcn_rcpf(li_l[crow(r, hi)]);
    bf16* Ow = cur.O + (size_t)(wid * QBLK) * Geo<MODE>::op(cur);
    { const bool odd = (r32 & 1) != 0;
#pragma unroll
    for (int r = 0; r < 16; r += 2) { const int orow = crow(r, hi) + (odd ? 1 : 0);
#pragma unroll
        for (int d0 = 0; d0 < 4; ++d0) { const float va = o[d0][r] * rli[r], vb = o[d0][r + 1] * rli[r + 1];
            const float y = pg8::dpp_f<0xB1>(odd ? va : vb);
            *(unsigned*)(Ow + (size_t)orow * Geo<MODE>::op(cur) + d0 * 32 + (r32 & ~1)) = cvtpk(odd ? y : va, odd ? vb : y); } } }
    __syncthreads();
#undef RESC
#undef KBASE
#undef ACT
#undef MASKT
#undef BIAS
#undef SEAM_K0
#undef HALF_STEP
}

template <int MODE>
__device__ __forceinline__ void attn_item_simple(const Item& cur, char* lds) {
    constexpr bool SK = Cfg<MODE>::SK; constexpr float SCALE = Cfg<MODE>::SCALE;
    const int tid = threadIdx.x, wid = __builtin_amdgcn_readfirstlane(tid >> 6), lane = tid & 63, r32 = lane & 31, hi = lane >> 5;
    const int W = Geo<MODE>::W(cur), skv = Geo<MODE>::skv(cur);
    const int j_lo = Geo<MODE>::jlo(cur);
    int j_hi = (cur.P0 + QB - 1) / KVBLK + 1; if (j_hi > skv / KVBLK) j_hi = skv / KVBLK;
    const int NT = j_hi - j_lo;
    const int qlo = cur.P0 + wid * QBLK, qm = qlo + r32 - 4 * hi;
    char* V_lds = lds + OFF_V; char* K_lds = lds + OFF_K;
    float* ws = (float*)(lds + OFF_WS) + wid * 64; float* li_l = ws, * al_l = ws + 32;
    float m_reg = -1e30f, l_reg = 0; f32x16 o[4] = {};
    const int sr = tid >> 4, sc = (tid & 15) * 8, vst0 = v_st(sr, sc), vst1 = v_st(32 + sr, sc), kws = KSWZ(sr, sc * 2);
    const int vb0 = (int)(uintptr_t)V_lds + v_rd_base(lane);
    float cref = 0.f; if constexpr (MODE == 1) cref = cur.C[cur.P0];
    Seam S;
#define RESC(a) do { if (__any((a) < 1.f)) { if (hi == 0) al_l[r32] = (a); asm volatile("s_waitcnt lgkmcnt(0)" ::: "memory");              \
                     _Pragma("unroll") for (int d_ = 0; d_ < 4; ++d_) _Pragma("unroll") for (int r = 0; r < 16; ++r) o[d_][r] *= al_l[crow(r, hi)]; } } while (0)
#define KBASE(t) ((j_lo + (t)) * KVBLK)
#define ACT(t) (KBASE(t) <= qlo + QBLK - 1 && KBASE(t) + KVBLK - 1 >= qlo - W + 1)
#define MASKT(P0_, P1_, t) do { const int kb_ = KBASE(t); if ((!SK || ACT(t)) && (kb_ + KVBLK - 1 > qlo || kb_ <= qlo + QBLK - 1 - W)) mask_tile(P0_, P1_, qm - kb_, (unsigned)W); } while (0)
#define BIAS(P0_, P1_, bf) do { if constexpr (MODE == 1) { const float* kbp = (const float*)(lds + OFF_KB) + (bf) * 64 + 4 * hi;              \
        _Pragma("unroll") for (int q_ = 0; q_ < 4; ++q_) { const f32x4 b0_ = *(const f32x4*)(kbp + 8 * q_), b1_ = *(const f32x4*)(kbp + 32 + 8 * q_);          \
            _Pragma("unroll") for (int r_ = 0; r_ < 4; ++r_) { P0_[4 * q_ + r_] += b0_[r_]; P1_[4 * q_ + r_] += b1_[r_]; } asm volatile("" ::: "memory"); } } } while (0)
    QLOAD(cur);
    SLOAD_H(cur, KBASE(0)); VMW(); SWRITE_H(0, cref);
    f32x16 pA0, pA1; float mnA, alA; bf16x8 pa0, pa1, pa2, pa3;
#define STEP(t, B) do {                                                                                                       \
        __syncthreads();                                                                                                      \
        if ((t) + 1 < NT) { SLOAD_H(cur, KBASE((t) + 1)); } SBAR();                                                           \
        qkt<B, MODE>(pA0, pA1, lds, r32, hi, S.qr, S.qr2, ACT(t));                                                            \
        BIAS(pA0, pA1, B); MASKT(pA0, pA1, (t)); partialSM<MODE>(pA0, pA1, m_reg, mnA, alA); RESC(alA);                       \
        finishSM(pA0, pA1, alA, l_reg, pa0, pa1, pa2, pa3); SBAR();                                                           \
        pv_tile<B, SK>(o, vb0, pa0, pa1, pa2, pa3, ACT(t)); SBAR();                                                           \
        if ((t) + 1 < NT) { VMW(); SWRITE_H((B) ^ 1, cref); } } while (0)
    for (int t = 0; t < NT; t += 2) {
        STEP(t, 0);
        if (t + 1 < NT) STEP(t + 1, 1);
    }
    if (hi == 0) li_l[r32] = l_reg; asm volatile("s_waitcnt lgkmcnt(0)" ::: "memory");
    if constexpr (MODE == 0) { if (hi == 0) cur.L[(size_t)(wid * QBLK + r32) * cur.lp] = m_reg * SCALE + __logf(l_reg); }
    float rli[16];
#pragma unroll
    for (int r = 0; r < 16; ++r) rli[r] = __builtin_amdgcn_rcpf(li_l[crow(r, hi)]);
    bf16* Ow = cur.O + (size_t)(wid * QBLK) * Geo<MODE>::op(cur);
    { const bool odd = (r32 & 1) != 0;
#pragma unroll
    for (int r = 0; r < 16; r += 2) { const int orow = crow(r, hi) + (odd ? 1 : 0);
#pragma unroll
        for (int d0 = 0; d0 < 4; ++d0) { const float va = o[d0][r] * rli[r], vb = o[d0][r + 1] * rli[r + 1];
            const float y = pg8::dpp_f<0xB1>(odd ? va : vb);
            *(unsigned*)(Ow + (size_t)orow * Geo<MODE>::op(cur) + d0 * 32 + (r32 & ~1)) = cvtpk(odd ? y : va, odd ? vb : y); } } }
    __syncthreads();
#undef RESC
#undef KBASE
#undef ACT
#undef MASKT
#undef BIAS
#undef STEP
}
#ifndef ATT_SIMPLE
#define ATT_SIMPLE 1
#endif
template <int MODE, class List>
__device__ __forceinline__ void attn_run(char* lds, const List& L) {
    const int n = L.count(); if (n <= 0) return;
#ifndef ATT_PIPE_MASK
#define ATT_PIPE_MASK 3
#endif
    if constexpr (((ATT_PIPE_MASK >> MODE) & 1) == 0) {
        for (int i = 0; i < n; ++i) { const Item it = L.get(i); attn_item_simple<MODE>(it, lds); }
        return;
    }
    Item cur = L.get(0); Seam S;
    attn_prime<MODE>(cur, lds, S);
    for (int i = 0;; ++i) {
        const bool last = (i + 1 >= n);
        const Item nxt = last ? cur : L.get(i + 1);
        attn_block<MODE>(cur, nxt, lds, S);
        if (last) break;
        cur = nxt;
    }
    __syncthreads();
}
#undef VMW
#undef VMWN
#undef SLOAD_H
#undef SWRITE_HK
#undef SWRITE_HV
#undef SWRITE_H
#undef QLOAD
#undef KSWZ
#undef SBAR
}

constexpr int NWAVES = 8;
constexpr int SEQ = 8192, NB = 2, TOK = NB * SEQ, DM = 2048, DFF = 5632, NEXP = 8;
constexpr int N_IN = 4608, OFF_CKV_C = 448, OFF_KROPE_C = 576, OFF_DQ_C = 640, OFF_DK_C = 2944, OFF_DV_C = 3712, W_IN_COLS_C = 4480;
constexpr float LN_EPS_C = 1e-5f;
#ifndef MK_PER_PHASE
#define MK_PER_PHASE 0
#endif
constexpr int NPH = 19;
#ifndef MOE_GATHER
#define MOE_GATHER 1
#endif

constexpr size_t MiB = 1u << 20;
constexpr size_t WS_CTL = 0, CTL_ZERO_BYTES = 1 * MiB;
constexpr size_t WS_COS128 = 1 * MiB, WS_SIN128 = 3 * MiB, WS_COS64 = 5 * MiB, WS_SIN64 = 6 * MiB;
constexpr size_t WS_SSQ = 7 * MiB, WS_LSE = 8 * MiB, WS_LOGF = 10 * MiB, WS_CUM = 11 * MiB, WS_ROUTE = 12 * MiB;
constexpr size_t WS_STATS = WS_SSQ + 800 * 1024;
constexpr size_t WS_W = 13 * MiB;
constexpr size_t WB_IN = WS_W, WB_QB = WB_IN + 18 * MiB, WB_KVB = WB_QB + 2 * MiB, WB_O0 = WB_KVB + 2 * MiB, WB_GU = WB_O0 + 8 * MiB, WB_DN = WB_GU + 44 * MiB,
                 WB_QKV = WB_DN + 22 * MiB, WB_O1 = WB_QKV + 24 * MiB, WB_EGU = WB_O1 + 8 * MiB  , WB_EDN = WB_EGU + 176 * MiB  , WS_XB = WB_EDN + 88 * MiB;
constexpr size_t WS_XR = WS_XB + 64 * MiB, WS_R = WS_XR + 128 * MiB, WS_S = WS_R + 286 * MiB, WS_END = WS_S + 136 * MiB;
constexpr size_t R_CQ = WS_R, R_CKV = R_CQ + 16 * MiB, R_KR = R_CKV + 8 * MiB, R_DQ = R_KR + 2 * MiB, R_DK = R_DQ + 72 * MiB, R_DV = R_DK + 24 * MiB,
                 R_QN = R_DV + 24 * MiB, R_QR = R_QN + 40 * MiB, R_KN = R_QR + 20 * MiB, R_VV = R_KN + 40 * MiB;
static_assert(R_VV + 40 * MiB == WS_S, "region R map");
constexpr size_t R_HF = WS_R, R_Q1 = WS_R, R_K1 = WS_R + 64 * MiB, R_V1 = WS_R + 128 * MiB, R_HE = WS_R, R_YPB = WS_R + 192 * MiB;
constexpr int MOE_MAX_TILES = 136, MOE_MAIN_TILES = 128;
static_assert((size_t)MOE_MAX_TILES * 256 * DFF <= 192 * MiB && (size_t)(MOE_MAX_TILES - MOE_MAIN_TILES) * 256 * DM * 2 <= 94 * MiB && (size_t)TOK * DFF * 2 <= 286 * MiB, "overlays fit region R");
constexpr size_t S_MIX = WS_S, S_OG = WS_S + 64 * MiB, S_XP = WS_S;
static_assert((size_t)MOE_MAX_TILES * 256 * DM * 2 <= 136 * MiB, "XP fits region S");
constexpr size_t RT_E = WS_ROUTE, RT_W = WS_ROUTE + 128 * 1024, RT_SLOT = WS_ROUTE + 384 * 1024, RT_META = WS_ROUTE + 640 * 1024, RT_ROWIDX = WS_ROUTE + 704 * 1024;
constexpr int CW_TMO = 0, CW_BAR = 4096, CW_QKMAX = 8192;

constexpr int RING_OFF = 0, RING_BYTES = 131072;
constexpr int LDSCTL_OFF = RING_BYTES, MISC_OFF = LDSCTL_OFF + 320;
constexpr int LDS_BYTES = 147456;
static_assert(att::LDS_BYTES <= RING_BYTES && pg8::STAGE_BYTES <= RING_BYTES, "phase scratch fits the ring region");

#define GAS __attribute__((address_space(1)))
#define LAS __attribute__((address_space(3)))
typedef unsigned short bf16;
typedef unsigned v4u __attribute__((ext_vector_type(4)));
typedef unsigned v2u __attribute__((ext_vector_type(2)));
typedef float f32x4 __attribute__((ext_vector_type(4)));
typedef float f32x2 __attribute__((ext_vector_type(2)));
typedef GAS unsigned gu32;
#define RLX_AGENT __ATOMIC_RELAXED, __HIP_MEMORY_SCOPE_AGENT
__device__ __forceinline__ unsigned pk2(float lo, float hi) { return pg8::cvt_pk_bf16(lo, hi); }
__device__ __forceinline__ float bf2f(unsigned short h) { return __uint_as_float((unsigned)h << 16); }
__device__ __forceinline__ int ld_i(const int* p) { return __hip_atomic_load(p, RLX_AGENT); }
__device__ __forceinline__ float ld_f(const float* p) { return __hip_atomic_load(p, RLX_AGENT); }
#define XB_TMO      128
#define XB_XCNT(j)  (256  + 64 * (j))
#define XB_XSUB(j)  (1280 + 64 * (j))
#define XB_XGEN(j)  (2304 + 64 * (j))
#define XB_TOP      3328
#define XB_TOPGEN   3392
#define XCD_BAR_WORDS 3456
#define XB_SPIN_CAP (1u << 18)

__device__ __forceinline__ unsigned xb_ld(unsigned* p)              { return __hip_atomic_load(p, __ATOMIC_RELAXED, __HIP_MEMORY_SCOPE_AGENT); }
__device__ __forceinline__ unsigned xb_add(unsigned* p, unsigned v) { return __hip_atomic_fetch_add(p, v, __ATOMIC_RELAXED, __HIP_MEMORY_SCOPE_AGENT); }
__device__ __forceinline__ unsigned xb_xcc_id() { return (unsigned)__builtin_amdgcn_s_getreg((3 << 11) | 20) & 0xFu; }
#define XB_SPIN(cond, bar) do { unsigned _sp = 0; while (cond) { __builtin_amdgcn_s_sleep(1); \
    if ((++_sp & 255u) == 0u) { if (xb_ld(&(bar)[XB_TMO])) break; if (_sp > XB_SPIN_CAP) { atomicAdd(&(bar)[XB_TMO], 1u); break; } } } } while (0)

struct XcdBarrier {
    unsigned* bar; unsigned x;
    volatile LAS unsigned* st;
};

__device__ __forceinline__ XcdBarrier xcd_barrier_post(unsigned* bar, volatile LAS unsigned* st) {
    XcdBarrier b; b.bar = bar; b.x = xb_xcc_id(); b.st = st;
    if (threadIdx.x == 0) (void)xb_add(&bar[XB_XCNT(b.x)], 1u);
    return b;
}
__device__ __forceinline__ void xcd_barrier_complete(unsigned* bar, unsigned x, unsigned& nloc, unsigned& nx) {
    const unsigned G = gridDim.x * gridDim.y * gridDim.z;
    unsigned sum, cnt, mine, sp = 0u;
    for (;;) {
        sum = 0u; cnt = 0u; mine = 0u;
#pragma unroll
        for (unsigned j = 0; j < 16; ++j) { const unsigned c = xb_ld(&bar[XB_XCNT(j)]); sum += c; cnt += (c > 0u) ? 1u : 0u; mine = (j == x) ? c : mine; }
        if (sum == G) break;
        __builtin_amdgcn_s_sleep(1);
        if ((++sp & 255u) == 0u) { if (xb_ld(&bar[XB_TMO])) break; if (sp > XB_SPIN_CAP) { atomicAdd(&bar[XB_TMO], 1u); break; } }
    }
    nloc = mine > 0u ? mine : 1u; nx = cnt > 0u ? cnt : 1u;
}

__device__ __forceinline__ void xcd_barrier(const XcdBarrier& b) {
    asm volatile("s_waitcnt vmcnt(0)" ::: "memory");
    __syncthreads();
    if (threadIdx.x == 0) {
        unsigned* bar = b.bar;
        __builtin_amdgcn_s_waitcnt(0);
        unsigned nloc = b.st[0], nx = b.st[1];
        if (nloc == 0u) { xcd_barrier_complete(bar, b.x, nloc, nx); b.st[0] = nloc; b.st[1] = nx; }
        const unsigned old = xb_add(&bar[XB_XSUB(b.x)], 1u);
        const unsigned gen = old / nloc;
        if (old + 1u == (gen + 1u) * nloc) {
            __builtin_amdgcn_fence(__ATOMIC_RELEASE, "agent");
            asm volatile("s_waitcnt vmcnt(0)" ::: "memory");
            const unsigned og = xb_add(&bar[XB_TOP], 1u);
            const unsigned tg = og / nx;
            if (og + 1u == (tg + 1u) * nx) xb_add(&bar[XB_TOPGEN], 1u);
            else XB_SPIN(xb_ld(&bar[XB_TOPGEN]) == tg, bar);
            __builtin_amdgcn_fence(__ATOMIC_ACQUIRE, "agent");
            xb_add(&bar[XB_XGEN(b.x)], 1u);
            asm volatile("s_waitcnt vmcnt(0)" ::: "memory");
        } else {
            XB_SPIN(xb_ld(&bar[XB_XGEN(b.x)]) == gen, bar);
            __builtin_amdgcn_fence(__ATOMIC_ACQUIRE, "agent");
            asm volatile("s_waitcnt vmcnt(0)" ::: "memory");
        }
    }
    __syncthreads();
}


__device__ __forceinline__ float wave_sum(float v) { return pg8::xsum32(pg8::xsum16(pg8::row16_sum(v))); }
#ifndef QKV_F8
#define QKV_F8 0
#endif
#ifndef FFN_DN_F8
#define FFN_DN_F8 1
#endif
#ifndef FFN_GU_F8
#define FFN_GU_F8 1
#endif
struct Conv { const float* src; const float* src2; const float* kscale; unsigned char* dst; int K, N, Kp, kind, f8; };
struct In { const float* p[27]; };
#define KA_CONST __attribute__((address_space(4)))
__device__ __forceinline__ const float* INP(int i) { return *(const float* const KA_CONST*)((const KA_CONST char*)__builtin_amdgcn_kernarg_segment_ptr() + 8 * i); }
constexpr int T_IN = (N_IN / 256) * (DM / 64), T_QB = (2048 / 256) * (512 / 64), T_KVB = (2560 / 256) * (256 / 64), T_O = (DM / 256) * (DM / 64), T_GU = (2 * DFF / 256) * (DM / 64), T_DN = (DM / 256) * (DFF / 64),
              T_QKV = (3 * DM / 256) * (DM / 64);
constexpr int T_TOTAL = T_IN + T_QB + T_KVB + T_O + T_GU + T_DN + T_QKV + T_O + NEXP * T_GU + NEXP * T_DN;
__device__ __forceinline__ Conv conv_decode(unsigned char* ws, int it, int& r) {
    r = it; Conv c;
    if (r < T_IN) { c = Conv{INP(1), nullptr, nullptr, ws + WB_IN, DM, W_IN_COLS_C, DM, 1, 0}; }
    else if ((r -= T_IN) < T_QB) { c = Conv{INP(3), nullptr, INP(2), ws + WB_QB, 448, 1920, 512, 2, 0}; }
    else if ((r -= T_QB) < T_KVB) { c = Conv{INP(5), nullptr, INP(4), ws + WB_KVB, 128, 2560, 256, 0, 0}; }
    else if ((r -= T_KVB) < T_O) { c = Conv{INP(6), nullptr, nullptr, ws + WB_O0, DM, DM, DM, 0, 0}; }
    else if ((r -= T_O) < T_GU) { c = Conv{INP(9), INP(10), nullptr, ws + WB_GU, DM, DFF, DM, 3, FFN_GU_F8}; }
    else if ((r -= T_GU) < T_DN) { c = Conv{INP(11), nullptr, nullptr, ws + WB_DN, DFF, DM, DFF, 0, FFN_DN_F8}; }
    else if ((r -= T_DN) < T_QKV) { c = Conv{INP(14), nullptr, nullptr, ws + WB_QKV, DM, 3 * DM, DM, 0, QKV_F8}; }
    else if ((r -= T_QKV) < T_O) { c = Conv{INP(17), nullptr, nullptr, ws + WB_O1, DM, DM, DM, 0, 0}; }
    else if ((r -= T_O) < NEXP * T_GU) { const int e = r / T_GU; r -= e * T_GU;
        c = Conv{INP(22) + (size_t)e * DM * DFF, INP(23) + (size_t)e * DM * DFF, nullptr, ws + WB_EGU + (size_t)e * 2 * DFF * DM, DM, DFF, DM, 3, 1}; }
    else { r -= NEXP * T_GU; const int e = r / T_DN; r -= e * T_DN;
        c = Conv{INP(24) + (size_t)e * DFF * DM, nullptr, nullptr, ws + WB_EDN + (size_t)e * DM * DFF, DFF, DM, DFF, 0, 1}; }
    return c;
}
__device__ __forceinline__ int conv_col(const Conv& c, int np, const float*& sp) {
    sp = c.src; int col = -1;
    if (c.kind == 0) { col = np < c.N ? np : -1; }
    else if (c.kind == 1) {
        const int t = np >> 8, w = np & 255, bj = w >> 7, ch = w & 127;
        if (t < 9) col = OFF_DQ_C + (2 * t + (ch >> 6)) * 128 + bj * 64 + (ch & 63);
        else if (t < 12) col = OFF_DK_C + (2 * (t - 9) + (ch >> 6)) * 128 + bj * 64 + (ch & 63);
        else if (t < 15) col = OFF_DV_C + (t - 12) * 256 + w;
        else if (t == 15) col = w;
        else if (t == 16) col = (256 + w < 448) ? 256 + w : -1;
        else col = ch < 64 ? OFF_CKV_C + bj * 64 + ch : (ch < 96 ? OFF_KROPE_C + bj * 32 + (ch - 64) : -1);
    } else if (c.kind == 2) {
        const int t = np >> 8;
        if (t < 5) col = (np >> 7) * 192 + (np & 127);
        else { const int w = np & 255, bj = w >> 7, ch = w & 127, head = 4 * (t - 5) + (ch >> 5); col = head < 10 ? head * 192 + 128 + bj * 32 + (ch & 31) : -1; }
    } else {
        const int t = np >> 8, w = np & 255, bj = w >> 7, ch = w & 127; const long long d2 = (const char*)c.src2 - (const char*)c.src; sp = (const float*)((const char*)c.src + (bj ? d2 : 0ll)); col = t * 128 + ch;
    }
    return col;
}
__device__ __forceinline__ void conv_load(const Conv& c, int r, int tid, f32x4 (&v)[8]) {
    const int nkb = c.Kp >> 6, rb = r / nkb, kb = r - rb * nkb, np = rb * 256 + (tid & 63) * 4, kl = tid >> 6, k0 = kb * 64;
    const float* sp; const int col = conv_col(c, np, sp);
#pragma unroll
    for (int i = 0; i < 8; ++i) { const int k = k0 + (c.f8 ? 4 * kl + 32 * (i >> 2) + (i & 3) : 2 * kl + 16 * (i >> 1) + (i & 1));
        v[i] = (col >= 0 && k < c.K) ? *(const f32x4*)(sp + (size_t)k * c.N + col) : (f32x4){0.f, 0.f, 0.f, 0.f}; }
    if (c.kscale) {
#pragma unroll
        for (int i = 0; i < 8; ++i) { const int k = k0 + 2 * kl + 16 * (i >> 1) + (i & 1); v[i] = v[i] * ((k < c.K) ? c.kscale[k] : 0.f); }
    }
}
constexpr int CV_PITCH = 1040;
__device__ __forceinline__ void conv_stage(const Conv& c, int tid, const f32x4 (&v)[8], LAS unsigned char* sm) {
    const int kl = tid >> 6, nl = (tid & 63) * 4;
    if (c.f8) {
#pragma unroll
        for (int j = 0; j < 2; ++j) { const int kg = kl + 8 * j, row = (kg & 3) * 4 + (kg >> 2); v4u o;
#pragma unroll
            for (int n = 0; n < 4; ++n) o[n] = pg8::pk4_fp8(v[4 * j][n] * pg8::W8_SCALE, v[4 * j + 1][n] * pg8::W8_SCALE, v[4 * j + 2][n] * pg8::W8_SCALE, v[4 * j + 3][n] * pg8::W8_SCALE);
            *(LAS v4u*)(sm + row * CV_PITCH + nl * 4) = o; }
    } else {
#pragma unroll
        for (int j = 0; j < 4; ++j) { const int kg = kl + 8 * j, row = (kg & 3) * 8 + (kg >> 2); v4u o;
#pragma unroll
            for (int n = 0; n < 4; ++n) o[n] = pk2(v[2 * j][n], v[2 * j + 1][n]);
            *(LAS v4u*)(sm + row * CV_PITCH + nl * 4) = o; }
    }
}
__device__ __forceinline__ void conv_store(const Conv& c, int r, int tid, const LAS unsigned char* sm) {
    const int nkb = c.Kp >> 6, rb = r / nkb, kb = r - rb * nkb;
    if (c.f8) {
        unsigned char* d = c.dst + (size_t)rb * 256 * c.Kp + kb * 64;
#pragma unroll
        for (int j = 0; j < 2; ++j) { const int idx = tid + 512 * j, n = idx >> 2, kc = idx & 3; v4u w;
#pragma unroll
            for (int q = 0; q < 4; ++q) w[q] = *(const LAS unsigned*)(sm + (q * 4 + kc) * CV_PITCH + n * 4);
            *(v4u*)(d + (size_t)n * c.Kp + 16 * kc) = w; }
    } else {
        unsigned char* d = c.dst + ((size_t)rb * 256 * c.Kp + kb * 64) * 2;
#pragma unroll
        for (int j = 0; j < 4; ++j) { const int idx = tid + 512 * j, n = idx >> 3, kc = idx & 7; v4u w;
#pragma unroll
            for (int q = 0; q < 4; ++q) w[q] = *(const LAS unsigned*)(sm + (q * 8 + kc) * CV_PITCH + n * 4);
            *(v4u*)(d + ((size_t)n * c.Kp + 8 * kc) * 2) = w; }
    }
}
__device__ __forceinline__ void conv_run(unsigned char* ws, LAS unsigned char* sm, int tid, int t_begin, int t_end, int nw, int w) {
    {
        const int CH = (t_end - t_begin + nw - 1) / nw, lim = t_begin + (w + 1) * CH < t_end ? t_begin + (w + 1) * CH : t_end;
        int it = t_begin + w * CH; f32x4 vA[8], vB[8];
        bool hasA = it < lim, hasB = it + 1 < lim;
        if (hasA) { int r; const Conv c = conv_decode(ws, it, r); conv_load(c, r, tid, vA); }
        if (hasB) { int r; const Conv c = conv_decode(ws, it + 1, r); conv_load(c, r, tid, vB); }
        while (hasA) {
            { int r; const Conv c = conv_decode(ws, it, r); conv_stage(c, tid, vA, sm); }
            const bool hasA2 = it + 2 < lim;
            if (hasA2) { int r; const Conv c = conv_decode(ws, it + 2, r); conv_load(c, r, tid, vA); }
            __syncthreads(); { int r; const Conv c = conv_decode(ws, it, r); conv_store(c, r, tid, sm); } __syncthreads();
            if (!hasB) break;
            { int r; const Conv c = conv_decode(ws, it + 1, r); conv_stage(c, tid, vB, sm); }
            const bool hasB2 = it + 3 < lim;
            if (hasB2) { int r; const Conv c = conv_decode(ws, it + 3, r); conv_load(c, r, tid, vB); }
            __syncthreads(); { int r; const Conv c = conv_decode(ws, it + 1, r); conv_store(c, r, tid, sm); } __syncthreads();
            it += 2; hasA = hasA2; hasB = hasB2;
        }
    }
}
constexpr int XT_GU = (2 * DFF / 128) * (DM / 64), XT_DN = (DM / 128) * (DFF / 64), XT_E = XT_GU + XT_DN, XT_TOTAL = NEXP * XT_E;
struct XTile { const float* src; unsigned char* dst; int N, Kp; };
__device__ __forceinline__ XTile xtile_decode(unsigned char* ws, int it) {
    const int e = it / XT_E; int r = it - e * XT_E; XTile x;
    if (r < XT_GU) { const int rb = r / (DM / 64), kb = r - rb * (DM / 64);
        x.src = (rb & 1 ? INP(23) : INP(22)) + (size_t)e * DM * DFF + (size_t)(kb * 64) * DFF + (rb >> 1) * 128; x.N = DFF; x.Kp = DM;
        x.dst = ws + WB_EGU + (size_t)e * 2 * DFF * DM + (size_t)(rb * 128) * DM + kb * 64; }
    else { r -= XT_GU; const int rb = r / (DFF / 64), kb = r - rb * (DFF / 64);
        x.src = INP(24) + (size_t)e * DFF * DM + (size_t)(kb * 64) * DM + rb * 128; x.N = DM; x.Kp = DFF;
        x.dst = ws + WB_EDN + (size_t)e * DM * DFF + (size_t)(rb * 128) * DFF + kb * 64; }
    return x;
}
__device__ __forceinline__ void xtile_dma(const XTile& x, LAS unsigned char* slot, int wave, int lane) {
#pragma unroll
    for (int j = 0; j < 4; ++j) { const int k = wave * 8 + 2 * j;
        __builtin_amdgcn_global_load_lds((const unsigned*)(x.src + (size_t)(k + (lane >> 5)) * x.N + (lane & 31) * 4), (LAS unsigned*)(slot + k * 512), 16, 0, 0); }
}
__device__ __forceinline__ void xtile_emit(const XTile& x, const LAS unsigned char* slot, int tid) {
    const int n = tid >> 2, kc = tid & 3; const LAS float* f = (const LAS float*)slot + (16 * kc) * 128 + n; v4u o;
#pragma unroll
    for (int q = 0; q < 4; ++q) o[q] = pg8::pk4_fp8(f[(4 * q) * 128] * pg8::W8_SCALE, f[(4 * q + 1) * 128] * pg8::W8_SCALE, f[(4 * q + 2) * 128] * pg8::W8_SCALE, f[(4 * q + 3) * 128] * pg8::W8_SCALE);
    *(v4u*)(x.dst + (size_t)n * x.Kp + 16 * kc) = o;
}
__device__ __forceinline__ void conv_run_dma(unsigned char* ws, LAS unsigned char* sm, int tid, int nw, int w) {
    const int wave = __builtin_amdgcn_readfirstlane(tid >> 6), lane = tid & 63;
    const int CH = (XT_TOTAL + nw - 1) / nw, beg = w * CH, lim = beg + CH < XT_TOTAL ? beg + CH : XT_TOTAL;
    if (beg >= lim) return;
#pragma unroll
    for (int d = 0; d < 3; ++d) { const int t = beg + d < lim ? beg + d : lim - 1; const XTile x = xtile_decode(ws, t); xtile_dma(x, sm + d * 32768, wave, lane); }
    for (int it = beg; it < lim; ++it) {
        asm volatile("s_waitcnt vmcnt(8)" ::: "memory");
        __builtin_amdgcn_s_barrier(); asm volatile("" ::: "memory");
        { const int t = it + 3 < lim ? it + 3 : lim - 1; const XTile x = xtile_decode(ws, t); xtile_dma(x, sm + ((it + 3 - beg) & 3) * 32768, wave, lane); }
        { const XTile x = xtile_decode(ws, it); xtile_emit(x, sm + ((it - beg) & 3) * 32768, tid); }
        asm volatile("s_waitcnt lgkmcnt(0)" ::: "memory");
    }
    asm volatile("s_waitcnt vmcnt(0)" ::: "memory"); __builtin_amdgcn_s_barrier();
}
#ifndef CONV_CUS
#define CONV_CUS 56
#endif
constexpr int T_NONEXP = T_IN + T_QB + T_KVB + T_O + T_GU + T_DN + T_QKV + T_O;
constexpr int T_EARLY = T_IN + T_QB + T_KVB + T_O;
__device__ __forceinline__ void p0_prologue(unsigned char* ws, LAS unsigned char* sm, int bx, int G, int gw, int NGW, int lane, int tid) {
    conv_run(ws, sm, tid, 0, CONV_CUS ? T_EARLY : T_TOTAL, G, bx);
    { const float* x = INP(0); bf16* xb = (bf16*)(ws + WS_XB); const int gt = gw * 64 + lane, NGT = NGW * 64;
      for (int i = gt; i < TOK * DM / 8; i += NGT) { const f32x4 a = *(const f32x4*)(x + (size_t)i * 8), b = *(const f32x4*)(x + (size_t)i * 8 + 4);
          *(v4u*)(xb + (size_t)i * 8) = pg8::pack8(a, b); } }
    { const int gt = gw * 64 + lane, NGT = NGW * 64;
      for (int i = gt; i < SEQ * 96; i += NGT) {
          const int pos = i / 96, f = i - pos * 96; const bool big = f < 64; const int fi = big ? f : f - 64;
          const double ex = -13.287712379549449 * (big ? (double)fi / 64.0 : (double)fi / 32.0);
          const double inv = ::exp2(ex);
          const double rev = (double)pos * inv * 0.15915494309189535;
          const float fr = (float)(rev - __builtin_rint(rev));
          const float cs = __builtin_amdgcn_cosf(fr), sn = __builtin_amdgcn_sinf(fr);
          if (big) { ((float*)(ws + WS_COS128))[pos * 64 + fi] = cs; ((float*)(ws + WS_SIN128))[pos * 64 + fi] = sn; }
          else { ((float*)(ws + WS_COS64))[pos * 32 + fi] = cs; ((float*)(ws + WS_SIN64))[pos * 32 + fi] = sn; }
      } }
}

__device__ __forceinline__ void ln_core(f32x4 (&v)[8], const float* g, const float* b, int lane, float* mean_out = nullptr, float* rstd_out = nullptr) {
    float s = 0.f;
#pragma unroll
    for (int j = 0; j < 8; ++j) s += (v[j][0] + v[j][1]) + (v[j][2] + v[j][3]);
    const float mean = wave_sum(s) * (1.f / DM); float s2 = 0.f;
#pragma unroll
    for (int j = 0; j < 8; ++j) { v[j] = v[j] - mean; s2 += (v[j][0] * v[j][0] + v[j][1] * v[j][1]) + (v[j][2] * v[j][2] + v[j][3] * v[j][3]); }
    const float rstd = 1.f / sqrtf(wave_sum(s2) * (1.f / DM) + LN_EPS_C);
    if (mean_out) { *mean_out = mean; *rstd_out = rstd; }
#pragma unroll
    for (int j = 0; j < 8; ++j) { const f32x4 gg = *(const f32x4*)(g + 4 * (lane + 64 * j)), bb = *(const f32x4*)(b + 4 * (lane + 64 * j)); v[j] = v[j] * rstd * gg + bb; }
}
template <int EXTRA, bool OUT8 = false, bool WRITE_XB = true>
__device__ __forceinline__ void ln_phase(pg8::res_t* XR, bf16* XB, const float* g, const float* b, const float* ew, const float* eb, unsigned char* ws, LAS float* sm, int gw, int NGW, int lane, int tid) {
    constexpr int NH = EXTRA == 1 ? 16 : (EXTRA == 2 ? 8 : 0);
    if constexpr (EXTRA != 0) {
        for (int k = tid; k < DM; k += NWAVES * 64)
#pragma unroll
            for (int q = 0; q < NH / 4; ++q) { const f32x4 w4 = *(const f32x4*)(ew + (size_t)k * NH + 4 * q);
#pragma unroll
                for (int cc = 0; cc < 4; ++cc) sm[(4 * q + cc) * DM + k] = w4[cc]; }
        __syncthreads();
    }
    for (int row0 = gw; row0 < TOK; row0 += 2 * NGW) {
        const int row1 = row0 + NGW; const bool two = row1 < TOK; const int r1 = two ? row1 : row0;
        f32x4 v0[8], v1[8];
#pragma unroll
        for (int j = 0; j < 8; ++j) {
#if XR_BF16
            const v2u w0 = *(const v2u*)(XR + (size_t)row0 * DM + 4 * (lane + 64 * j)), w1 = *(const v2u*)(XR + (size_t)r1 * DM + 4 * (lane + 64 * j)); v0[j] = pg8::res4(w0.x, w0.y); v1[j] = pg8::res4(w1.x, w1.y);
#else
            v0[j] = *(const f32x4*)(XR + (size_t)row0 * DM + 4 * (lane + 64 * j)); v1[j] = *(const f32x4*)(XR + (size_t)r1 * DM + 4 * (lane + 64 * j));
#endif
        }
        float mu0, rs0, mu1, rs1;
        ln_core(v0, g, b, lane, &mu0, &rs0); ln_core(v1, g, b, lane, &mu1, &rs1);
        if (lane == 0) { f32x2* ST = (f32x2*)(ws + WS_STATS); ST[row0] = (f32x2){mu0, rs0}; if (two) ST[row1] = (f32x2){mu1, rs1}; }
        if constexpr (WRITE_XB) {
#pragma unroll
        for (int j = 0; j < 8; ++j) {
            if constexpr (OUT8) { *(unsigned*)((unsigned char*)XB + (size_t)row0 * DM + 4 * (lane + 64 * j)) = pg8::pk4_fp8(v0[j][0], v0[j][1], v0[j][2], v0[j][3]); }
            else { v2u o; o.x = pk2(v0[j][0], v0[j][1]); o.y = pk2(v0[j][2], v0[j][3]); *(v2u*)(XB + (size_t)row0 * DM + 4 * (lane + 64 * j)) = o; } }
        if (two) {
#pragma unroll
            for (int j = 0; j < 8; ++j) {
                if constexpr (OUT8) { *(unsigned*)((unsigned char*)XB + (size_t)row1 * DM + 4 * (lane + 64 * j)) = pg8::pk4_fp8(v1[j][0], v1[j][1], v1[j][2], v1[j][3]); }
                else { v2u o; o.x = pk2(v1[j][0], v1[j][1]); o.y = pk2(v1[j][2], v1[j][3]); *(v2u*)(XB + (size_t)row1 * DM + 4 * (lane + 64 * j)) = o; } }
        }
        }
        if constexpr (EXTRA != 0) {
            float m0 = 0.f, m1 = 0.f;
#pragma unroll 2
            for (int h = 0; h < NH; ++h) { float s0 = 0.f, s1 = 0.f;
#pragma unroll
                for (int j = 0; j < 8; ++j) { const f32x4 w4 = *(const LAS f32x4*)(sm + h * DM + 4 * (lane + 64 * j));
                    s0 += (v0[j][0] * w4[0] + v0[j][1] * w4[1]) + (v0[j][2] * w4[2] + v0[j][3] * w4[3]);
                    s1 += (v1[j][0] * w4[0] + v1[j][1] * w4[1]) + (v1[j][2] * w4[2] + v1[j][3] * w4[3]); }
                s0 = wave_sum(s0); s1 = wave_sum(s1);
                if (lane == h) { m0 = s0; m1 = s1; } }
            if constexpr (EXTRA == 1) {
                if (lane < 16) { const float bb = eb[lane]; float z = m0 + bb;
                    ((float*)(ws + WS_LOGF))[(size_t)row0 * 16 + lane] = fminf(z, 0.f) - log1pf(__expf(-fabsf(z)));
                    z = m1 + bb;
                    if (two) ((float*)(ws + WS_LOGF))[(size_t)row1 * 16 + lane] = fminf(z, 0.f) - log1pf(__expf(-fabsf(z))); }
            } else {
                const float bb = lane < 8 ? eb[lane] : 0.f; m0 += bb; m1 += bb;
#pragma unroll
                for (int rr = 0; rr < 2; ++rr) {
                    float a[8];
#pragma unroll
                    for (int h = 0; h < 8; ++h) a[h] = __shfl(rr ? m1 : m0, h);
                    int e0 = 0; float l0 = a[0];
#pragma unroll
                    for (int h = 1; h < 8; ++h) if (a[h] > l0) { l0 = a[h]; e0 = h; }
                    int e1 = -1; float l1 = -__builtin_inff();
#pragma unroll
                    for (int h = 0; h < 8; ++h) if (h != e0 && a[h] > l1) { l1 = a[h]; e1 = h; }
                    const int row = rr ? row1 : row0;
                    if (lane == 0 && (rr == 0 || two)) { const float w0 = 1.f / (1.f + __expf(l1 - l0));
                        ((int*)(ws + RT_E))[row] = e0 | (e1 << 8);
                        ((f32x2*)(ws + RT_W))[row] = (f32x2){w0, 1.f - w0}; }
                }
            }
        }
    }
    if constexpr (EXTRA != 0) __syncthreads();
}
__device__ __forceinline__ void merge_phase(unsigned char* ws, int gw, int NGW, int lane) {
    const bf16* OG = (const bf16*)(ws + S_OG); const float* LSE = (const float*)(ws + WS_LSE); bf16* MIX = (bf16*)(ws + S_MIX);
    for (int tok = gw; tok < TOK; tok += NGW) {
#pragma unroll
        for (int h = 0; h < 6; ++h) {
            const float l0 = LSE[(size_t)tok * 6 + h], l1 = LSE[(size_t)TOK * 6 + (size_t)tok * 6 + h], l2 = LSE[(size_t)2 * TOK * 6 + (size_t)tok * 6 + h];
            const float mx = fmaxf(l0, fmaxf(l1, l2)); const float e0 = __expf(l0 - mx), e1 = __expf(l1 - mx), e2 = __expf(l2 - mx); const float inv = 1.f / (e0 + e1 + e2);
            const unsigned a = *(const unsigned*)(OG + (size_t)tok * 768 + h * 128 + 2 * lane), b = *(const unsigned*)(OG + (size_t)TOK * 768 + (size_t)tok * 768 + h * 128 + 2 * lane),
                           c = *(const unsigned*)(OG + (size_t)2 * TOK * 768 + (size_t)tok * 768 + h * 128 + 2 * lane);
            const float lo = (e0 * bf2f(a & 0xffff) + e1 * bf2f(b & 0xffff) + e2 * bf2f(c & 0xffff)) * inv, hi = (e0 * bf2f(a >> 16) + e1 * bf2f(b >> 16) + e2 * bf2f(c >> 16)) * inv;
            *(unsigned*)(MIX + (size_t)tok * DM + 1280 + h * 128 + 2 * lane) = pk2(lo, hi);
        }
    }
}
__device__ __forceinline__ void scan_phase(unsigned char* ws, LAS float* sm, int bh, int tid) {
    const int b = bh >> 4, h = bh & 15; const float* LOGF = (const float*)(ws + WS_LOGF); float* CUM = (float*)(ws + WS_CUM) + (size_t)bh * SEQ;
    float v[16]; float run = 0.f;
#pragma unroll
    for (int i = 0; i < 16; ++i) { run += LOGF[((size_t)b * SEQ + tid * 16 + i) * 16 + h]; v[i] = run; }
    const int lane = tid & 63, wave = tid >> 6;
    float inc = run;
#pragma unroll
    for (int o = 1; o < 64; o <<= 1) { const float t = __shfl_up(inc, o); if (lane >= o) inc += t; }
    if (lane == 63) sm[wave] = inc;
    __syncthreads();
    float base = inc - run;
#pragma unroll
    for (int w = 0; w < 8; ++w) if (w < wave) base += sm[w];
#pragma unroll
    for (int i = 0; i < 16; ++i) CUM[tid * 16 + i] = base + v[i];
    __syncthreads();
}
__device__ __forceinline__ void dispatch_phase(unsigned char* ws, LAS int* sm, int tid) {
    const int* E = (const int*)(ws + RT_E); int* SLOT = (int*)(ws + RT_SLOT); int* META = (int*)(ws + RT_META); int* ROWIDX = (int*)(ws + RT_ROWIDX);
    int c[8]; LAS int* ev = sm + 8192 + tid * 33;
#pragma unroll
    for (int e = 0; e < 8; ++e) c[e] = 0;
#pragma unroll
    for (int i = 0; i < 8; ++i) { const v4u q = *(const v4u*)(E + tid * 32 + 4 * i); ev[4 * i] = (int)q.x; ev[4 * i + 1] = (int)q.y; ev[4 * i + 2] = (int)q.z; ev[4 * i + 3] = (int)q.w; }
#pragma unroll 2
    for (int i = 0; i < 32; ++i) { const int e0 = ev[i] & 255, e1 = ev[i] >> 8;
#pragma unroll
        for (int e = 0; e < 8; ++e) c[e] += (e0 == e) + (e1 == e); }
#pragma unroll
    for (int e = 0; e < 8; ++e) sm[tid * 8 + e] = c[e];
    __syncthreads();
    { const int wave = tid >> 6, lane = tid & 63;
      int loc[8]; int s = 0;
#pragma unroll
      for (int i = 0; i < 8; ++i) { loc[i] = s; s += sm[(lane * 8 + i) * 8 + wave]; }
      int inc = s;
#pragma unroll
      for (int o = 1; o < 64; o <<= 1) { const int t = __shfl_up(inc, o); if (lane >= o) inc += t; }
      const int exc = inc - s;
      __syncthreads();
#pragma unroll
      for (int i = 0; i < 8; ++i) sm[(lane * 8 + i) * 8 + wave] = exc + loc[i];
      if (lane == 63) sm[4096 + wave] = inc; }
    __syncthreads();
    if (tid == 0) { int off = 0;
        for (int e = 0; e < 8; ++e) { const int n = sm[4096 + e], np = (n + 255) & ~255; META[8 + e] = n; META[16 + e] = off; sm[4104 + e] = off;
            for (int t = off >> 8; t < (off + np) >> 8; ++t) META[32 + t] = e;
            off += np; }
        META[0] = off >> 8; }
    __syncthreads();
    int base[8];
#pragma unroll
    for (int e = 0; e < 8; ++e) base[e] = sm[4104 + e] + sm[tid * 8 + e];
#pragma unroll 2
    for (int i = 0; i < 32; ++i) { const int e0 = ev[i] & 255, e1 = ev[i] >> 8; int s0 = 0, s1 = 0;
#pragma unroll
        for (int e = 0; e < 8; ++e) { if (e0 == e) { s0 = base[e]; base[e]++; } if (e1 == e) { s1 = base[e]; base[e]++; } }
        *(v2u*)(SLOT + (tid * 32 + i) * 2) = (v2u){(unsigned)s0, (unsigned)s1};
#if MOE_GATHER
        ROWIDX[s0] = tid * 32 + i; ROWIDX[s1] = tid * 32 + i;
#endif
    }
#if MOE_GATHER
    for (int e = 0; e < 8; ++e) { const int n = sm[4096 + e], off = sm[4104 + e], np = (n + 255) & ~255;
        for (int r = n + tid; r < np; r += NWAVES * 64) ROWIDX[off + r] = TOK; }
#endif
    __syncthreads();
}
__device__ __forceinline__ void gather_phase(unsigned char* ws, const float* lg, const float* lb, int gw, int NGW, int lane) {
    const pg8::res_t* XR = (const pg8::res_t*)(ws + WS_XR); unsigned char* XP = ws + S_XP; const int* SLOT = (const int*)(ws + RT_SLOT); const int* META = (const int*)(ws + RT_META);
    for (int tok = gw; tok < TOK; tok += NGW) {
        const v2u sl = *(const v2u*)(SLOT + 2 * tok); const int s0 = (int)sl.x, s1 = (int)sl.y;
        const f32x2 st = ((const f32x2*)(ws + WS_STATS))[tok];
#pragma unroll
        for (int j = 0; j < 2; ++j) { const pg8::res_t* xp = XR + (size_t)tok * DM + 16 * (lane + 64 * j); const float* gp = lg + 16 * (lane + 64 * j); const float* bp = lb + 16 * (lane + 64 * j);
#if XR_BF16
            const v4u w0 = *(const v4u*)xp, w1 = *(const v4u*)(xp + 8); const f32x4 xa = pg8::res4(w0.x, w0.y), xb = pg8::res4(w0.z, w0.w), xc = pg8::res4(w1.x, w1.y), xd = pg8::res4(w1.z, w1.w);
#else
            const f32x4 xa = *(const f32x4*)xp, xb = *(const f32x4*)(xp + 4), xc = *(const f32x4*)(xp + 8), xd = *(const f32x4*)(xp + 12);
#endif
            const f32x4 a = (xa - st[0]) * st[1] * *(const f32x4*)gp + *(const f32x4*)bp, b = (xb - st[0]) * st[1] * *(const f32x4*)(gp + 4) + *(const f32x4*)(bp + 4),
                        c = (xc - st[0]) * st[1] * *(const f32x4*)(gp + 8) + *(const f32x4*)(bp + 8), d = (xd - st[0]) * st[1] * *(const f32x4*)(gp + 12) + *(const f32x4*)(bp + 12);
            v4u x; x.x = pg8::pk4_fp8(a[0], a[1], a[2], a[3]); x.y = pg8::pk4_fp8(b[0], b[1], b[2], b[3]); x.z = pg8::pk4_fp8(c[0], c[1], c[2], c[3]); x.w = pg8::pk4_fp8(d[0], d[1], d[2], d[3]);
            *(v4u*)(XP + (size_t)s0 * DM + 16 * (lane + 64 * j)) = x; *(v4u*)(XP + (size_t)s1 * DM + 16 * (lane + 64 * j)) = x; }
    }
    for (int e = 0; e < 8; ++e) { const int n = META[8 + e], off = META[16 + e], np = (n + 255) & ~255; const v4u z = {0u, 0u, 0u, 0u};
        for (int r = n + gw; r < np; r += NGW)
#pragma unroll
            for (int j = 0; j < 2; ++j) *(v4u*)(XP + (size_t)(off + r) * DM + 16 * (lane + 64 * j)) = z; }
}
__device__ __forceinline__ void final_phase(unsigned char* ws, float* out, const float* lg, const float* lb, const float* g, const float* b, int gw, int NGW, int lane) {
    const pg8::res_t* XR = (const pg8::res_t*)(ws + WS_XR); const bf16* YP = (const bf16*)(ws + S_XP); const bf16* YPB = (const bf16*)(ws + R_YPB); const int* SLOT = (const int*)(ws + RT_SLOT); const f32x2* RW = (const f32x2*)(ws + RT_W);
    for (int row = gw; row < TOK; row += NGW) {
        const v2u sl = *(const v2u*)(SLOT + 2 * row); const int s0 = (int)sl.x, s1 = (int)sl.y; const f32x2 w = RW[row]; const f32x2 st = ((const f32x2*)(ws + WS_STATS))[row];
        f32x4 v[8];
#pragma unroll
        for (int j = 0; j < 8; ++j) {
#if XR_BF16
            const v2u xw = *(const v2u*)(XR + (size_t)row * DM + 4 * (lane + 64 * j)); const f32x4 xr = pg8::res4(xw.x, xw.y);
#else
            const f32x4 xr = *(const f32x4*)(XR + (size_t)row * DM + 4 * (lane + 64 * j));
#endif
            const f32x4 x = (xr - st[0]) * st[1] * *(const f32x4*)(lg + 4 * (lane + 64 * j)) + *(const f32x4*)(lb + 4 * (lane + 64 * j));
            const v2u a = *(const v2u*)(YP + (size_t)s0 * DM + 4 * (lane + 64 * j)), c = *(const v2u*)(YP + (size_t)s1 * DM + 4 * (lane + 64 * j));
            f32x4 ya = {bf2f(a.x & 0xffff), bf2f(a.x >> 16), bf2f(a.y & 0xffff), bf2f(a.y >> 16)}, yc = {bf2f(c.x & 0xffff), bf2f(c.x >> 16), bf2f(c.y & 0xffff), bf2f(c.y >> 16)};
            if (s0 >= MOE_MAIN_TILES * 256) { const v2u q = *(const v2u*)(YPB + (size_t)(s0 - MOE_MAIN_TILES * 256) * DM + 4 * (lane + 64 * j)); ya += (f32x4){bf2f(q.x & 0xffff), bf2f(q.x >> 16), bf2f(q.y & 0xffff), bf2f(q.y >> 16)}; }
            if (s1 >= MOE_MAIN_TILES * 256) { const v2u q = *(const v2u*)(YPB + (size_t)(s1 - MOE_MAIN_TILES * 256) * DM + 4 * (lane + 64 * j)); yc += (f32x4){bf2f(q.x & 0xffff), bf2f(q.x >> 16), bf2f(q.y & 0xffff), bf2f(q.y >> 16)}; }
            const f32x4 m = ya * w[0] + yc * w[1];
            v[j] = x * pg8::ALPHA_RES + m; }
        ln_core(v, g, b, lane);
#pragma unroll
        for (int j = 0; j < 8; ++j) *(f32x4*)(out + (size_t)row * DM + 4 * (lane + 64 * j)) = v[j];
    }
}

__device__ __forceinline__ int snake_k(int i, int G, int c) { return (i & 1) ? i * G + (G - 1 - c) : i * G + c; }
__device__ __forceinline__ int snake_count(int total, int G, int c) { int n = 0; while (snake_k(n, G, c) < total) ++n; return n; }
struct FoxList {
    int G, c; unsigned char* ws; int j0, j1, j2, j3, n;
    __device__ __forceinline__ int first_tile(int i) const {
        const int k = snake_k(i, G, c), qb = 31 - (k >> 5), bh = k & 31, b = bh >> 4, h = bh & 15;
        const float* C = (const float*)(ws + WS_CUM) + (size_t)bh * SEQ;
        const unsigned* MP = (const unsigned*)(ws + WS_CTL) + CW_QKMAX;
        const float qm = __uint_as_float(MP[(0 * 2 + b) * 16 + h]), km = __uint_as_float(MP[(1 * 2 + b) * 16 + h]);
        const float S = 1.1f * 0.08838834764831845f * 4.0f * sqrtf(qm * km), thr = -(2.0f * S + 110.0f);
        const int lane = threadIdx.x & 63, nt0 = qb * 4;
        const float c0 = C[qb * 256];
        const bool keep0 = (lane < nt0) ? (c0 - C[64 * lane + 63] >= thr) : true, keep1 = (lane + 64 < nt0) ? (c0 - C[64 * (lane + 64) + 63] >= thr) : true;
        const unsigned long long m0 = __ballot(keep0), m1 = __ballot(keep1);
        int j = m0 ? __builtin_ctzll(m0) : 64 + (m1 ? __builtin_ctzll(m1) : 0);
        return j > nt0 ? nt0 : j; }
    __device__ __forceinline__ void init(int G_, int c_, unsigned char* ws_) { G = G_; c = c_; ws = ws_; n = snake_count(1024, G, c); j0 = j1 = j2 = j3 = 0;
        if (n > 0) j0 = first_tile(0); if (n > 1) j1 = first_tile(1); if (n > 2) j2 = first_tile(2); if (n > 3) j3 = first_tile(3); }
    __device__ __forceinline__ int count() const { return n; }
    __device__ __forceinline__ att::Item get(int i) const {
        const int k = snake_k(i, G, c), qb = 31 - (k >> 5), bh = k & 31, b = bh >> 4, h = bh & 15; att::Item it{};
        const bf16* Q1 = (const bf16*)(ws + R_Q1); const bf16* K1 = (const bf16*)(ws + R_K1); const bf16* V1 = (const bf16*)(ws + R_V1); bf16* MIX = (bf16*)(ws + S_MIX);
        it.Q = Q1 + ((size_t)b * SEQ + qb * 256) * DM + h * 128; it.K = K1 + (size_t)b * SEQ * DM + h * 128; it.V = V1 + (size_t)b * SEQ * DM + h * 128;
        it.O = MIX + ((size_t)b * SEQ + qb * 256) * DM + h * 128; it.C = (const float*)(ws + WS_CUM) + (size_t)bh * SEQ;
        it.Q2 = nullptr; it.K2 = nullptr; it.L = nullptr; it.qp = DM; it.kp = DM; it.vp = DM; it.op = DM; it.qp2 = 0; it.kp2 = 0; it.lp = 0; it.P0 = qb * 256; it.skv = SEQ; it.W = SEQ;
        it.jlo = i == 0 ? j0 : (i == 1 ? j1 : (i == 2 ? j2 : (i == 3 ? j3 : 0)));
        return it; }
};
struct MlaList {
    int G, c; unsigned char* ws;
    __device__ __forceinline__ int count() const { return snake_count(640, G, c); }
    __device__ __forceinline__ att::Item get(int i) const {
        const int k = snake_k(i, G, c), qb = 31 - k / 20, bh = k % 20, b = bh / 10, h = bh % 10; att::Item it{};
        const size_t r0 = (size_t)b * SEQ + qb * 256, k0 = (size_t)b * SEQ;
        it.Q = (const bf16*)(ws + R_QN) + r0 * 1280 + h * 128; it.Q2 = (const bf16*)(ws + R_QR) + r0 * 640 + h * 64;
        it.K = (const bf16*)(ws + R_KN) + k0 * 1280 + h * 128; it.K2 = (const bf16*)(ws + R_KR) + k0 * 64; it.V = (const bf16*)(ws + R_VV) + k0 * 1280 + h * 128;
        it.O = (bf16*)(ws + S_MIX) + r0 * DM + h * 128; it.C = nullptr; it.L = nullptr;
        it.qp = 1280; it.kp = 1280; it.vp = 1280; it.op = DM; it.qp2 = 640; it.kp2 = 64; it.lp = 0; it.P0 = qb * 256; it.skv = SEQ; it.W = SEQ;
        return it; }
};
struct DilList {
    int start, n; unsigned char* ws;
    __device__ __forceinline__ void init(int G, int c) {
        const int tgt = (4224000 + 1152 * 970 + G / 2) / G;
        int acc = 0, prev = 0, cur = 0;
        for (int j = 0; j <= c; ++j) {
            int s = 0; for (int i = 0; snake_k(i, G, j) < 640; ++i) s += 4 * (32 - snake_k(i, G, j) / 20);
            int d = tgt - 100 * s; if (d < 0) d = 0;
            acc += d; prev = cur; cur = (acc + 485) / 970; if (cur > 1152) cur = 1152; }
        if (c == G - 1) cur = 1152;
        if (prev > cur) prev = cur;
        start = prev; n = cur - prev;
    }
    __device__ __forceinline__ int count() const { return n; }
    __device__ __forceinline__ att::Item get(int i) const {
        const int k = start + i, j = k & 31, rest = k >> 5, g = rest % 3, h = (rest / 3) % 6, b = rest / 18, d = 1 << (2 * g), r = j & (d - 1), sb = j >> (2 * g); att::Item it{};
        const size_t t0 = (size_t)b * SEQ + (size_t)sb * 256 * d + r, tk = (size_t)b * SEQ + r;
        it.Q = (const bf16*)(ws + R_DQ) + t0 * 2304 + (g * 6 + h) * 128; it.K = (const bf16*)(ws + R_DK) + tk * 768 + h * 128; it.V = (const bf16*)(ws + R_DV) + tk * 768 + h * 128;
        it.O = (bf16*)(ws + S_OG) + (size_t)g * TOK * 768 + t0 * 768 + h * 128; it.L = (float*)(ws + WS_LSE) + (size_t)g * TOK * 6 + t0 * 6 + h;
        it.Q2 = nullptr; it.K2 = nullptr; it.C = nullptr; it.qp = 2304 * d; it.kp = 768 * d; it.vp = 768 * d; it.op = 768 * d; it.qp2 = 0; it.kp2 = 0; it.lp = 6 * d;
        it.P0 = sb * 256; it.skv = SEQ / d; it.W = 129;
        return it; }
};

struct Args { In in; float* out; unsigned char* ws; int ph_lo, ph_hi; };
static_assert(sizeof(Args) == 240, "kernarg layout");
__global__ void __launch_bounds__(NWAVES * 64, 2) mega_fwd(Args args) {
    extern __shared__ __attribute__((aligned(16))) unsigned char lds[];
    LAS unsigned char* ldsl = (LAS unsigned char*)lds;
    volatile LAS unsigned* MISC = (volatile LAS unsigned*)(ldsl + MISC_OFF);
    const int tid = threadIdx.x, lane = tid & 63, wave = __builtin_amdgcn_readfirstlane(tid >> 6);
    const int G = gridDim.x, bx = blockIdx.x, gw = bx * NWAVES + wave, NGW = G * NWAVES;
    unsigned char* ws = *(unsigned char* const KA_CONST*)((const KA_CONST char*)__builtin_amdgcn_kernarg_segment_ptr() + 224);
    gu32* ctl = (gu32*)(ws + WS_CTL);
    for (int u = tid; u < (LDS_BYTES - LDSCTL_OFF) / 4; u += NWAVES * 64) ((LAS unsigned*)(ldsl + LDSCTL_OFF))[u] = 0u;
    __syncthreads();
#if MK_PER_PHASE
#define GRID_BAR() do { } while (0)
#else
    XcdBarrier bar = xcd_barrier_post((unsigned*)(ctl + CW_BAR), MISC + 8);
#define GRID_BAR() xcd_barrier(bar)
#endif
    const int lo = *(const KA_CONST int*)((const KA_CONST char*)__builtin_amdgcn_kernarg_segment_ptr() + 232), hi = *(const KA_CONST int*)((const KA_CONST char*)__builtin_amdgcn_kernarg_segment_ptr() + 236);
#ifndef PH_MASK
#define PH_MASK 0x7ffff
#endif
#define IN(k) ((((PH_MASK) >> (k)) & 1) && lo <= (k) && (k) < hi)
#define BOTH(k) (IN(k) && IN((k) + 1))
#ifndef REP_MASK
#define REP_MASK 0
#endif
#define REP(k) (((REP_MASK) >> (k)) & 1)
#ifndef EPI_PROBE
#define EPI_PROBE (-1)
#define EPI_PROBE_MODE 1
#define EPI_AMP 8
#endif
#define PB(k) ((k) == EPI_PROBE ? EPI_PROBE_MODE : 0)
#ifndef STG_MODE
#define STG_MODE 0
#endif
#if STG_MODE == 1
#define STG_GRP (bx & 7)
#define STG_G 8
#elif STG_MODE == 2
#define STG_GRP ((bx >> 3) & 3)
#define STG_G 4
#endif
#if STG_MODE
#define STAGGER(period_ticks) do { const unsigned d = (unsigned)STG_GRP * (unsigned)(period_ticks) / STG_G; if (d) { const unsigned long long t0 = __builtin_amdgcn_s_memrealtime(); while (__builtin_amdgcn_s_memrealtime() - t0 < d) __builtin_amdgcn_s_sleep(4); } } while (0)
#else
#define STAGGER(period_ticks) do { } while (0)
#endif
#define EPI_SPIN(k) do { if ((k) == EPI_PROBE) { __syncthreads(); if (bx == 0) { const unsigned long long ticks = (unsigned long long)MISC[32] * EPI_AMP, t0 = __builtin_amdgcn_s_memrealtime(); while (__builtin_amdgcn_s_memrealtime() - t0 < ticks) __builtin_amdgcn_s_sleep(8); } } } while (0)
#define XB ((bf16*)(ws + WS_XB))
#define XR ((pg8::res_t*)(ws + WS_XR))
#if XR_BF16
#define RES0 ((const pg8::res_t*)XB)
#else
#define RES0 ((const pg8::res_t*)INP(0))
#endif
#define MIX ((bf16*)(ws + S_MIX))
#define COS128 ((const float*)(ws + WS_COS128))
#define SIN128 ((const float*)(ws + WS_SIN128))
#define COS64 ((const float*)(ws + WS_COS64))
#define SIN64 ((const float*)(ws + WS_SIN64))
#define SSQ ((float*)(ws + WS_SSQ))

    if (IN(0)) {
#if REP(0)
        p0_prologue(ws, ldsl + RING_OFF, bx, G, gw, NGW, lane, tid); GRID_BAR();
#endif
        p0_prologue(ws, ldsl + RING_OFF, bx, G, gw, NGW, lane, tid); if (BOTH(0)) GRID_BAR(); }
    if (IN(1)) {
        pg8::Gemm g{XB, (const bf16*)(ws + WB_IN), TOK, N_IN, DM}; pg8::StaticOrder S; S.init(TOK, N_IN, G, bx);
        pg8::EpiIn E{(bf16*)(ws + R_DQ), (bf16*)(ws + R_DK), (bf16*)(ws + R_DV), (bf16*)(ws + R_CQ), (bf16*)(ws + R_CKV), (bf16*)(ws + R_KR), SSQ, COS128, SIN128, COS64, SIN64};
#if REP(1)
        pg8::gemm_phase<pg8::EpiIn, pg8::StaticOrder, true, true>(ldsl + RING_OFF, g, S, E); GRID_BAR();
#endif
        STAGGER(4600);
        pg8::gemm_phase<pg8::EpiIn, pg8::StaticOrder, true, true, false, PB(1)>(ldsl + RING_OFF, g, S, E); EPI_SPIN(1);
        if (BOTH(1)) GRID_BAR();
    }
    if (IN(2)) {
        { pg8::Gemm g{(const bf16*)(ws + R_CQ), (const bf16*)(ws + WB_QB), TOK, 2048, 512}; pg8::StaticOrder S; S.init(TOK, 2048, G, bx);
          pg8::EpiQb E{(bf16*)(ws + R_QN), (bf16*)(ws + R_QR), SSQ, COS64, SIN64};
          pg8::gemm_phase<pg8::EpiQb, pg8::StaticOrder, true, true>(ldsl + RING_OFF, g, S, E); }
        { pg8::Gemm g{(const bf16*)(ws + R_CKV), (const bf16*)(ws + WB_KVB), TOK, 2560, 256}; pg8::StaticOrder S; S.init(TOK, 2560, G, bx);
          pg8::EpiKvb E{(bf16*)(ws + R_KN), (bf16*)(ws + R_VV), SSQ};
          pg8::gemm_phase<pg8::EpiKvb, pg8::StaticOrder, true, true>(ldsl + RING_OFF, g, S, E); }
        if (BOTH(2)) GRID_BAR();
    }
    if (IN(3)) {
        if (CONV_CUS && bx < CONV_CUS) { conv_run_dma(ws, ldsl + RING_OFF, tid, CONV_CUS, bx); __syncthreads(); conv_run(ws, ldsl + RING_OFF, tid, T_EARLY, T_NONEXP, CONV_CUS, bx); }
        else {
            const int Ga = G - CONV_CUS, ca = bx - CONV_CUS;
            { MlaList L{Ga, ca, ws}; att::attn_run<2, MlaList>((char*)lds + RING_OFF, L); }
            { DilList L; L.ws = ws; L.init(Ga, ca); att::attn_run<0, DilList>((char*)lds + RING_OFF, L); }
        }
        if (BOTH(3)) GRID_BAR();
    }
    if (IN(4)) {
#ifdef THIN_PROBE
        merge_phase(ws, gw, NGW, lane); GRID_BAR();
#endif
        merge_phase(ws, gw, NGW, lane); if (BOTH(4)) GRID_BAR(); }
    if (IN(5)) {
        pg8::Gemm g{MIX, (const bf16*)(ws + WB_O0), TOK, DM, DM}; pg8::StaticOrder S; S.init(TOK, DM, G, bx);
        pg8::EpiRes E{RES0, XR, 1.f, nullptr, nullptr, nullptr};
        pg8::gemm_phase<pg8::EpiRes, pg8::StaticOrder, true, true, false, PB(5)>(ldsl + RING_OFF, g, S, E); EPI_SPIN(5);
        if (BOTH(5)) GRID_BAR();
    }
    if (IN(6)) {
        ln_phase<0, FFN_GU_F8 != 0>(XR, XB, INP(7), INP(8), nullptr, nullptr, ws, (LAS float*)(ldsl + RING_OFF), gw, NGW, lane, tid); if (BOTH(6)) GRID_BAR(); }
    if (IN(7)) {
        pg8::Gemm g{XB, (const bf16*)(ws + WB_GU), TOK, 2 * DFF, FFN_GU_F8 ? DM / 2 : DM}; pg8::StaticOrder S; S.init(TOK, 2 * DFF, G, bx);
#if FFN_DN_F8
        pg8::EpiSwiglu8 E{ws + R_HF, DFF};
        pg8::gemm_phase<pg8::EpiSwiglu8, pg8::StaticOrder, true, true, true>(ldsl + RING_OFF, g, S, E);
#else
        pg8::EpiSwiglu E{(bf16*)(ws + R_HF), DFF, 0, FFN_GU_F8 ? 1.f / pg8::W8_SCALE : 1.f};
        STAGGER(2600);
        pg8::gemm_phase<pg8::EpiSwiglu, pg8::StaticOrder, true, true, FFN_GU_F8 != 0, PB(7)>(ldsl + RING_OFF, g, S, E); EPI_SPIN(7);
#endif
        if (BOTH(7)) GRID_BAR();
    }
    if (IN(8)) {
        pg8::Gemm g{(const bf16*)(ws + R_HF), (const bf16*)(ws + WB_DN), TOK, DM, FFN_DN_F8 ? DFF / 2 : DFF}; pg8::StaticOrder S; S.init(TOK, DM, G, bx);
        pg8::EpiRes E{XR, XR, FFN_DN_F8 ? 1.f / (pg8::W8_SCALE * pg8::H8_SCALE) : 1.f, (const float*)(ws + WS_STATS), INP(7), INP(8)};
        pg8::gemm_phase<pg8::EpiRes, pg8::StaticOrder, true, true, FFN_DN_F8 != 0, PB(8)>(ldsl + RING_OFF, g, S, E); EPI_SPIN(8);
        if (BOTH(8)) GRID_BAR();
    }
    if (IN(9)) {
        ln_phase<1, QKV_F8 != 0>(XR, XB, INP(12), INP(13), INP(15), INP(16), ws, (LAS float*)(ldsl + RING_OFF), gw, NGW, lane, tid); if (BOTH(9)) GRID_BAR(); }
    if (IN(10)) {
        if (bx < 32) scan_phase(ws, (LAS float*)(ldsl + RING_OFF), bx, tid);
        pg8::Gemm g{XB, (const bf16*)(ws + WB_QKV), TOK, 3 * DM, QKV_F8 ? DM / 2 : DM}; pg8::StaticOrder S; S.init(TOK, 3 * DM, G, bx);
        pg8::EpiPlain E{(bf16*)(ws + R_Q1), DM, DM, (size_t)TOK * DM, QKV_F8 ? 1.f / pg8::W8_SCALE : 1.f, (unsigned*)(ws + WS_CTL) + CW_QKMAX};
#if REP(10)
        pg8::gemm_phase<pg8::EpiPlain, pg8::StaticOrder, true, true, QKV_F8 != 0>(ldsl + RING_OFF, g, S, E); GRID_BAR();
#endif
        pg8::gemm_phase<pg8::EpiPlain, pg8::StaticOrder, true, true, QKV_F8 != 0, PB(10)>(ldsl + RING_OFF, g, S, E); EPI_SPIN(10);
        if (BOTH(10)) GRID_BAR();
    }
    if (IN(11)) {
#if REP(11)
        for (int rep_ = 0; rep_ < 2; ++rep_) { FoxList L; L.init(G, bx, ws); att::attn_run<1, FoxList>((char*)lds + RING_OFF, L); GRID_BAR(); }
#else
        { FoxList L; L.init(G, bx, ws); att::attn_run<1, FoxList>((char*)lds + RING_OFF, L); } if (BOTH(11)) GRID_BAR();
#endif
    }
    if (IN(12)) {
        pg8::Gemm g{MIX, (const bf16*)(ws + WB_O1), TOK, DM, DM}; pg8::StaticOrder S; S.init(TOK, DM, G, bx);
        pg8::EpiRes E{XR, XR, 1.f, (const float*)(ws + WS_STATS), INP(12), INP(13)};
        pg8::gemm_phase<pg8::EpiRes, pg8::StaticOrder, true, true, false, PB(12)>(ldsl + RING_OFF, g, S, E); EPI_SPIN(12);
        if (BOTH(12)) GRID_BAR();
    }
    if (IN(13)) {
#if MOE_GATHER
        ln_phase<2, true, true>(XR, XB, INP(18), INP(19), INP(20), INP(21), ws, (LAS float*)(ldsl + RING_OFF), gw, NGW, lane, tid);
        if (gw == 0) { unsigned char* z = (unsigned char*)XB + (size_t)TOK * DM + lane * 32; const v4u zz = {0u, 0u, 0u, 0u}; *(v4u*)z = zz; *(v4u*)(z + 16) = zz; }
#else
        ln_phase<2, false, false>(XR, XB, INP(18), INP(19), INP(20), INP(21), ws, (LAS float*)(ldsl + RING_OFF), gw, NGW, lane, tid);
#endif
        if (BOTH(13)) GRID_BAR(); }
    if (IN(14)) {
#ifdef THIN_PROBE
        if (bx == 0) dispatch_phase(ws, (LAS int*)(ldsl + RING_OFF), tid); GRID_BAR();
#endif
        if (bx == 0) dispatch_phase(ws, (LAS int*)(ldsl + RING_OFF), tid); if (BOTH(14)) GRID_BAR(); }
#if !MOE_GATHER
    if (IN(15)) {
#ifdef THIN_PROBE
        gather_phase(ws, INP(18), INP(19), gw, NGW, lane); GRID_BAR();
#endif
        gather_phase(ws, INP(18), INP(19), gw, NGW, lane); if (BOTH(15)) GRID_BAR(); }
#endif
    if (IN(16) || IN(17)) {
        const int* META = (const int*)(ws + RT_META);
        const int ntiles = __builtin_amdgcn_readfirstlane(ld_i(META));
        if (IN(16)) {
#if MOE_GATHER
            pg8::Gemm g{(const bf16*)XB, (const bf16*)(ws + WB_EGU), 0, 2 * DFF, DM / 2}; pg8::MoeGatherOrder S; S.init(ntiles, 2 * DFF, G, bx, 0, META + 32, (size_t)2 * DFF * DM); S.rowidx = (const int*)(ws + RT_ROWIDX);
            typedef pg8::MoeGatherOrder GuOrder;
#else
            pg8::Gemm g{(const bf16*)(ws + S_XP), (const bf16*)(ws + WB_EGU), 0, 2 * DFF, DM / 2}; pg8::MoeOrder S; S.init(ntiles, 2 * DFF, G, bx, 0, META + 32, (size_t)2 * DFF * DM);
            typedef pg8::MoeOrder GuOrder;
#endif
            pg8::EpiSwiglu8 E{ws + R_HE, DFF};
#if REP(16)
            pg8::gemm_phase<pg8::EpiSwiglu8, GuOrder, true, true, true>(ldsl + RING_OFF, g, S, E); GRID_BAR();
#endif
            STAGGER(2400);
            pg8::gemm_phase<pg8::EpiSwiglu8, GuOrder, true, true, true, PB(16)>(ldsl + RING_OFF, g, S, E); EPI_SPIN(16);
            if (BOTH(16)) GRID_BAR();
        }
        if (IN(17)) {
            const int nmain = ntiles < MOE_MAIN_TILES ? ntiles : MOE_MAIN_TILES;
            { pg8::Gemm g{(const bf16*)(ws + R_HE), (const bf16*)(ws + WB_EDN), 0, DM, DFF / 2}; pg8::MoeOrder S; S.init(nmain, DM, G, bx, 0, META + 32, (size_t)DM * DFF);
              pg8::EpiPlainS E{(bf16*)(ws + S_XP), DM, 1.f / (pg8::W8_SCALE * pg8::H8_SCALE), nullptr, 0};
              pg8::gemm_phase<pg8::EpiPlainS, pg8::MoeOrder, true, true, true>(ldsl + RING_OFF, g, S, E); }
            if (ntiles > MOE_MAIN_TILES) {
              pg8::Gemm g{(const bf16*)(ws + R_HE), (const bf16*)(ws + WB_EDN), 0, DM, DFF / 2, DFF / 4}; pg8::TailOrder S{MOE_MAIN_TILES, ntiles - MOE_MAIN_TILES, G, bx, META + 32, (size_t)DM * DFF, (size_t)DFF / 2};
              pg8::EpiPlainS E{(bf16*)(ws + S_XP), DM, 1.f / (pg8::W8_SCALE * pg8::H8_SCALE), (bf16*)(ws + R_YPB), MOE_MAIN_TILES * 256};
              pg8::gemm_phase<pg8::EpiPlainS, pg8::TailOrder, true, true, true>(ldsl + RING_OFF, g, S, E); }
            if (BOTH(17)) GRID_BAR();
        }
    }
    if (IN(18)) {
#ifdef THIN_PROBE
        final_phase(ws, *(float* const KA_CONST*)((const KA_CONST char*)__builtin_amdgcn_kernarg_segment_ptr() + 216), INP(18), INP(19), INP(25), INP(26), gw, NGW, lane); GRID_BAR();
#endif
#ifdef BAR_PROBE
        for (int i_ = 0; i_ < 20; ++i_) GRID_BAR();
#endif
        final_phase(ws, *(float* const KA_CONST*)((const KA_CONST char*)__builtin_amdgcn_kernarg_segment_ptr() + 216), INP(18), INP(19), INP(25), INP(26), gw, NGW, lane); }
#undef IN
#undef BOTH
#undef GRID_BAR
#undef XB
#undef XR
#undef RES0
#undef MIX
#undef COS128
#undef SIN128
#undef COS64
#undef SIN64
#undef SSQ
}

extern "C" void kernel_launch(void* const* d_in, const int* in_sizes, int n_in, void* d_out, int out_size, void* d_ws, size_t ws_size, hipStream_t stream) {
    static int grid = 0;
    if (grid == 0) {
        if (n_in != 27 || in_sizes[0] != TOK * DM || out_size != TOK * DM || ws_size < WS_END) {
            fprintf(stderr, "kernel_launch: built for 27 inputs, x/out of %d floats, >= %zu bytes of workspace; got n_in %d, in0 %d, out %d, ws %zu; nothing launched\n", TOK * DM, (size_t)WS_END, n_in, n_in > 0 ? in_sizes[0] : -1, out_size, ws_size);
            grid = -1; return; }
        int dev = 0, cus = 0, per_cu = 0;
        if (hipGetDevice(&dev) != hipSuccess || hipDeviceGetAttribute(&cus, hipDeviceAttributeMultiprocessorCount, dev) != hipSuccess) { fprintf(stderr, "kernel_launch: device query failed\n"); grid = -1; return; }
        if (hipFuncSetAttribute((const void*)mega_fwd, hipFuncAttributeMaxDynamicSharedMemorySize, LDS_BYTES) != hipSuccess) { fprintf(stderr, "kernel_launch: hipFuncSetAttribute failed\n"); grid = -1; return; }
        if (hipOccupancyMaxActiveBlocksPerMultiprocessor(&per_cu, (const void*)mega_fwd, NWAVES * 64, LDS_BYTES) != hipSuccess || per_cu < 1)
            fprintf(stderr, "kernel_launch: note: occupancy query reports %d workgroups per CU\n", per_cu);
        (void)hipGetLastError();
        grid = cus;
    }
    if (grid < 0) return;
    if (hipMemsetAsync((char*)d_ws + WS_CTL, 0, CTL_ZERO_BYTES, stream) != hipSuccess) { fprintf(stderr, "kernel_launch: memset failed\n"); return; }
    Args a{};
    for (int i = 0; i < 27; ++i) a.in.p[i] = (const float*)d_in[i];
    a.out = (float*)d_out; a.ws = (unsigned char*)d_ws;
#if MK_PER_PHASE
    for (int ph = 0; ph < NPH; ++ph) { a.ph_lo = ph; a.ph_hi = ph + 1; hipLaunchKernelGGL(mega_fwd, dim3(grid), dim3(NWAVES * 64), LDS_BYTES, stream, a); }
#else
    a.ph_lo = 0; a.ph_hi = NPH; hipLaunchKernelGGL(mega_fwd, dim3(grid), dim3(NWAVES * 64), LDS_BYTES, stream, a);
#endif
    const hipError_t le = hipPeekAtLastError();
    if (le != hipSuccess) fprintf(stderr, "kernel_launch: launch failed: %s\n", hipGetErrorName(le));
}
```

```cpp
#include <hip/hip_runtime.h>
#include <cstdio>
#include <cstdint>
namespace pg8 {
#define PG8_LAS __attribute__((address_space(3)))
typedef unsigned short bf16_t;
typedef short bf16x8 __attribute__((ext_vector_type(8)));
typedef float f32x4 __attribute__((ext_vector_type(4)));
typedef unsigned u32x4 __attribute__((ext_vector_type(4)));
constexpr int BM = 256, BK = 64, HALF = 128, HTB = HALF * BK * 2  , STAGE_BYTES = 8 * HTB, NXCD = 8, WGM = 8;

__host__ __device__ __forceinline__ int lds_byte(int r, int c) { const int st = (r >> 4) * 2 + (c >> 5), rr = r & 15, cc = c & 31, ob = rr * 64 + cc * 2; return st * 1024 + (ob ^ (((ob >> 9) & 1) << 5)); }
__host__ __device__ __forceinline__ void stage_rc(int b, int& R, int& C) { const int st = b / 1024, sb = b % 1024, swz = sb ^ (((sb >> 9) & 1) << 5); R = (st >> 1) * 16 + swz / 64; C = (st & 1) * 32 + (swz % 64) / 2; }
__host__ __device__ __forceinline__ int perm32(int rho) { const int n = rho >> 4, i = rho & 15; return 8 * (i >> 2) + 4 * n + (i & 3); }

struct Unit { int pm, pn, kh; };
struct Gemm { const bf16_t* A; const bf16_t* Bt; int M, N, K; int Kl = 0; };

struct StaticOrder {
    int nM, nN, nwg, G, c;
    __host__ __device__ void init(int M, int N, int G_, int c_) { nM = M / BM; nN = N / BM; nwg = nM * nN; G = G_; c = c_; }
    __host__ __device__ bool next(int i, Unit& u) const {
        const long L = (long)i * G + c; if (L >= nwg) return false;
        int wgid = (int)L; { const int q = nwg / NXCD, r = nwg % NXCD, xcd = wgid % NXCD, off = wgid / NXCD; wgid = (xcd < r ? xcd * (q + 1) : r * (q + 1) + (xcd - r) * q) + off; }
        const int nig = WGM * nN, gid = wgid / nig, fm = gid * WGM, gsz = (nM - fm) < WGM ? (nM - fm) : WGM;
        u.pm = fm + ((wgid % nig) % gsz); u.pn = (wgid % nig) / gsz; u.kh = 0; return true;
    }
    __device__ __forceinline__ const char* bbase(const Gemm& g, const Unit&) const { return (const char*)g.Bt; }
    __device__ __forceinline__ size_t aoff(const Unit&) const { return 0; }
    __device__ __forceinline__ void a_ready(const Unit&) const {}
    __device__ __forceinline__ void done(const Unit&) const {}
};

__device__ __forceinline__ unsigned cvt_pk_bf16(float lo, float hi) { unsigned r; asm volatile("v_cvt_pk_bf16_f32 %0, %1, %2" : "=v"(r) : "v"(lo), "v"(hi)); return r; }
__device__ __forceinline__ u32x4 pack8(f32x4 a, f32x4 b) { u32x4 w; w.x = cvt_pk_bf16(a[0], a[1]); w.y = cvt_pk_bf16(a[2], a[3]); w.z = cvt_pk_bf16(b[0], b[1]); w.w = cvt_pk_bf16(b[2], b[3]); return w; }
__device__ __forceinline__ float sq4(f32x4 v) { return (v[0] * v[0] + v[1] * v[1]) + (v[2] * v[2] + v[3] * v[3]); }
typedef int i32x8 __attribute__((ext_vector_type(8)));
typedef int i32x4 __attribute__((ext_vector_type(4)));
typedef float f32x2 __attribute__((ext_vector_type(2)));
#ifndef XR_BF16
#define XR_BF16 2
#endif
#if XR_BF16
typedef bf16_t res_t;
#else
typedef float res_t;
#endif
typedef _Float16 f16x2 __attribute__((ext_vector_type(2)));
typedef unsigned u32x2s __attribute__((ext_vector_type(2)));
template <int CTRL> __device__ __forceinline__ float dpp_f(float v) { return __builtin_bit_cast(float, __builtin_amdgcn_update_dpp(0, __builtin_bit_cast(int, v), CTRL, 0xf, 0xf, false)); }
__device__ __forceinline__ float row16_sum(float v) { v += dpp_f<0xB1>(v); v += dpp_f<0x4E>(v); v += dpp_f<0x141>(v); v += dpp_f<0x140>(v); return v; }
__device__ __forceinline__ float row16_max(float v) { v = fmaxf(v, dpp_f<0xB1>(v)); v = fmaxf(v, dpp_f<0x4E>(v)); v = fmaxf(v, dpp_f<0x141>(v)); v = fmaxf(v, dpp_f<0x140>(v)); return v; }
__device__ __forceinline__ float xsum16(float v) { float a = v, b = v; asm("s_nop 1\n\tv_permlane16_swap_b32 %0, %1" : "+v"(a), "+v"(b)); return a + b; }
__device__ __forceinline__ float xsum32(float v) { float a = v, b = v; asm("s_nop 1\n\tv_permlane32_swap_b32 %0, %1" : "+v"(a), "+v"(b)); return a + b; }
__device__ __forceinline__ f32x4 bf4(unsigned lo, unsigned hi) { return (f32x4){__builtin_bit_cast(float, lo << 16), __builtin_bit_cast(float, lo & 0xffff0000u), __builtin_bit_cast(float, hi << 16), __builtin_bit_cast(float, hi & 0xffff0000u)}; }
#if XR_BF16 == 2
__device__ __forceinline__ f32x4 res4(unsigned lo, unsigned hi) { const f16x2 a = __builtin_bit_cast(f16x2, lo), b = __builtin_bit_cast(f16x2, hi); return (f32x4){(float)a[0], (float)a[1], (float)b[0], (float)b[1]}; }
__device__ __forceinline__ unsigned res_pk2(float a, float b) { const f16x2 h = {(_Float16)a, (_Float16)b}; return __builtin_bit_cast(unsigned, h); }
__device__ __forceinline__ u32x4 res_pack8(f32x4 a, f32x4 b) { u32x4 w; w.x = res_pk2(a[0], a[1]); w.y = res_pk2(a[2], a[3]); w.z = res_pk2(b[0], b[1]); w.w = res_pk2(b[2], b[3]); return w; }
#else
__device__ __forceinline__ f32x4 res4(unsigned lo, unsigned hi) { return bf4(lo, hi); }
__device__ __forceinline__ u32x4 res_pack8(f32x4 a, f32x4 b) { return pack8(a, b); }
#endif
__device__ __forceinline__ i32x8 cat8(bf16x8 lo, bf16x8 hi) { const i32x4 a = __builtin_bit_cast(i32x4, lo), b = __builtin_bit_cast(i32x4, hi); return __builtin_shufflevector(a, b, 0, 1, 2, 3, 4, 5, 6, 7); }
__device__ __forceinline__ void mfma8(f32x4& c, const i32x8 a, const i32x8 b) { asm volatile("v_mfma_f32_16x16x128_f8f6f4 %0, %1, %2, %0" : "+v"(c) : "v"(a), "v"(b)); }
constexpr float ALPHA_RES = 1.41421356237309515f;

struct MoeOrder {
    StaticOrder so; int t0; const int* texp; size_t estride;
    __device__ __forceinline__ void init(int ntiles, int N, int G_, int c_, int t0_, const int* texp_, size_t estride_) { so.init(ntiles * BM, N, G_, c_); t0 = t0_; texp = texp_; estride = estride_; }
    __device__ __forceinline__ bool next(int i, Unit& u) const { if (!so.next(i, u)) return false; u.pm += t0; return true; }
    __device__ __forceinline__ const char* bbase(const Gemm& g, const Unit& u) const {
        const int e = __builtin_amdgcn_readfirstlane(__hip_atomic_load(texp + u.pm, __ATOMIC_RELAXED, __HIP_MEMORY_SCOPE_AGENT));
        return (const char*)g.Bt + (size_t)e * estride; }
    __device__ __forceinline__ size_t aoff(const Unit&) const { return 0; }
    __device__ __forceinline__ void a_ready(const Unit&) const {}
    __device__ __forceinline__ void done(const Unit&) const {}
};
struct TailOrder {
    int t0, nrt, G, c; const int* texp; size_t estride, khbytes;
    __device__ __forceinline__ bool next(int i, Unit& u) const { const int L = i * G + c; if (L >= nrt * 16) return false; u.kh = L & 1; u.pn = (L >> 1) & 7; u.pm = t0 + (L >> 4); return true; }
    __device__ __forceinline__ const char* bbase(const Gemm& g, const Unit& u) const {
        const int e = __builtin_amdgcn_readfirstlane(__hip_atomic_load(texp + u.pm, __ATOMIC_RELAXED, __HIP_MEMORY_SCOPE_AGENT));
        return (const char*)g.Bt + (size_t)e * estride + (size_t)u.kh * khbytes; }
    __device__ __forceinline__ size_t aoff(const Unit& u) const { return (size_t)u.kh * khbytes; }
    __device__ __forceinline__ void a_ready(const Unit&) const {}
    __device__ __forceinline__ void done(const Unit&) const {}
};

struct EpiIn {
    static constexpr bool PERM = true, AFTER_DRAIN = false;
    bf16_t *DQ, *DK, *DV, *CQ, *CKV, *KR; float* SSQ; const float *cos128, *sin128, *cos64, *sin64;
    __device__ __forceinline__ void rope_tile(const f32x4 (&acc)[2][2][4][2], bf16_t* base, int pitch, int head, int i0, int row0) const {
        f32x4 c0[2], c1[2], s0[2], s1[2];
#define EPIIN_LOAD(k) _Pragma("unroll") for (int q = 0; q < 2; ++q) { const int it = 2 * (k) + q, pos = (row0 + (it >> 2) * HALF + (it & 3) * 16) & 8191; \
            c0[q] = *(const f32x4*)(cos128 + pos * 64 + i0); c1[q] = *(const f32x4*)(cos128 + pos * 64 + i0 + 4); s0[q] = *(const f32x4*)(sin128 + pos * 64 + i0); s1[q] = *(const f32x4*)(sin128 + pos * 64 + i0 + 4); }
        EPIIN_LOAD(0)
#pragma unroll
        for (int k = 0; k < 4; ++k) {
            u32x4 w0[2], w1[2];
#pragma unroll
            for (int q = 0; q < 2; ++q) { const int it = 2 * k + q, ai = it >> 2, m = it & 3;
                const f32x4 a0 = acc[ai][0][m][0], a1 = acc[ai][0][m][1], b0 = acc[ai][1][m][0], b1 = acc[ai][1][m][1];
                w0[q] = pack8(a0 * c0[q] - b0 * s0[q], a1 * c1[q] - b1 * s1[q]); w1[q] = pack8(b0 * c0[q] + a0 * s0[q], b1 * c1[q] + a1 * s1[q]); }
            if (k < 3) { EPIIN_LOAD(k + 1) }
#pragma unroll
            for (int q = 0; q < 2; ++q) { const int it = 2 * k + q, row = row0 + (it >> 2) * HALF + (it & 3) * 16;
                bf16_t* p = base + (size_t)row * pitch + head * 128 + i0; *(u32x4*)p = w0[q]; *(u32x4*)(p + 64) = w1[q]; }
        }
#undef EPIIN_LOAD
    }
    __device__ __forceinline__ void operator()(const f32x4 (&acc)[2][2][4][2], const Unit& u, int wr, int wc, int fr, int fq) const {
        const int t = u.pn, row0 = u.pm * BM + wr * 64 + fr;
        if (t < 12) {
            bf16_t* base; int pitch, head0;
            if (t < 9) { base = DQ; pitch = 2304; head0 = 2 * t; } else { base = DK; pitch = 768; head0 = 2 * (t - 9); }
            const int ch = wc * 32 + 8 * fq, head = head0 + (ch >> 6), i0 = ch & 63;
            rope_tile(acc, base, pitch, head, i0, row0);
        } else if (t < 15) {
#pragma unroll
            for (int ai = 0; ai < 2; ++ai)
#pragma unroll
                for (int m = 0; m < 4; ++m) {
                    const int row = row0 + ai * HALF + m * 16;
#pragma unroll
                    for (int bj = 0; bj < 2; ++bj) *(u32x4*)(DV + (size_t)row * 768 + (t - 12) * 256 + bj * HALF + wc * 32 + 8 * fq) = pack8(acc[ai][bj][m][0], acc[ai][bj][m][1]);
                }
        } else if (t < 17) {
#pragma unroll
            for (int ai = 0; ai < 2; ++ai)
#pragma unroll
                for (int m = 0; m < 4; ++m) {
                    const int row = row0 + ai * HALF + m * 16; float s = 0.f;
#pragma unroll
                    for (int bj = 0; bj < 2; ++bj) { *(u32x4*)(CQ + (size_t)row * 512 + (t - 15) * 256 + bj * HALF + wc * 32 + 8 * fq) = pack8(acc[ai][bj][m][0], acc[ai][bj][m][1]);
                        s += sq4(acc[ai][bj][m][0]) + sq4(acc[ai][bj][m][1]); }
                    s = xsum16(s); s = xsum32(s);
                    if (fq == 0) SSQ[(size_t)row * 12 + (t - 15) * 4 + wc] = s;
                }
        } else {
#pragma unroll
            for (int ai = 0; ai < 2; ++ai)
#pragma unroll
                for (int m = 0; m < 4; ++m) {
                    const int row = row0 + ai * HALF + m * 16, pos = row & 8191;
                    if (wc < 2) {
                        float s = 0.f;
#pragma unroll
                        for (int bj = 0; bj < 2; ++bj) { *(u32x4*)(CKV + (size_t)row * 256 + bj * 64 + wc * 32 + 8 * fq) = pack8(acc[ai][bj][m][0], acc[ai][bj][m][1]);
                            s += sq4(acc[ai][bj][m][0]) + sq4(acc[ai][bj][m][1]); }
                        s = xsum16(s); s = xsum32(s);
                        if (fq == 0) SSQ[(size_t)row * 12 + 8 + wc] = s;
                    } else {
                        const u32x4 z = {0u, 0u, 0u, 0u};
#pragma unroll
                        for (int bj = 0; bj < 2; ++bj) *(u32x4*)(CKV + (size_t)row * 256 + 128 + (wc - 2) * 64 + bj * 32 + 8 * fq) = z;
                        if (wc == 2) {
                            const int i0 = 8 * fq;
                            const f32x4 c0 = *(const f32x4*)(cos64 + pos * 32 + i0), c1 = *(const f32x4*)(cos64 + pos * 32 + i0 + 4);
                            const f32x4 s0 = *(const f32x4*)(sin64 + pos * 32 + i0), s1 = *(const f32x4*)(sin64 + pos * 32 + i0 + 4);
                            const f32x4 a0 = acc[ai][0][m][0], a1 = acc[ai][0][m][1], b0 = acc[ai][1][m][0], b1 = acc[ai][1][m][1];
                            bf16_t* p = KR + (size_t)row * 64 + i0;
                            *(u32x4*)p = pack8(a0 * c0 - b0 * s0, a1 * c1 - b1 * s1);
                            *(u32x4*)(p + 32) = pack8(b0 * c0 + a0 * s0, b1 * c1 + a1 * s1);
                        }
                    }
                }
        }
    }
};

struct EpiQb {
    static constexpr bool PERM = true, AFTER_DRAIN = false;
    bf16_t *QN, *QR; const float* SSQ; const float *cos64, *sin64;
    __device__ __forceinline__ void rope_tile(const f32x4 (&acc)[2][2][4][2], const float (&rs)[8], int head, int i0, int row0) const {
        f32x4 c0[2], c1[2], s0[2], s1[2];
#define EPIQB_LOAD(k) _Pragma("unroll") for (int q = 0; q < 2; ++q) { const int it = 2 * (k) + q, pos = (row0 + (it >> 2) * HALF + (it & 3) * 16) & 8191; \
            c0[q] = *(const f32x4*)(cos64 + pos * 32 + i0); c1[q] = *(const f32x4*)(cos64 + pos * 32 + i0 + 4); s0[q] = *(const f32x4*)(sin64 + pos * 32 + i0); s1[q] = *(const f32x4*)(sin64 + pos * 32 + i0 + 4); }
        EPIQB_LOAD(0)
#pragma unroll
        for (int k = 0; k < 4; ++k) {
            u32x4 w0[2], w1[2];
#pragma unroll
            for (int q = 0; q < 2; ++q) { const int it = 2 * k + q, ai = it >> 2, m = it & 3; const float r = rs[it];
                const f32x4 a0 = acc[ai][0][m][0] * r, a1 = acc[ai][0][m][1] * r, b0 = acc[ai][1][m][0] * r, b1 = acc[ai][1][m][1] * r;
                w0[q] = pack8(a0 * c0[q] - b0 * s0[q], a1 * c1[q] - b1 * s1[q]); w1[q] = pack8(b0 * c0[q] + a0 * s0[q], b1 * c1[q] + a1 * s1[q]); }
            if (k < 3) { EPIQB_LOAD(k + 1) }
#pragma unroll
            for (int q = 0; q < 2; ++q) { const int it = 2 * k + q, row = row0 + (it >> 2) * HALF + (it & 3) * 16;
                bf16_t* p = QR + (size_t)row * 640 + head * 64 + i0; *(u32x4*)p = w0[q]; *(u32x4*)(p + 32) = w1[q]; }
        }
#undef EPIQB_LOAD
    }
    __device__ __forceinline__ void operator()(const f32x4 (&acc)[2][2][4][2], const Unit& u, int wr, int wc, int fr, int fq) const {
        const int t = u.pn, row0 = u.pm * BM + wr * 64 + fr;
        float rs[8];
#pragma unroll
        for (int h = 0; h < 2; ++h) { f32x4 q0[4], q1[4];
#pragma unroll
            for (int m = 0; m < 4; ++m) { const int row = row0 + h * HALF + m * 16; q0[m] = *(const f32x4*)(SSQ + (size_t)row * 12); q1[m] = *(const f32x4*)(SSQ + (size_t)row * 12 + 4); }
#pragma unroll
            for (int m = 0; m < 4; ++m) { const f32x4 a = q0[m], b = q1[m]; rs[h * 4 + m] = 1.0f / sqrtf((((a[0] + a[1]) + (a[2] + a[3])) + ((b[0] + b[1]) + (b[2] + b[3]))) * (1.0f / 448.0f) + 1e-6f); } }
        if (t < 5) {
#pragma unroll
            for (int ai = 0; ai < 2; ++ai)
#pragma unroll
                for (int m = 0; m < 4; ++m) { const int row = row0 + ai * HALF + m * 16; const float r = rs[ai * 4 + m];
#pragma unroll
                    for (int bj = 0; bj < 2; ++bj) *(u32x4*)(QN + (size_t)row * 1280 + t * 256 + bj * HALF + wc * 32 + 8 * fq) = pack8(acc[ai][bj][m][0] * r, acc[ai][bj][m][1] * r); }
        } else {
            const int head = 4 * (t - 5) + wc, i0 = 8 * fq;
            if (head < 10) rope_tile(acc, rs, head, i0, row0);
        }
    }
};

struct EpiKvb {
    static constexpr bool PERM = true, AFTER_DRAIN = false;
    bf16_t *KN, *VV; const float* SSQ;
    __device__ __forceinline__ void operator()(const f32x4 (&acc)[2][2][4][2], const Unit& u, int wr, int wc, int fr, int fq) const {
        const int t = u.pn, row0 = u.pm * BM + wr * 64 + fr;
#pragma unroll
        for (int ai = 0; ai < 2; ++ai)
#pragma unroll
            for (int m = 0; m < 4; ++m) {
                const int row = row0 + ai * HALF + m * 16;
                const float rs = 1.0f / sqrtf((SSQ[(size_t)row * 12 + 8] + SSQ[(size_t)row * 12 + 9]) * (1.0f / 128.0f) + 1e-6f);
                *(u32x4*)(KN + (size_t)row * 1280 + t * 128 + wc * 32 + 8 * fq) = pack8(acc[ai][0][m][0] * rs, acc[ai][0][m][1] * rs);
                *(u32x4*)(VV + (size_t)row * 1280 + t * 128 + wc * 32 + 8 * fq) = pack8(acc[ai][1][m][0] * rs, acc[ai][1][m][1] * rs);
            }
    }
};

#if XR_BF16
struct EpiRes {
    static constexpr bool PERM = true, AFTER_DRAIN = false;
    const bf16_t* res; bf16_t* out; float s;
    const float* st; const float* g; const float* b;
    __device__ __forceinline__ void operator()(const f32x4 (&acc)[2][2][4][2], const Unit& u, int wr, int wc, int fr, int fq) const {
        const int row0 = u.pm * BM + wr * 64 + fr, col0 = u.pn * BM + wc * 32 + 8 * fq;
        if (st) {
            f32x2 ms[2][4];
#pragma unroll
            for (int ai = 0; ai < 2; ++ai)
#pragma unroll
                for (int m = 0; m < 4; ++m) ms[ai][m] = *(const f32x2*)(st + 2 * (row0 + ai * HALF + m * 16));
#pragma unroll
            for (int bj = 0; bj < 2; ++bj) {
                const int cc = col0 + bj * HALF;
                const f32x4 g0 = *(const f32x4*)(g + cc), g1 = *(const f32x4*)(g + cc + 4), b0 = *(const f32x4*)(b + cc), b1 = *(const f32x4*)(b + cc + 4);
                u32x4 r[2][4];
#pragma unroll
                for (int ai = 0; ai < 2; ++ai)
#pragma unroll
                    for (int m = 0; m < 4; ++m) r[ai][m] = *(const u32x4*)(res + (size_t)(row0 + ai * HALF + m * 16) * 2048 + cc);
#pragma unroll
                for (int ai = 0; ai < 2; ++ai)
#pragma unroll
                    for (int m = 0; m < 4; ++m) { const float mu = ms[ai][m][0], rr = ms[ai][m][1];
                        const f32x4 x0 = (res4(r[ai][m].x, r[ai][m].y) - mu) * rr * g0 + b0, x1 = (res4(r[ai][m].z, r[ai][m].w) - mu) * rr * g1 + b1;
                        *(u32x4*)(out + (size_t)(row0 + ai * HALF + m * 16) * 2048 + cc) = res_pack8(x0 * ALPHA_RES + acc[ai][bj][m][0] * s, x1 * ALPHA_RES + acc[ai][bj][m][1] * s); }
            }
        } else {
            u32x4 r[2][2][4];
#pragma unroll
            for (int bj = 0; bj < 2; ++bj)
#pragma unroll
                for (int ai = 0; ai < 2; ++ai)
#pragma unroll
                    for (int m = 0; m < 4; ++m) r[bj][ai][m] = *(const u32x4*)(res + (size_t)(row0 + ai * HALF + m * 16) * 2048 + col0 + bj * HALF);
#pragma unroll
            for (int bj = 0; bj < 2; ++bj)
#pragma unroll
                for (int ai = 0; ai < 2; ++ai)
#pragma unroll
                    for (int m = 0; m < 4; ++m) { const u32x4 w = r[bj][ai][m];
                        *(u32x4*)(out + (size_t)(row0 + ai * HALF + m * 16) * 2048 + col0 + bj * HALF) = res_pack8(bf4(w.x, w.y) * ALPHA_RES + acc[ai][bj][m][0] * s, bf4(w.z, w.w) * ALPHA_RES + acc[ai][bj][m][1] * s); }
        }
    }
};
#else
struct EpiRes {
    static constexpr bool PERM = true, AFTER_DRAIN = false;
    const float* res; float* out; float s;
    const float* st; const float* g; const float* b;
    __device__ __forceinline__ void operator()(const f32x4 (&acc)[2][2][4][2], const Unit& u, int wr, int wc, int fr, int fq) const {
        const int row0 = u.pm * BM + wr * 64 + fr, col0 = u.pn * BM + wc * 32 + 8 * fq;
        if (st) {
#pragma unroll
            for (int bj = 0; bj < 2; ++bj) {
                const int cc = col0 + bj * HALF;
                const f32x4 g0 = *(const f32x4*)(g + cc), g1 = *(const f32x4*)(g + cc + 4), b0 = *(const f32x4*)(b + cc), b1 = *(const f32x4*)(b + cc + 4);
#pragma unroll
                for (int ai = 0; ai < 2; ++ai) {
                    f32x4 r0[4], r1[4]; f32x2 ms[4];
#pragma unroll
                    for (int m = 0; m < 4; ++m) { const size_t p = (size_t)(row0 + ai * HALF + m * 16) * 2048 + cc; r0[m] = *(const f32x4*)(res + p); r1[m] = *(const f32x4*)(res + p + 4); }
#pragma unroll
                    for (int m = 0; m < 4; ++m) ms[m] = *(const f32x2*)(st + 2 * (row0 + ai * HALF + m * 16));
#pragma unroll
                    for (int m = 0; m < 4; ++m) {
                        const size_t p = (size_t)(row0 + ai * HALF + m * 16) * 2048 + cc; const float mu = ms[m][0], rr = ms[m][1];
                        const f32x4 x0 = (r0[m] - mu) * rr * g0 + b0, x1 = (r1[m] - mu) * rr * g1 + b1;
                        *(f32x4*)(out + p) = x0 * ALPHA_RES + acc[ai][bj][m][0] * s; *(f32x4*)(out + p + 4) = x1 * ALPHA_RES + acc[ai][bj][m][1] * s;
                    }
                }
            }
        } else {
            f32x4 r0[4], r1[4];
#define EPIRES_LOAD(k) { const int cc = col0 + ((k) >> 1) * HALF, rb = row0 + ((k) & 1) * HALF; \
                _Pragma("unroll") for (int m = 0; m < 4; ++m) { const size_t p = (size_t)(rb + m * 16) * 2048 + cc; r0[m] = *(const f32x4*)(res + p); r1[m] = *(const f32x4*)(res + p + 4); } }
            EPIRES_LOAD(0)
#pragma unroll
            for (int k = 0; k < 4; ++k) {
                const int bj = k >> 1, ai = k & 1, cc = col0 + bj * HALF, rb = row0 + ai * HALF;
                f32x4 o0[4], o1[4];
#pragma unroll
                for (int m = 0; m < 4; ++m) { o0[m] = r0[m] * ALPHA_RES + acc[ai][bj][m][0] * s; o1[m] = r1[m] * ALPHA_RES + acc[ai][bj][m][1] * s; }
                if (k < 3) EPIRES_LOAD(k + 1)
#pragma unroll
                for (int m = 0; m < 4; ++m) { const size_t p = (size_t)(rb + m * 16) * 2048 + cc; *(f32x4*)(out + p) = o0[m]; *(f32x4*)(out + p + 4) = o1[m]; }
            }
#undef EPIRES_LOAD
        }
    }
};

#endif

struct EpiSwiglu {
    static constexpr bool PERM = true, AFTER_DRAIN = false;
    bf16_t* O; int ldc; int row_off; float s;
    __device__ __forceinline__ f32x4 sw(f32x4 g, f32x4 uu) const {
        const float c1 = -1.4426950408889634f * s, K = 1.0f / (s * s);
        const f32x4 t = g * c1; f32x4 e, r;
#pragma unroll
        for (int j = 0; j < 4; ++j) e[j] = __builtin_amdgcn_exp2f(t[j]);
        const f32x4 d = e * K + K;
#pragma unroll
        for (int j = 0; j < 4; ++j) r[j] = __builtin_amdgcn_rcpf(d[j]);
        return (g * uu) * r; }
    __device__ __forceinline__ void operator()(const f32x4 (&acc)[2][2][4][2], const Unit& u, int wr, int wc, int fr, int fq) const {
        const int row0 = u.pm * BM + wr * 64 + fr - row_off, col0 = u.pn * HALF + wc * 32 + 8 * fq;
#pragma unroll
        for (int ai = 0; ai < 2; ++ai)
#pragma unroll
            for (int m = 0; m < 4; ++m)
                *(u32x4*)(O + (size_t)(row0 + ai * HALF + m * 16) * ldc + col0) = pack8(sw(acc[ai][0][m][0], acc[ai][1][m][0]), sw(acc[ai][0][m][1], acc[ai][1][m][1]));
    }
};

struct EpiPlain {
    static constexpr bool PERM = true, AFTER_DRAIN = false;
    bf16_t* O; int ldc; int split_cols; size_t split_stride; float s;
    unsigned* maxp;
    __device__ __forceinline__ void operator()(const f32x4 (&acc)[2][2][4][2], const Unit& u, int wr, int wc, int fr, int fq) const {
        const int row0 = u.pm * BM + wr * 64 + fr; int colt = u.pn * BM; bf16_t* base = O;
        if (split_cols) { const int t = colt / split_cols; base += (size_t)t * split_stride; colt -= t * split_cols; }
        const int col0 = colt + wc * 32 + 8 * fq;
        float mx0 = 0.f, mx1 = 0.f; unsigned* const mp = maxp; const bool domax = (mp != nullptr) && split_cols != 0 && (u.pn * BM) < 2 * split_cols;
#pragma unroll
        for (int ai = 0; ai < 2; ++ai)
#pragma unroll
            for (int m = 0; m < 4; ++m) {
                { const f32x4 a = acc[ai][0][m][0] * s, b = acc[ai][0][m][1] * s;
                  *(u32x4*)(base + (size_t)(row0 + ai * HALF + m * 16) * ldc + col0) = pack8(a, b);
                  if (domax) { float q = sq4(a) + sq4(b); q = xsum16(q); q = xsum32(q); mx0 = fmaxf(mx0, q); } }
                { const f32x4 a = acc[ai][1][m][0] * s, b = acc[ai][1][m][1] * s;
                  *(u32x4*)(base + (size_t)(row0 + ai * HALF + m * 16) * ldc + col0 + HALF) = pack8(a, b);
                  if (domax) { float q = sq4(a) + sq4(b); q = xsum16(q); q = xsum32(q); mx1 = fmaxf(mx1, q); } }
            }
        if (domax) {
            const int t = (u.pn * BM) / split_cols;
            mx0 = row16_max(mx0); mx1 = row16_max(mx1);
            if (fr == 0 && fq == 0) { unsigned* d = mp + (t * 2 + (u.pm * BM) / 8192) * 16 + (colt / 128);
                atomicMax(d, __float_as_uint(mx0)); atomicMax(d + 1, __float_as_uint(mx1)); }
        }
    }
};

constexpr float W8_SCALE = 64.f, H8_SCALE = 16.f;
__device__ __forceinline__ unsigned pk4_fp8(float a, float b, float c, float d) { int p = __builtin_amdgcn_cvt_pk_fp8_f32(a, b, 0, false); p = __builtin_amdgcn_cvt_pk_fp8_f32(c, d, p, true); return (unsigned)p; }
struct EpiSwiglu8 {
    static constexpr bool PERM = true, AFTER_DRAIN = false;
    unsigned char* O; int ldc;
#ifdef OLD_SW
    __device__ __forceinline__ f32x4 sw(f32x4 g, f32x4 uu) const { f32x4 r;
#pragma unroll
        for (int j = 0; j < 4; ++j) { const float gg = g[j] * (1.f / W8_SCALE); r[j] = gg * __builtin_amdgcn_rcpf(1.0f + __builtin_amdgcn_exp2f(-1.4426950408889634f * gg)) * (uu[j] * (H8_SCALE / W8_SCALE)); }
        return r; }
#else
    static __device__ __forceinline__ f32x2 pk_mul2(f32x2 a, f32x2 b) { f32x2 d; asm("v_pk_mul_f32 %0, %1, %2" : "=v"(d) : "v"(a), "v"(b)); return d; }
    __device__ __forceinline__ f32x4 sw(f32x4 g, f32x4 uu) const {
        constexpr float C1 = -1.4426950408889634f / W8_SCALE, K = W8_SCALE * W8_SCALE / H8_SCALE;
        const f32x2 c1 = {C1, C1}; const f32x2 t0 = pk_mul2(g.xy, c1), t1 = pk_mul2(g.zw, c1);
        const f32x4 e = {__builtin_amdgcn_exp2f(t0[0]), __builtin_amdgcn_exp2f(t0[1]), __builtin_amdgcn_exp2f(t1[0]), __builtin_amdgcn_exp2f(t1[1])};
        const f32x4 d = e * K + K; f32x4 r;
#pragma unroll
        for (int j = 0; j < 4; ++j) r[j] = __builtin_amdgcn_rcpf(d[j]);
        return (g * uu) * r; }
#endif
    __device__ __forceinline__ void operator()(const f32x4 (&acc)[2][2][4][2], const Unit& u, int wr, int wc, int fr, int fq) const {
        const int row0 = u.pm * BM + wr * 64 + fr, col0 = u.pn * HALF + wc * 32 + 8 * fq;
#pragma unroll
        for (int ai = 0; ai < 2; ++ai)
#pragma unroll
            for (int m = 0; m < 4; ++m) { const f32x4 a = sw(acc[ai][0][m][0], acc[ai][1][m][0]), b = sw(acc[ai][0][m][1], acc[ai][1][m][1]);
                typedef unsigned u32x2 __attribute__((ext_vector_type(2)));
                u32x2 w; w.x = pk4_fp8(a[0], a[1], a[2], a[3]); w.y = pk4_fp8(b[0], b[1], b[2], b[3]);
                *(u32x2*)(O + (size_t)(row0 + ai * HALF + m * 16) * ldc + col0) = w; }
    }
};
struct EpiPlainS {
    static constexpr bool PERM = true, AFTER_DRAIN = false;
    bf16_t* O; int ldc; float s; bf16_t* O2; int row2;
    __device__ __forceinline__ void operator()(const f32x4 (&acc)[2][2][4][2], const Unit& u, int wr, int wc, int fr, int fq) const {
        const int row0 = u.pm * BM + wr * 64 + fr - (u.kh ? row2 : 0), col0 = u.pn * BM + wc * 32 + 8 * fq; bf16_t* const O = u.kh ? this->O2 : this->O;
#pragma unroll
        for (int ai = 0; ai < 2; ++ai)
#pragma unroll
            for (int m = 0; m < 4; ++m)
#pragma unroll
                for (int bj = 0; bj < 2; ++bj) *(u32x4*)(O + (size_t)(row0 + ai * HALF + m * 16) * ldc + col0 + bj * HALF) = pack8(acc[ai][bj][m][0] * s, acc[ai][bj][m][1] * s);
    }
};
template <class Epi, class Sched, bool ALIGN_EPI = false, bool SP2 = false, bool F8 = false, int PROBE = 0>
__device__ __forceinline__ void gemm_phase(PG8_LAS unsigned char* lds, const Gemm g, const Sched& S, const Epi& E) {
    const int tid = threadIdx.x, wid = __builtin_amdgcn_readfirstlane(tid >> 6), lane = tid & 63, wr = wid >> 2, wc = wid & 3, fr = lane & 15, fq = lane >> 4;
    const int K = g.K, nt = (g.Kl ? g.Kl : K) / BK;
    unsigned voffA[2], voffB[2];
#pragma unroll
    for (int i = 0; i < 2; ++i) { int R, C; stage_rc(tid * 16 + i * 8192, R, C); const int Rb = Epi::PERM ? ((R & ~31) + perm32(R & 31)) : R;
        voffA[i] = (unsigned)(R * K + C) * 2u; voffB[i] = (unsigned)(Rb * K + C) * 2u; }
    const size_t kstep = (size_t)(BK * 2);
    const size_t hstep = (size_t)HALF * K * 2;
    const size_t tstep = 2 * hstep;
    const unsigned ldsw = (unsigned)wid * 1024u;
    const int aoff = lds_byte(wr * 64 + fr, fq * 8), boff = lds_byte(wc * 32 + fr, fq * 8);
#define PG8_SA(b, h) (((b) * 2 + (h)) * HTB)
#define PG8_SB(b, h) ((4 + (b) * 2 + (h)) * HTB)
#define PG8_STAGE(bufoff, gbase, voff) do { _Pragma("unroll") for (int _i = 0; _i < 2; ++_i) \
        __builtin_amdgcn_global_load_lds((const unsigned*)((const char*)(gbase) + (voff)[_i]), (PG8_LAS unsigned*)(lds + (bufoff) + ldsw + _i * 8192), 16, 0, 0); } while (0)
#define PG8_LDA(dst, b, h) do { _Pragma("unroll") for (int m = 0; m < 4; ++m) _Pragma("unroll") for (int k = 0; k < 2; ++k) dst[m][k] = *(const PG8_LAS bf16x8*)(lds + PG8_SA(b, h) + aoff + m * 2048 + k * 1024); } while (0)
#define PG8_LDB(dst, b, h) do { _Pragma("unroll") for (int n = 0; n < 2; ++n) _Pragma("unroll") for (int k = 0; k < 2; ++k) dst[n][k] = *(const PG8_LAS bf16x8*)(lds + PG8_SB(b, h) + boff + n * 2048 + k * 1024); } while (0)
#define PG8_MMA(ai, bj, At, Bt) do { __builtin_amdgcn_s_setprio(1); if constexpr (F8) { _Pragma("unroll") for (int m = 0; m < 4; ++m) _Pragma("unroll") for (int n = 0; n < 2; ++n) \
        mfma8(acc[ai][bj][m][n], cat8(Bt[n][0], Bt[n][1]), cat8(At[m][0], At[m][1])); } else { \
        _Pragma("unroll") for (int m = 0; m < 4; ++m) _Pragma("unroll") for (int n = 0; n < 2; ++n) _Pragma("unroll") for (int k = 0; k < 2; ++k) \
        acc[ai][bj][m][n] = __builtin_amdgcn_mfma_f32_16x16x32_bf16(Bt[n][k], At[m][k], acc[ai][bj][m][n], 0, 0, 0); } __builtin_amdgcn_s_setprio(0); } while (0)
#define PG8_WAIT_V(n) asm volatile("s_waitcnt vmcnt(" #n ")" ::: "memory")
#define PG8_WAIT_L(n) asm volatile("s_waitcnt lgkmcnt(" #n ")" ::: "memory")
#define PG8_BAR __builtin_amdgcn_s_barrier()
#define PG8_SCHED __builtin_amdgcn_sched_barrier(0)
    Unit cur, nxt; int ui = 0;
    if (!S.next(0, cur)) return;
    f32x4 acc[2][2][4][2];
#pragma unroll
    for (int a = 0; a < 2; ++a)
#pragma unroll
        for (int b = 0; b < 2; ++b)
#pragma unroll
            for (int m = 0; m < 4; ++m)
#pragma unroll
                for (int n = 0; n < 2; ++n) acc[a][b][m][n] = (f32x4){0.f, 0.f, 0.f, 0.f};
    bf16x8 At[4][2], B0[2][2], B1[2][2];
    unsigned pb_t = 0u, pb_acc = 0u; bool pb_open = false;
    if constexpr (PROBE == 2) pb_t = (unsigned)__builtin_amdgcn_s_memrealtime();
    const char* cA = (const char*)g.A + (size_t)cur.pm * tstep + S.aoff(cur); const char* cB = S.bbase(g, cur) + (size_t)cur.pn * tstep;
    S.a_ready(cur);
    if constexpr (SP2) {
        PG8_STAGE(PG8_SB(0, 0), cB, voffB); PG8_STAGE(PG8_SB(0, 1), cB + hstep, voffB); PG8_STAGE(PG8_SA(0, 0), cA, voffA); PG8_STAGE(PG8_SA(0, 1), cA + hstep, voffA);
        if (wr == 1) PG8_BAR;
        PG8_WAIT_V(2); PG8_BAR;
        PG8_STAGE(PG8_SB(1, 0), cB + kstep, voffB); PG8_STAGE(PG8_SA(1, 0), cA + kstep, voffA); PG8_STAGE(PG8_SB(1, 1), cB + hstep + kstep, voffB);
        PG8_WAIT_V(6); PG8_BAR;
    } else {
        PG8_STAGE(PG8_SB(0, 0), cB, voffB); PG8_STAGE(PG8_SA(0, 0), cA, voffA); PG8_STAGE(PG8_SB(0, 1), cB + hstep, voffB); PG8_STAGE(PG8_SA(0, 1), cA + hstep, voffA);
        if (wr == 1) PG8_BAR;
        PG8_WAIT_V(4); PG8_BAR;
        PG8_STAGE(PG8_SB(1, 0), cB + kstep, voffB); PG8_STAGE(PG8_SA(1, 0), cA + kstep, voffA); PG8_STAGE(PG8_SB(1, 1), cB + hstep + kstep, voffB);
        PG8_WAIT_V(6); PG8_BAR;
    }
    for (;;) {
        const bool has_next = S.next(ui + 1, nxt);
        const char* nA = has_next ? (const char*)g.A + (size_t)nxt.pm * tstep + S.aoff(nxt) : cA; const char* nB = has_next ? S.bbase(g, nxt) + (size_t)nxt.pn * tstep : cB;
        for (int t = 0; t < nt; t += 2) {
            const bool last = (t == nt - 2);
            const char* a1 = cA + (size_t)(t + 1) * kstep;
            const char* a2 = last ? nA : cA + (size_t)(t + 2) * kstep; const char* b2 = last ? nB : cB + (size_t)(t + 2) * kstep;
            const char* a3 = a2 + kstep; const char* b3 = b2 + kstep;
            if (last && has_next) S.a_ready(nxt);
            if constexpr (SP2) {
            PG8_LDB(B0, 0, 0); PG8_LDB(B1, 0, 1); PG8_SCHED; PG8_LDA(At, 0, 0); PG8_STAGE(PG8_SA(1, 1), a1 + hstep, voffA);
            PG8_WAIT_V(8); PG8_WAIT_L(0); PG8_BAR;
            if constexpr (PROBE == 1) { if (t == 0 && pb_open) { pb_acc += (unsigned)__builtin_amdgcn_s_memrealtime() - pb_t; pb_open = false; } }
            PG8_MMA(0, 0, At, B0); PG8_MMA(0, 1, At, B1); PG8_BAR; PG8_SCHED;
            PG8_LDA(At, 0, 1); PG8_STAGE(PG8_SB(0, 0), b2, voffB); PG8_STAGE(PG8_SB(0, 1), b2 + hstep, voffB); PG8_STAGE(PG8_SA(0, 0), a2, voffA);
            PG8_WAIT_V(8); PG8_WAIT_L(0); PG8_BAR; PG8_MMA(1, 0, At, B0); PG8_MMA(1, 1, At, B1); PG8_BAR; PG8_SCHED;
            PG8_LDB(B0, 1, 0); PG8_LDB(B1, 1, 1); PG8_SCHED; PG8_LDA(At, 1, 0); PG8_STAGE(PG8_SA(0, 1), a2 + hstep, voffA);
            PG8_WAIT_V(8); PG8_WAIT_L(0); PG8_BAR; PG8_MMA(0, 0, At, B0); PG8_MMA(0, 1, At, B1); PG8_BAR; PG8_SCHED;
            PG8_LDA(At, 1, 1); PG8_STAGE(PG8_SB(1, 0), b3, voffB); PG8_STAGE(PG8_SB(1, 1), b3 + hstep, voffB); PG8_STAGE(PG8_SA(1, 0), a3, voffA);
            PG8_WAIT_V(8); PG8_WAIT_L(0); PG8_BAR; PG8_MMA(1, 0, At, B0); PG8_MMA(1, 1, At, B1); PG8_BAR; PG8_SCHED;
            } else {
            PG8_LDB(B0, 0, 0); PG8_SCHED; PG8_LDA(At, 0, 0); PG8_STAGE(PG8_SA(1, 1), a1 + hstep, voffA);
            PG8_WAIT_L(8); PG8_BAR; PG8_WAIT_L(0); PG8_MMA(0, 0, At, B0); PG8_BAR; PG8_SCHED;
            PG8_LDB(B1, 0, 1); PG8_STAGE(PG8_SB(0, 0), b2, voffB);
            PG8_BAR; PG8_WAIT_L(0); PG8_MMA(0, 1, At, B1); PG8_BAR;
            PG8_LDA(At, 0, 1); PG8_STAGE(PG8_SA(0, 0), a2, voffA);
            PG8_BAR; PG8_WAIT_L(0); PG8_MMA(1, 0, At, B0); PG8_BAR; PG8_SCHED;
            PG8_STAGE(PG8_SB(0, 1), b2 + hstep, voffB);
            PG8_WAIT_V(6); PG8_BAR; PG8_MMA(1, 1, At, B1); PG8_BAR;
            PG8_LDB(B0, 1, 0); PG8_SCHED; PG8_LDA(At, 1, 0); PG8_STAGE(PG8_SA(0, 1), a2 + hstep, voffA);
            PG8_WAIT_L(8); PG8_BAR; PG8_WAIT_L(0); PG8_MMA(0, 0, At, B0); PG8_BAR; PG8_SCHED;
            PG8_LDB(B1, 1, 1); PG8_STAGE(PG8_SB(1, 0), b3, voffB);
            PG8_BAR; PG8_WAIT_L(0); PG8_MMA(0, 1, At, B1); PG8_BAR;
            PG8_LDA(At, 1, 1); PG8_STAGE(PG8_SA(1, 0), a3, voffA);
            PG8_BAR; PG8_WAIT_L(0); PG8_MMA(1, 0, At, B0); PG8_BAR; PG8_SCHED;
            PG8_STAGE(PG8_SB(1, 1), b3 + hstep, voffB);
            PG8_WAIT_V(6); PG8_BAR; PG8_MMA(1, 1, At, B1); PG8_BAR;
            }
        }
        if constexpr (PROBE == 1) { pb_t = (unsigned)__builtin_amdgcn_s_memrealtime(); pb_open = true; }
        if constexpr (ALIGN_EPI) { if (wr == 0) PG8_BAR; }
        if constexpr (F8) { asm volatile("s_nop 15\n\ts_nop 15" ::: "memory"); PG8_SCHED; }
        if constexpr (PROBE == 3) pb_t = (unsigned)__builtin_amdgcn_s_memrealtime();
        if constexpr (!Epi::AFTER_DRAIN) { E(acc, cur, wr, wc, fr, fq); S.done(cur); }
        if constexpr (PROBE == 3) { asm volatile("" ::: "memory"); pb_acc += (unsigned)__builtin_amdgcn_s_memrealtime() - pb_t; }
        if (!has_next) break;
#pragma unroll
        for (int a = 0; a < 2; ++a)
#pragma unroll
            for (int b = 0; b < 2; ++b)
#pragma unroll
                for (int m = 0; m < 4; ++m)
#pragma unroll
                    for (int n = 0; n < 2; ++n) acc[a][b][m][n] = (f32x4){0.f, 0.f, 0.f, 0.f};
        cur = nxt; cA = nA; cB = nB; ++ui;
        if constexpr (ALIGN_EPI) { if (wr == 1) PG8_BAR; }
    }
    PG8_WAIT_V(0);
    if constexpr (!ALIGN_EPI) { if (wr == 0) PG8_BAR; }
    PG8_BAR;
    if constexpr (Epi::AFTER_DRAIN) { E.fused(acc, cur, wr, wc, fr, fq, lds, wid, lane); S.done(cur); }
    if constexpr (PROBE != 0) { const unsigned now = (unsigned)__builtin_amdgcn_s_memrealtime(); if (PROBE == 2 || (PROBE == 1 && pb_open)) pb_acc += now - pb_t;
        if (tid == 0) *(volatile PG8_LAS unsigned*)(lds + 131072 + 320 + 128) = pb_acc; }
#undef PG8_SA
#undef PG8_SB
#undef PG8_STAGE
#undef PG8_LDA
#undef PG8_LDB
#undef PG8_MMA
#undef PG8_WAIT_V
#undef PG8_WAIT_L
#undef PG8_BAR
#undef PG8_SCHED
}
}


namespace att {
typedef unsigned short bf16;
typedef short bf16x8 __attribute__((ext_vector_type(8)));
typedef short s16x4 __attribute__((ext_vector_type(4)));
typedef float f32x16 __attribute__((ext_vector_type(16)));
typedef float f32x4 __attribute__((ext_vector_type(4)));
typedef unsigned u32x4 __attribute__((ext_vector_type(4)));
constexpr int NW = 8, QBLK = 32, KVBLK = 64, QB = NW * QBLK, D = 128;
constexpr int SHM_V = KVBLK * D * 2, SHM_K = KVBLK * D * 2, K2P = 144, SHM_K2 = KVBLK * K2P;
constexpr int OFF_V = 0, OFF_K = 2 * SHM_V, OFF_K2 = OFF_K + 2 * SHM_K, OFF_KB = OFF_K2 + 2 * SHM_K2, OFF_WS = OFF_KB + 2 * 64 * 4, LDS_BYTES = OFF_WS + NW * 64 * 4;
constexpr float THR = 8.f;
#ifndef ATT_PRIO
#define ATT_PRIO 1
#endif
template <int MODE> struct Cfg { static constexpr float SCALE = (MODE == 2) ? 0.07216878364870322f : 0.08838834764831845f; static constexpr bool SK = (MODE == 0); };

#define KSWZ(row, colB) ((row) * 256 + ((colB) ^ (((row) & 7) << 4)))
#define SBAR() __builtin_amdgcn_sched_barrier(0)
__device__ __forceinline__ int v_st(int k, int c) { const int kk = (k & ~0xC) | ((k & 4) << 1) | ((k & 8) >> 1); return ((kk >> 3) * 4 + (c >> 5)) * 512 + ((kk & 7) * 32 + (c & 31)) * 2; }
__device__ __forceinline__ int v_rd_base(int lane) { return ((lane & 3) << 3) | (((lane >> 2) & 3) << 6) | (((lane >> 4) & 1) << 5) | (((lane >> 5) & 1) << 8); }
constexpr int v_rd_off(int d0, int ks, int half) { return d0 * 512 + ks * 4096 + half * 2048; }
__device__ __forceinline__ int crow(int r, int hi) { return (r & 3) + 8 * (r >> 2) + 4 * hi; }
__device__ __forceinline__ unsigned cvtpk(float lo, float hi) { unsigned r; asm volatile("v_cvt_pk_bf16_f32 %0, %1, %2" : "=v"(r) : "v"(lo), "v"(hi)); return r; }
__device__ __forceinline__ bf16x8 load8(const bf16* p) { return *reinterpret_cast<const bf16x8*>(p); }
__device__ __forceinline__ void mask_tile(f32x16& p0, f32x16& p1, int dq, unsigned W) {
    const float NEG = -__builtin_inff();
#pragma unroll
    for (int r = 0; r < 16; ++r) {
        const int c = (r & 3) + 8 * (r >> 2);
        if ((unsigned)(dq - c) >= W) p0[r] = NEG;
        if ((unsigned)(dq - c - 32) >= W) p1[r] = NEG;
    }
}
template <int MODE>
__device__ __forceinline__ void partialSM(f32x16& p0, f32x16& p1, float& m_reg, float& mn, float& alpha) {
    constexpr float SCALE = Cfg<MODE>::SCALE;
    float pmax = p0[0];
#pragma unroll
    for (int r = 1; r < 16; ++r) pmax = fmaxf(pmax, p0[r]);
#pragma unroll
    for (int r = 0; r < 16; ++r) pmax = fmaxf(pmax, p1[r]);
    { auto rr = __builtin_amdgcn_permlane32_swap(__float_as_uint(pmax), __float_as_uint(pmax), false, false);
      pmax = fmaxf(__uint_as_float(rr[0]), __uint_as_float(rr[1])); }
    constexpr float C2 = 1.4426950408889634f * SCALE;
    if (__builtin_expect(__all((pmax - m_reg) * SCALE <= THR), 1)) { mn = m_reg; alpha = 1.f; }
    else { mn = fmaxf(m_reg, pmax); alpha = __builtin_amdgcn_exp2f((m_reg - mn) * C2); m_reg = mn; }
    const float mnL = -mn * C2;
    p0 = p0 * C2 + mnL; p1 = p1 * C2 + mnL;
#pragma unroll
    for (int r = 0; r < 16; ++r) p0[r] = __builtin_amdgcn_exp2f(p0[r]);
}
__device__ __forceinline__ void finishSM(f32x16& p0, f32x16& p1, float alpha, float& l_reg, bf16x8& pa0, bf16x8& pa1, bf16x8& pa2, bf16x8& pa3) {
#pragma unroll
    for (int r = 0; r < 16; ++r) p1[r] = __builtin_amdgcn_exp2f(p1[r]);
    float ps;
    { typedef float f32x8 __attribute__((ext_vector_type(8))); typedef float f32x4_ __attribute__((ext_vector_type(4))); typedef float f32x2_ __attribute__((ext_vector_type(2)));
      const f32x16 s16 = p0 + p1; const f32x8 s8 = s16.lo + s16.hi; const f32x4_ s4 = s8.lo + s8.hi; const f32x2_ s2 = s4.lo + s4.hi; ps = s2[0] + s2[1]; }
    { auto rr = __builtin_amdgcn_permlane32_swap(__float_as_uint(ps), __float_as_uint(ps), false, false);
      ps = __uint_as_float(rr[0]) + __uint_as_float(rr[1]); }
    l_reg = l_reg * alpha + ps;
#define PK4(P, B_, OUT) do { unsigned a0 = cvtpk(P[B_+0], P[B_+1]), a1 = cvtpk(P[B_+2], P[B_+3]);                          \
        unsigned b0 = cvtpk(P[B_+4], P[B_+5]), b1 = cvtpk(P[B_+6], P[B_+7]);                                             \
        auto r0 = __builtin_amdgcn_permlane32_swap(a0, b0, false, false); auto r1 = __builtin_amdgcn_permlane32_swap(a1, b1, false, false); \
        u32x4 w = {r0[0], r1[0], r0[1], r1[1]}; OUT = *reinterpret_cast<bf16x8*>(&w); } while (0)
    PK4(p0, 0, pa0); PK4(p0, 8, pa1); PK4(p1, 0, pa2); PK4(p1, 8, pa3);
#undef PK4
}
template <int KB, int MODE>
__device__ __forceinline__ void qkt(f32x16& p0, f32x16& p1, const char* lds, int r32, int hi, const bf16x8* qr, const bf16x8* qr2, bool act) {
    constexpr bool SK = Cfg<MODE>::SK;
    if (SK && !act) { const float NEG = -__builtin_inff();
#pragma unroll
        for (int r = 0; r < 16; ++r) { p0[r] = NEG; p1[r] = NEG; } return; }
    p0 = f32x16{}; p1 = f32x16{};
    const char* kb[4];
#pragma unroll
    for (int dd = 0; dd < 4; ++dd) kb[dd] = lds + OFF_K + KB * SHM_K + KSWZ(r32, (dd * 16 + hi * 8) * 2);
    __builtin_amdgcn_s_setprio(ATT_PRIO);
#pragma unroll
    for (int d0 = 0; d0 < 8; ++d0) { const char* a = kb[d0 & 3] + (d0 >> 2) * 128;
        bf16x8 b0 = *reinterpret_cast<const bf16x8*>(a);
        bf16x8 b1 = *reinterpret_cast<const bf16x8*>(a + 32 * 256);
        p0 = __builtin_amdgcn_mfma_f32_32x32x16_bf16(b0, qr[d0], p0, 0, 0, 0);
        p1 = __builtin_amdgcn_mfma_f32_32x32x16_bf16(b1, qr[d0], p1, 0, 0, 0); }
    if constexpr (MODE == 2) {
        const char* k2 = lds + OFF_K2 + KB * SHM_K2 + r32 * K2P + hi * 16;
#pragma unroll
        for (int d0 = 0; d0 < 4; ++d0) {
            bf16x8 b0 = *reinterpret_cast<const bf16x8*>(k2 + d0 * 32);
            bf16x8 b1 = *reinterpret_cast<const bf16x8*>(k2 + d0 * 32 + 32 * K2P);
            p0 = __builtin_amdgcn_mfma_f32_32x32x16_bf16(b0, qr2[d0], p0, 0, 0, 0);
            p1 = __builtin_amdgcn_mfma_f32_32x32x16_bf16(b1, qr2[d0], p1, 0, 0, 0); }
    }
    __builtin_amdgcn_s_setprio(0);
}
template <int VB, bool SK>
__device__ __forceinline__ void pv_tile(f32x16* o, int vb0, bf16x8 pa0, bf16x8 pa1, bf16x8 pa2, bf16x8 pa3, bool act) {
    if (SK && !act) return;
    __builtin_amdgcn_s_setprio(ATT_PRIO);
#define TRRD(dst, off) asm volatile("ds_read_b64_tr_b16 %0, %1 offset:%2" : "=&v"(dst) : "v"(vb0), "i"(off) : "memory")
#define PV_D0(d0) do { s16x4 l0, l1, l2, l3, h0, h1, h2, h3; constexpr int b_ = OFF_V + VB * SHM_V + v_rd_off(d0, 0, 0);   \
        TRRD(l0, b_); TRRD(h0, b_ + 2048); TRRD(l1, b_ + 4096); TRRD(h1, b_ + 6144); TRRD(l2, b_ + 8192); TRRD(h2, b_ + 10240); TRRD(l3, b_ + 12288); TRRD(h3, b_ + 14336); \
        asm volatile("s_waitcnt lgkmcnt(0)" ::: "memory"); SBAR();   \
        o[d0] = __builtin_amdgcn_mfma_f32_32x32x16_bf16(pa0, (bf16x8){l0[0], l0[1], l0[2], l0[3], h0[0], h0[1], h0[2], h0[3]}, o[d0], 0, 0, 0);   \
        o[d0] = __builtin_amdgcn_mfma_f32_32x32x16_bf16(pa1, (bf16x8){l1[0], l1[1], l1[2], l1[3], h1[0], h1[1], h1[2], h1[3]}, o[d0], 0, 0, 0);   \
        o[d0] = __builtin_amdgcn_mfma_f32_32x32x16_bf16(pa2, (bf16x8){l2[0], l2[1], l2[2], l2[3], h2[0], h2[1], h2[2], h2[3]}, o[d0], 0, 0, 0);   \
        o[d0] = __builtin_amdgcn_mfma_f32_32x32x16_bf16(pa3, (bf16x8){l3[0], l3[1], l3[2], l3[3], h3[0], h3[1], h3[2], h3[3]}, o[d0], 0, 0, 0); } while (0)
    PV_D0(0); PV_D0(1); PV_D0(2); PV_D0(3);
    __builtin_amdgcn_s_setprio(0);
#undef PV_D0
#undef TRRD
}

struct Item { const bf16* Q; const bf16* K; const bf16* V; bf16* O; const bf16* Q2; const bf16* K2; const float* C; float* L; int qp, kp, vp, op, qp2, kp2, lp, P0, skv, W, jlo; };
struct Seam { bf16x8 qr[8]; bf16x8 qr2[4]; bf16x8 st_v0, st_v1, st_k0, st_k1, st_k2; float st_c; };
template <int MODE> struct Geo {
    static __device__ __forceinline__ int qp(const Item& it) { return MODE == 1 ? 2048 : (MODE == 2 ? 1280 : it.qp); }
    static __device__ __forceinline__ int kp(const Item& it) { return MODE == 1 ? 2048 : (MODE == 2 ? 1280 : it.kp); }
    static __device__ __forceinline__ int vp(const Item& it) { return MODE == 1 ? 2048 : (MODE == 2 ? 1280 : it.vp); }
    static __device__ __forceinline__ int op(const Item& it) { return MODE == 0 ? it.op : 2048; }
    static __device__ __forceinline__ int qp2(const Item&) { return 640; }
    static __device__ __forceinline__ int kp2(const Item&) { return 64; }
    static __device__ __forceinline__ int skv(const Item& it) { return MODE == 0 ? it.skv : 8192; }
    static __device__ __forceinline__ int W(const Item& it) { return MODE == 0 ? it.W : 8192; }
    static __device__ __forceinline__ int jlo(const Item& it) { if (MODE == 1) return it.jlo; const int lowk = it.P0 - W(it) + 1; return lowk > 0 ? lowk / KVBLK : 0; }
};
__device__ __forceinline__ int swa_jlo(int P0, int W) { const int lowk = P0 - W + 1; return lowk > 0 ? lowk / KVBLK : 0; }
#define VMW() asm volatile("s_waitcnt vmcnt(0)" ::: "memory")
#define VMWN(n) asm volatile("s_waitcnt vmcnt(%0)" :: "i"(n) : "memory")
#define SLOAD_H(IT, k0) do { S.st_v0 = load8((IT).V + (size_t)((k0) + sr) * Geo<MODE>::vp(IT) + sc); S.st_v1 = load8((IT).V + (size_t)((k0) + 32 + sr) * Geo<MODE>::vp(IT) + sc);              \
                             S.st_k0 = load8((IT).K + (size_t)((k0) + sr) * Geo<MODE>::kp(IT) + sc); S.st_k1 = load8((IT).K + (size_t)((k0) + 32 + sr) * Geo<MODE>::kp(IT) + sc);              \
                             if constexpr (MODE == 2) S.st_k2 = load8((IT).K2 + (size_t)((k0) + (tid >> 3)) * Geo<MODE>::kp2(IT) + (tid & 7) * 8);                                  \
                             if constexpr (MODE == 1) S.st_c = (IT).C[(k0) + lane]; } while (0)
#define SWRITE_HK(bf, CREF) do { *(bf16x8*)(K_lds + (bf) * SHM_K + kws) = S.st_k0; *(bf16x8*)(K_lds + (bf) * SHM_K + kws + 32 * 256) = S.st_k1;                            \
                             if constexpr (MODE == 2) *(bf16x8*)(lds + OFF_K2 + (bf) * SHM_K2 + (tid >> 3) * K2P + (tid & 7) * 16) = S.st_k2;                             \
                             if constexpr (MODE == 1) { if (wid == 0) ((float*)(lds + OFF_KB))[(bf) * 64 + lane] = ((CREF) - S.st_c) * (1.0f / Cfg<MODE>::SCALE); } } while (0)
#define SWRITE_HV(bf) do { *(bf16x8*)(V_lds + (bf) * SHM_V + vst0) = S.st_v0; *(bf16x8*)(V_lds + (bf) * SHM_V + vst1) = S.st_v1; } while (0)
#define SWRITE_H(bf, CREF) do { SWRITE_HV(bf); SWRITE_HK(bf, CREF); } while (0)
#define QLOAD(IT) do { _Pragma("unroll") for (int d0 = 0; d0 < 8; ++d0) S.qr[d0] = load8((IT).Q + (size_t)(wid * QBLK + r32) * Geo<MODE>::qp(IT) + d0 * 16 + hi * 8);               \
                       if constexpr (MODE == 2) { _Pragma("unroll") for (int d0 = 0; d0 < 4; ++d0) S.qr2[d0] = load8((IT).Q2 + (size_t)(wid * QBLK + r32) * Geo<MODE>::qp2(IT) + d0 * 16 + hi * 8); } } while (0)
template <int MODE>
__device__ __forceinline__ void attn_prime(const Item& cur, char* lds, Seam& S) {
    const int tid = threadIdx.x, wid = __builtin_amdgcn_readfirstlane(tid >> 6), lane = tid & 63, r32 = lane & 31, hi = lane >> 5;
    const int sr = tid >> 4, sc = (tid & 15) * 8, kws = KSWZ(sr, sc * 2); char* K_lds = lds + OFF_K;
    const int kb0 = Geo<MODE>::jlo(cur) * KVBLK;
    float cref = 0.f; if constexpr (MODE == 1) cref = cur.C[cur.P0];
    QLOAD(cur);
    SLOAD_H(cur, kb0); VMW(); SWRITE_HK(0, cref);
    __syncthreads();
}
template <int MODE>
__device__ __forceinline__ void attn_block(const Item& cur, const Item& nxt, char* lds, Seam& S) {
    constexpr bool SK = Cfg<MODE>::SK; constexpr float SCALE = Cfg<MODE>::SCALE;
    const int tid = threadIdx.x, wid = __builtin_amdgcn_readfirstlane(tid >> 6), lane = tid & 63, r32 = lane & 31, hi = lane >> 5;
    const int W = Geo<MODE>::W(cur), skv = Geo<MODE>::skv(cur);
    const int j_lo = Geo<MODE>::jlo(cur);
    int j_hi = (cur.P0 + QB - 1) / KVBLK + 1; if (j_hi > skv / KVBLK) j_hi = skv / KVBLK;
    const int NT = j_hi - j_lo;
    const int kbn = Geo<MODE>::jlo(nxt) * KVBLK;
    const int qlo = cur.P0 + wid * QBLK, qm = qlo + r32 - 4 * hi;
    char* V_lds = lds + OFF_V; char* K_lds = lds + OFF_K;
    float* ws = (float*)(lds + OFF_WS) + wid * 64; float* li_l = ws, * al_l = ws + 32;
    float m_reg = -1e30f, l_reg = 0; f32x16 o[4] = {};
    const int sr = tid >> 4, sc = (tid & 15) * 8, vst0 = v_st(sr, sc), vst1 = v_st(32 + sr, sc), kws = KSWZ(sr, sc * 2);
    const int vb0 = (int)(uintptr_t)V_lds + v_rd_base(lane);
    float cref = 0.f, crefn = 0.f; if constexpr (MODE == 1) { cref = cur.C[cur.P0]; crefn = nxt.C[nxt.P0]; }
#define RESC(a) do { if (__any((a) < 1.f)) { if (hi == 0) al_l[r32] = (a); asm volatile("s_waitcnt lgkmcnt(0)" ::: "memory");              \
                     _Pragma("unroll") for (int d_ = 0; d_ < 4; ++d_) _Pragma("unroll") for (int r = 0; r < 16; ++r) o[d_][r] *= al_l[crow(r, hi)]; } } while (0)
#define KBASE(t) ((j_lo + (t)) * KVBLK)
#define ACT(t) (KBASE(t) <= qlo + QBLK - 1 && KBASE(t) + KVBLK - 1 >= qlo - W + 1)
#define MASKT(P0_, P1_, t) do { const int kb_ = KBASE(t); if ((!SK || ACT(t)) && (kb_ + KVBLK - 1 > qlo || kb_ <= qlo + QBLK - 1 - W)) mask_tile(P0_, P1_, qm - kb_, (unsigned)W); } while (0)
#define BIAS(P0_, P1_, bf) do { if constexpr (MODE == 1) { const float* kbp = (const float*)(lds + OFF_KB) + (bf) * 64 + 4 * hi;              \
        _Pragma("unroll") for (int q_ = 0; q_ < 4; ++q_) { const f32x4 b0_ = *(const f32x4*)(kbp + 8 * q_), b1_ = *(const f32x4*)(kbp + 32 + 8 * q_);          \
            _Pragma("unroll") for (int r_ = 0; r_ < 4; ++r_) { P0_[4 * q_ + r_] += b0_[r_]; P1_[4 * q_ + r_] += b1_[r_]; } asm volatile("" ::: "memory"); } } } while (0)
    constexpr int NQL = (MODE == 2) ? 12 : 8;
#define SEAM_K0() do { VMWN(NQL); SWRITE_HK(0, crefn); SBAR(); } while (0)
    f32x16 pA0, pA1, pB0, pB1; float mnA, mnB, alA, alB; bf16x8 pa0, pa1, pa2, pa3;
    SWRITE_HV(0); SBAR();
    if (NT > 1) SLOAD_H(cur, KBASE(1));
    SBAR(); qkt<0, MODE>(pA0, pA1, lds, r32, hi, S.qr, S.qr2, ACT(0));
    BIAS(pA0, pA1, 0); MASKT(pA0, pA1, 0); partialSM<MODE>(pA0, pA1, m_reg, mnA, alA);
    if (NT > 1) { VMW(); SWRITE_H(1, cref); }
    __syncthreads();
#define HALF_STEP(PX0, PX1, mnX, alX, PY0, PY1, alY, t, KB, VB, SB) do {                                                      \
        SBAR(); qkt<KB, MODE>(PX0, PX1, lds, r32, hi, S.qr, S.qr2, ACT(t));                                                   \
        finishSM(PY0, PY1, alY, l_reg, pa0, pa1, pa2, pa3); SBAR();                                                           \
        if ((t) + 1 < NT) { SLOAD_H(cur, KBASE((t) + 1)); SBAR(); }                                                           \
        pv_tile<VB, SK>(o, vb0, pa0, pa1, pa2, pa3, ACT((t) - 1)); BIAS(PX0, PX1, KB); MASKT(PX0, PX1, (t)); partialSM<MODE>(PX0, PX1, m_reg, mnX, alX); \
        __syncthreads();                                                                                                      \
        if ((t) + 1 < NT) { VMW(); SWRITE_H(SB, cref); }                                                                      \
        RESC(alX); __syncthreads(); } while (0)
    for (int t = 1; t + 1 < NT; t += 2) {
        HALF_STEP(pB0, pB1, mnB, alB, pA0, pA1, alA, t, 1, 0, 0);
        HALF_STEP(pA0, pA1, mnA, alA, pB0, pB1, alB, t + 1, 0, 1, 1);
    }
    const bool even = (NT & 1) == 0;
    if (even) { SBAR(); qkt<1, MODE>(pB0, pB1, lds, r32, hi, S.qr, S.qr2, ACT(NT - 1)); SBAR(); }
    SLOAD_H(nxt, kbn); SBAR();
    QLOAD(nxt);
    SBAR();
    finishSM(pA0, pA1, alA, l_reg, pa0, pa1, pa2, pa3); SBAR();
    pv_tile<0, SK>(o, vb0, pa0, pa1, pa2, pa3, ACT(even ? NT - 2 : NT - 1));
    if (even) { BIAS(pB0, pB1, 1); MASKT(pB0, pB1, NT - 1); partialSM<MODE>(pB0, pB1, m_reg, mnB, alB); __syncthreads(); RESC(alB);
        finishSM(pB0, pB1, alB, l_reg, pa0, pa1, pa2, pa3); SBAR(); pv_tile<1, SK>(o, vb0, pa0, pa1, pa2, pa3, ACT(NT - 1)); }
    SBAR(); SEAM_K0();
    if (hi == 0) li_l[r32] = l_reg; asm volatile("s_waitcnt lgkmcnt(0)" ::: "memory");
    if constexpr (MODE == 0) { if (hi == 0) cur.L[(size_t)(wid * QBLK + r32) * cur.lp] = m_reg * SCALE + __logf(l_reg); }
    float rli[16];
#pragma unroll
    for (int r = 0; r < 16; ++r) rli[r] = __builtin_amdgcn_rcpf(li_l[crow(r, hi)]);
    bf16* Ow = cur.O + (size_t)(wid * QBLK) * Geo<MODE>::op(cur);
    { const bool odd = (r32 & 1) != 0;
#pragma unroll
    for (int r = 0; r < 16; r += 2) { const int orow = crow(r, hi) + (odd ? 1 : 0);
#pragma unroll
        for (int d0 = 0; d0 < 4; ++d0) { const float va = o[d0][r] * rli[r], vb = o[d0][r + 1] * rli[r + 1];
            const float y = pg8::dpp_f<0xB1>(odd ? va : vb);
            *(unsigned*)(Ow + (size_t)orow * Geo<MODE>::op(cur) + d0 * 32 + (r32 & ~1)) = cvtpk(odd ? y : va, odd ? vb : y); } } }
    __syncthreads();
#undef RESC
#undef KBASE
#undef ACT
#undef MASKT
#undef BIAS
#undef SEAM_K0
#undef HALF_STEP
}

template <int MODE>
__device__ __forceinline__ void attn_item_simple(const Item& cur, char* lds) {
    constexpr bool SK = Cfg<MODE>::SK; constexpr float SCALE = Cfg<MODE>::SCALE;
    const int tid = threadIdx.x, wid = __builtin_amdgcn_readfirstlane(tid >> 6), lane = tid & 63, r32 = lane & 31, hi = lane >> 5;
    const int W = Geo<MODE>::W(cur), skv = Geo<MODE>::skv(cur);
    const int j_lo = Geo<MODE>::jlo(cur);
    int j_hi = (cur.P0 + QB - 1) / KVBLK + 1; if (j_hi > skv / KVBLK) j_hi = skv / KVBLK;
    const int NT = j_hi - j_lo;
    const int qlo = cur.P0 + wid * QBLK, qm = qlo + r32 - 4 * hi;
    char* V_lds = lds + OFF_V; char* K_lds = lds + OFF_K;
    float* ws = (float*)(lds + OFF_WS) + wid * 64; float* li_l = ws, * al_l = ws + 32;
    float m_reg = -1e30f, l_reg = 0; f32x16 o[4] = {};
    const int sr = tid >> 4, sc = (tid & 15) * 8, vst0 = v_st(sr, sc), vst1 = v_st(32 + sr, sc), kws = KSWZ(sr, sc * 2);
    const int vb0 = (int)(uintptr_t)V_lds + v_rd_base(lane);
    float cref = 0.f; if constexpr (MODE == 1) cref = cur.C[cur.P0];
    Seam S;
#define RESC(a) do { if (__any((a) < 1.f)) { if (hi == 0) al_l[r32] = (a); asm volatile("s_waitcnt lgkmcnt(0)" ::: "memory");              \
                     _Pragma("unroll") for (int d_ = 0; d_ < 4; ++d_) _Pragma("unroll") for (int r = 0; r < 16; ++r) o[d_][r] *= al_l[crow(r, hi)]; } } while (0)
#define KBASE(t) ((j_lo + (t)) * KVBLK)
#define ACT(t) (KBASE(t) <= qlo + QBLK - 1 && KBASE(t) + KVBLK - 1 >= qlo - W + 1)
#define MASKT(P0_, P1_, t) do { const int kb_ = KBASE(t); if ((!SK || ACT(t)) && (kb_ + KVBLK - 1 > qlo || kb_ <= qlo + QBLK - 1 - W)) mask_tile(P0_, P1_, qm - kb_, (unsigned)W); } while (0)
#define BIAS(P0_, P1_, bf) do { if constexpr (MODE == 1) { const float* kbp = (const float*)(lds + OFF_KB) + (bf) * 64 + 4 * hi;              \
        _Pragma("unroll") for (int q_ = 0; q_ < 4; ++q_) { const f32x4 b0_ = *(const f32x4*)(kbp + 8 * q_), b1_ = *(const f32x4*)(kbp + 32 + 8 * q_);          \
            _Pragma("unroll") for (int r_ = 0; r_ < 4; ++r_) { P0_[4 * q_ + r_] += b0_[r_]; P1_[4 * q_ + r_] += b1_[r_]; } asm volatile("" ::: "memory"); } } } while (0)
    QLOAD(cur);
    SLOAD_H(cur, KBASE(0)); VMW(); SWRITE_H(0, cref);
    f32x16 pA0, pA1; float mnA, alA; bf16x8 pa0, pa1, pa2, pa3;
#define STEP(t, B) do {                                                                                                       \
        __syncthreads();                                                                                                      \
        if ((t) + 1 < NT) { SLOAD_H(cur, KBASE((t) + 1)); } SBAR();                                                           \
        qkt<B, MODE>(pA0, pA1, lds, r32, hi, S.qr, S.qr2, ACT(t));                                                            \
        BIAS(pA0, pA1, B); MASKT(pA0, pA1, (t)); partialSM<MODE>(pA0, pA1, m_reg, mnA, alA); RESC(alA);                       \
        finishSM(pA0, pA1, alA, l_reg, pa0, pa1, pa2, pa3); SBAR();                                                           \
        pv_tile<B, SK>(o, vb0, pa0, pa1, pa2, pa3, ACT(t)); SBAR();                                                           \
        if ((t) + 1 < NT) { VMW(); SWRITE_H((B) ^ 1, cref); } } while (0)
    for (int t = 0; t < NT; t += 2) {
        STEP(t, 0);
        if (t + 1 < NT) STEP(t + 1, 1);
    }
    if (hi == 0) li_l[r32] = l_reg; asm volatile("s_waitcnt lgkmcnt(0)" ::: "memory");
    if constexpr (MODE == 0) { if (hi == 0) cur.L[(size_t)(wid * QBLK + r32) * cur.lp] = m_reg * SCALE + __logf(l_reg); }
    float rli[16];
#pragma unroll
    for (int r = 0; r < 16; ++r) rli[r] = __builtin_amdgcn_rcpf(li_l[crow(r, hi)]);
    bf16* Ow = cur.O + (size_t)(wid * QBLK) * Geo<MODE>::op(cur);
    { const bool odd = (r32 & 1) != 0;
#pragma unroll
    for (int r = 0; r < 16; r += 2) { const int orow = crow(r, hi) + (odd ? 1 : 0);
#pragma unroll
        for (int d0 = 0; d0 < 4; ++d0) { const float va = o[d0][r] * rli[r], vb = o[d0][r + 1] * rli[r + 1];
            const float y = pg8::dpp_f<0xB1>(odd ? va : vb);
            *(unsigned*)(Ow + (size_t)orow * Geo<MODE>::op(cur) + d0 * 32 + (r32 & ~1)) = cvtpk(odd ? y : va, odd ? vb : y); } } }
    __syncthreads();
#undef RESC
#undef KBASE
#undef ACT
#undef MASKT
#undef BIAS
#undef STEP
}
#ifndef ATT_SIMPLE
#define ATT_SIMPLE 1
#endif
template <int MODE, class List>
__device__ __forceinline__ void attn_run(char* lds, const List& L) {
    const int n = L.count(); if (n <= 0) return;
#ifndef ATT_PIPE_MASK
#define ATT_PIPE_MASK 3
#endif
    if constexpr (((ATT_PIPE_MASK >> MODE) & 1) == 0) {
        for (int i = 0; i < n; ++i) { const Item it = L.get(i); attn_item_simple<MODE>(it, lds); }
        return;
    }
    Item cur = L.get(0); Seam S;
    attn_prime<MODE>(cur, lds, S);
    for (int i = 0;; ++i) {
        const bool last = (i + 1 >= n);
        const Item nxt = last ? cur : L.get(i + 1);
        attn_block<MODE>(cur, nxt, lds, S);
        if (last) break;
        cur = nxt;
    }
    __syncthreads();
}
#undef VMW
#undef VMWN
#undef SLOAD_H
#undef SWRITE_HK
#undef SWRITE_HV
#undef SWRITE_H
#undef QLOAD
#undef KSWZ
#undef SBAR
}

constexpr int NWAVES = 8;
constexpr int SEQ = 8192, NB = 2, TOK = NB * SEQ, DM = 2048, DFF = 5632, NEXP = 8;
constexpr int N_IN = 4608, OFF_CKV_C = 448, OFF_KROPE_C = 576, OFF_DQ_C = 640, OFF_DK_C = 2944, OFF_DV_C = 3712, W_IN_COLS_C = 4480;
constexpr float LN_EPS_C = 1e-5f;
#ifndef MK_PER_PHASE
#define MK_PER_PHASE 0
#endif
constexpr int NPH = 19;

constexpr size_t MiB = 1u << 20;
constexpr size_t WS_CTL = 0, CTL_ZERO_BYTES = 1 * MiB;
constexpr size_t WS_COS128 = 1 * MiB, WS_SIN128 = 3 * MiB, WS_COS64 = 5 * MiB, WS_SIN64 = 6 * MiB;
constexpr size_t WS_SSQ = 7 * MiB, WS_LSE = 8 * MiB, WS_LOGF = 10 * MiB, WS_CUM = 11 * MiB, WS_ROUTE = 12 * MiB;
constexpr size_t WS_STATS = WS_SSQ + 800 * 1024;
constexpr size_t WS_W = 13 * MiB;
constexpr size_t WB_IN = WS_W, WB_QB = WB_IN + 18 * MiB, WB_KVB = WB_QB + 2 * MiB, WB_O0 = WB_KVB + 2 * MiB, WB_GU = WB_O0 + 8 * MiB, WB_DN = WB_GU + 44 * MiB,
                 WB_QKV = WB_DN + 22 * MiB, WB_O1 = WB_QKV + 24 * MiB, WB_EGU = WB_O1 + 8 * MiB  , WB_EDN = WB_EGU + 176 * MiB  , WS_XB = WB_EDN + 88 * MiB;
constexpr size_t WS_XR = WS_XB + 64 * MiB, WS_R = WS_XR + 128 * MiB, WS_S = WS_R + 286 * MiB, WS_END = WS_S + 136 * MiB;
constexpr size_t R_CQ = WS_R, R_CKV = R_CQ + 16 * MiB, R_KR = R_CKV + 8 * MiB, R_DQ = R_KR + 2 * MiB, R_DK = R_DQ + 72 * MiB, R_DV = R_DK + 24 * MiB,
                 R_QN = R_DV + 24 * MiB, R_QR = R_QN + 40 * MiB, R_KN = R_QR + 20 * MiB, R_VV = R_KN + 40 * MiB;
static_assert(R_VV + 40 * MiB == WS_S, "region R map");
constexpr size_t R_HF = WS_R, R_Q1 = WS_R, R_K1 = WS_R + 64 * MiB, R_V1 = WS_R + 128 * MiB, R_HE = WS_R, R_YPB = WS_R + 192 * MiB;
constexpr int MOE_MAX_TILES = 136, MOE_MAIN_TILES = 128;
static_assert((size_t)MOE_MAX_TILES * 256 * DFF <= 192 * MiB && (size_t)(MOE_MAX_TILES - MOE_MAIN_TILES) * 256 * DM * 2 <= 94 * MiB && (size_t)TOK * DFF * 2 <= 286 * MiB, "overlays fit region R");
constexpr size_t S_MIX = WS_S, S_OG = WS_S + 64 * MiB, S_XP = WS_S;
static_assert((size_t)MOE_MAX_TILES * 256 * DM * 2 <= 136 * MiB, "XP fits region S");
constexpr size_t RT_E = WS_ROUTE, RT_W = WS_ROUTE + 128 * 1024, RT_SLOT = WS_ROUTE + 384 * 1024, RT_META = WS_ROUTE + 640 * 1024;
constexpr int CW_TMO = 0, CW_BAR = 4096, CW_QKMAX = 8192;

constexpr int RING_OFF = 0, RING_BYTES = 131072;
constexpr int LDSCTL_OFF = RING_BYTES, MISC_OFF = LDSCTL_OFF + 320;
constexpr int LDS_BYTES = 147456;
static_assert(att::LDS_BYTES <= RING_BYTES && pg8::STAGE_BYTES <= RING_BYTES, "phase scratch fits the ring region");

#define GAS __attribute__((address_space(1)))
#define LAS __attribute__((address_space(3)))
typedef unsigned short bf16;
typedef unsigned v4u __attribute__((ext_vector_type(4)));
typedef unsigned v2u __attribute__((ext_vector_type(2)));
typedef float f32x4 __attribute__((ext_vector_type(4)));
typedef float f32x2 __attribute__((ext_vector_type(2)));
typedef GAS unsigned gu32;
#define RLX_AGENT __ATOMIC_RELAXED, __HIP_MEMORY_SCOPE_AGENT
__device__ __forceinline__ unsigned pk2(float lo, float hi) { return pg8::cvt_pk_bf16(lo, hi); }
__device__ __forceinline__ float bf2f(unsigned short h) { return __uint_as_float((unsigned)h << 16); }
__device__ __forceinline__ int ld_i(const int* p) { return __hip_atomic_load(p, RLX_AGENT); }
__device__ __forceinline__ float ld_f(const float* p) { return __hip_atomic_load(p, RLX_AGENT); }
#define XB_TMO      128
#define XB_XCNT(j)  (256  + 64 * (j))
#define XB_XSUB(j)  (1280 + 64 * (j))
#define XB_XGEN(j)  (2304 + 64 * (j))
#define XB_TOP      3328
#define XB_TOPGEN   3392
#define XCD_BAR_WORDS 3456
#define XB_SPIN_CAP (1u << 18)

__device__ __forceinline__ unsigned xb_ld(unsigned* p)              { return __hip_atomic_load(p, __ATOMIC_RELAXED, __HIP_MEMORY_SCOPE_AGENT); }
__device__ __forceinline__ unsigned xb_add(unsigned* p, unsigned v) { return __hip_atomic_fetch_add(p, v, __ATOMIC_RELAXED, __HIP_MEMORY_SCOPE_AGENT); }
__device__ __forceinline__ unsigned xb_xcc_id() { return (unsigned)__builtin_amdgcn_s_getreg((3 << 11) | 20) & 0xFu; }
#define XB_SPIN(cond, bar) do { unsigned _sp = 0; while (cond) { __builtin_amdgcn_s_sleep(1); \
    if ((++_sp & 255u) == 0u) { if (xb_ld(&(bar)[XB_TMO])) break; if (_sp > XB_SPIN_CAP) { atomicAdd(&(bar)[XB_TMO], 1u); break; } } } } while (0)

struct XcdBarrier {
    unsigned* bar; unsigned x;
    volatile LAS unsigned* st;
};

__device__ __forceinline__ XcdBarrier xcd_barrier_post(unsigned* bar, volatile LAS unsigned* st) {
    XcdBarrier b; b.bar = bar; b.x = xb_xcc_id(); b.st = st;
    if (threadIdx.x == 0) (void)xb_add(&bar[XB_XCNT(b.x)], 1u);
    return b;
}
__device__ __forceinline__ void xcd_barrier_complete(unsigned* bar, unsigned x, unsigned& nloc, unsigned& nx) {
    const unsigned G = gridDim.x * gridDim.y * gridDim.z;
    unsigned sum, cnt, mine, sp = 0u;
    for (;;) {
        sum = 0u; cnt = 0u; mine = 0u;
#pragma unroll
        for (unsigned j = 0; j < 16; ++j) { const unsigned c = xb_ld(&bar[XB_XCNT(j)]); sum += c; cnt += (c > 0u) ? 1u : 0u; mine = (j == x) ? c : mine; }
        if (sum == G) break;
        __builtin_amdgcn_s_sleep(1);
        if ((++sp & 255u) == 0u) { if (xb_ld(&bar[XB_TMO])) break; if (sp > XB_SPIN_CAP) { atomicAdd(&bar[XB_TMO], 1u); break; } }
    }
    nloc = mine > 0u ? mine : 1u; nx = cnt > 0u ? cnt : 1u;
}

__device__ __forceinline__ void xcd_barrier(const XcdBarrier& b) {
    asm volatile("s_waitcnt vmcnt(0)" ::: "memory");
    __syncthreads();
    if (threadIdx.x == 0) {
        unsigned* bar = b.bar;
        __builtin_amdgcn_s_waitcnt(0);
        unsigned nloc = b.st[0], nx = b.st[1];
        if (nloc == 0u) { xcd_barrier_complete(bar, b.x, nloc, nx); b.st[0] = nloc; b.st[1] = nx; }
        const unsigned old = xb_add(&bar[XB_XSUB(b.x)], 1u);
        const unsigned gen = old / nloc;
        if (old + 1u == (gen + 1u) * nloc) {
            __builtin_amdgcn_fence(__ATOMIC_RELEASE, "agent");
            asm volatile("s_waitcnt vmcnt(0)" ::: "memory");
            const unsigned og = xb_add(&bar[XB_TOP], 1u);
            const unsigned tg = og / nx;
            if (og + 1u == (tg + 1u) * nx) xb_add(&bar[XB_TOPGEN], 1u);
            else XB_SPIN(xb_ld(&bar[XB_TOPGEN]) == tg, bar);
            __builtin_amdgcn_fence(__ATOMIC_ACQUIRE, "agent");
            xb_add(&bar[XB_XGEN(b.x)], 1u);
            asm volatile("s_waitcnt vmcnt(0)" ::: "memory");
        } else {
            XB_SPIN(xb_ld(&bar[XB_XGEN(b.x)]) == gen, bar);
            __builtin_amdgcn_fence(__ATOMIC_ACQUIRE, "agent");
            asm volatile("s_waitcnt vmcnt(0)" ::: "memory");
        }
    }
    __syncthreads();
}


__device__ __forceinline__ float wave_sum(float v) { return pg8::xsum32(pg8::xsum16(pg8::row16_sum(v))); }
#ifndef QKV_F8
#define QKV_F8 0
#endif
#ifndef FFN_DN_F8
#define FFN_DN_F8 1
#endif
#ifndef FFN_GU_F8
#define FFN_GU_F8 1
#endif
struct Conv { const float* src; const float* src2; const float* kscale; unsigned char* dst; int K, N, Kp, kind, f8; };
struct In { const float* p[27]; };
#define KA_CONST __attribute__((address_space(4)))
__device__ __forceinline__ const float* INP(int i) { return *(const float* const KA_CONST*)((const KA_CONST char*)__builtin_amdgcn_kernarg_segment_ptr() + 8 * i); }
constexpr int T_IN = (N_IN / 256) * (DM / 64), T_QB = (2048 / 256) * (512 / 64), T_KVB = (2560 / 256) * (256 / 64), T_O = (DM / 256) * (DM / 64), T_GU = (2 * DFF / 256) * (DM / 64), T_DN = (DM / 256) * (DFF / 64),
              T_QKV = (3 * DM / 256) * (DM / 64);
constexpr int T_TOTAL = T_IN + T_QB + T_KVB + T_O + T_GU + T_DN + T_QKV + T_O + NEXP * T_GU + NEXP * T_DN;
__device__ __forceinline__ Conv conv_decode(unsigned char* ws, int it, int& r) {
    r = it; Conv c;
    if (r < T_IN) { c = Conv{INP(1), nullptr, nullptr, ws + WB_IN, DM, W_IN_COLS_C, DM, 1, 0}; }
    else if ((r -= T_IN) < T_QB) { c = Conv{INP(3), nullptr, INP(2), ws + WB_QB, 448, 1920, 512, 2, 0}; }
    else if ((r -= T_QB) < T_KVB) { c = Conv{INP(5), nullptr, INP(4), ws + WB_KVB, 128, 2560, 256, 0, 0}; }
    else if ((r -= T_KVB) < T_O) { c = Conv{INP(6), nullptr, nullptr, ws + WB_O0, DM, DM, DM, 0, 0}; }
    else if ((r -= T_O) < T_GU) { c = Conv{INP(9), INP(10), nullptr, ws + WB_GU, DM, DFF, DM, 3, FFN_GU_F8}; }
    else if ((r -= T_GU) < T_DN) { c = Conv{INP(11), nullptr, nullptr, ws + WB_DN, DFF, DM, DFF, 0, FFN_DN_F8}; }
    else if ((r -= T_DN) < T_QKV) { c = Conv{INP(14), nullptr, nullptr, ws + WB_QKV, DM, 3 * DM, DM, 0, QKV_F8}; }
    else if ((r -= T_QKV) < T_O) { c = Conv{INP(17), nullptr, nullptr, ws + WB_O1, DM, DM, DM, 0, 0}; }
    else if ((r -= T_O) < NEXP * T_GU) { const int e = r / T_GU; r -= e * T_GU;
        c = Conv{INP(22) + (size_t)e * DM * DFF, INP(23) + (size_t)e * DM * DFF, nullptr, ws + WB_EGU + (size_t)e * 2 * DFF * DM, DM, DFF, DM, 3, 1}; }
    else { r -= NEXP * T_GU; const int e = r / T_DN; r -= e * T_DN;
        c = Conv{INP(24) + (size_t)e * DFF * DM, nullptr, nullptr, ws + WB_EDN + (size_t)e * DM * DFF, DFF, DM, DFF, 0, 1}; }
    return c;
}
__device__ __forceinline__ int conv_col(const Conv& c, int np, const float*& sp) {
    sp = c.src; int col = -1;
    if (c.kind == 0) { col = np < c.N ? np : -1; }
    else if (c.kind == 1) {
        const int t = np >> 8, w = np & 255, bj = w >> 7, ch = w & 127;
        if (t < 9) col = OFF_DQ_C + (2 * t + (ch >> 6)) * 128 + bj * 64 + (ch & 63);
        else if (t < 12) col = OFF_DK_C + (2 * (t - 9) + (ch >> 6)) * 128 + bj * 64 + (ch & 63);
        else if (t < 15) col = OFF_DV_C + (t - 12) * 256 + w;
        else if (t == 15) col = w;
        else if (t == 16) col = (256 + w < 448) ? 256 + w : -1;
        else col = ch < 64 ? OFF_CKV_C + bj * 64 + ch : (ch < 96 ? OFF_KROPE_C + bj * 32 + (ch - 64) : -1);
    } else if (c.kind == 2) {
        const int t = np >> 8;
        if (t < 5) col = (np >> 7) * 192 + (np & 127);
        else { const int w = np & 255, bj = w >> 7, ch = w & 127, head = 4 * (t - 5) + (ch >> 5); col = head < 10 ? head * 192 + 128 + bj * 32 + (ch & 31) : -1; }
    } else {
        const int t = np >> 8, w = np & 255, bj = w >> 7, ch = w & 127; const long long d2 = (const char*)c.src2 - (const char*)c.src; sp = (const float*)((const char*)c.src + (bj ? d2 : 0ll)); col = t * 128 + ch;
    }
    return col;
}
__device__ __forceinline__ void conv_load(const Conv& c, int r, int tid, f32x4 (&v)[8]) {
    const int nkb = c.Kp >> 6, rb = r / nkb, kb = r - rb * nkb, np = rb * 256 + (tid & 63) * 4, kl = tid >> 6, k0 = kb * 64;
    const float* sp; const int col = conv_col(c, np, sp);
#pragma unroll
    for (int i = 0; i < 8; ++i) { const int k = k0 + (c.f8 ? 4 * kl + 32 * (i >> 2) + (i & 3) : 2 * kl + 16 * (i >> 1) + (i & 1));
        v[i] = (col >= 0 && k < c.K) ? *(const f32x4*)(sp + (size_t)k * c.N + col) : (f32x4){0.f, 0.f, 0.f, 0.f}; }
    if (c.kscale) {
#pragma unroll
        for (int i = 0; i < 8; ++i) { const int k = k0 + 2 * kl + 16 * (i >> 1) + (i & 1); v[i] = v[i] * ((k < c.K) ? c.kscale[k] : 0.f); }
    }
}
constexpr int CV_PITCH = 1040;
__device__ __forceinline__ void conv_stage(const Conv& c, int tid, const f32x4 (&v)[8], LAS unsigned char* sm) {
    const int kl = tid >> 6, nl = (tid & 63) * 4;
    if (c.f8) {
#pragma unroll
        for (int j = 0; j < 2; ++j) { const int kg = kl + 8 * j, row = (kg & 3) * 4 + (kg >> 2); v4u o;
#pragma unroll
            for (int n = 0; n < 4; ++n) o[n] = pg8::pk4_fp8(v[4 * j][n] * pg8::W8_SCALE, v[4 * j + 1][n] * pg8::W8_SCALE, v[4 * j + 2][n] * pg8::W8_SCALE, v[4 * j + 3][n] * pg8::W8_SCALE);
            *(LAS v4u*)(sm + row * CV_PITCH + nl * 4) = o; }
    } else {
#pragma unroll
        for (int j = 0; j < 4; ++j) { const int kg = kl + 8 * j, row = (kg & 3) * 8 + (kg >> 2); v4u o;
#pragma unroll
            for (int n = 0; n < 4; ++n) o[n] = pk2(v[2 * j][n], v[2 * j + 1][n]);
            *(LAS v4u*)(sm + row * CV_PITCH + nl * 4) = o; }
    }
}
__device__ __forceinline__ void conv_store(const Conv& c, int r, int tid, const LAS unsigned char* sm) {
    const int nkb = c.Kp >> 6, rb = r / nkb, kb = r - rb * nkb;
    if (c.f8) {
        unsigned char* d = c.dst + (size_t)rb * 256 * c.Kp + kb * 64;
#pragma unroll
        for (int j = 0; j < 2; ++j) { const int idx = tid + 512 * j, n = idx >> 2, kc = idx & 3; v4u w;
#pragma unroll
            for (int q = 0; q < 4; ++q) w[q] = *(const LAS unsigned*)(sm + (q * 4 + kc) * CV_PITCH + n * 4);
            *(v4u*)(d + (size_t)n * c.Kp + 16 * kc) = w; }
    } else {
        unsigned char* d = c.dst + ((size_t)rb * 256 * c.Kp + kb * 64) * 2;
#pragma unroll
        for (int j = 0; j < 4; ++j) { const int idx = tid + 512 * j, n = idx >> 3, kc = idx & 7; v4u w;
#pragma unroll
            for (int q = 0; q < 4; ++q) w[q] = *(const LAS unsigned*)(sm + (q * 8 + kc) * CV_PITCH + n * 4);
            *(v4u*)(d + ((size_t)n * c.Kp + 8 * kc) * 2) = w; }
    }
}
__device__ __forceinline__ void conv_run(unsigned char* ws, LAS unsigned char* sm, int tid, int t_begin, int t_end, int nw, int w) {
    {
        const int CH = (t_end - t_begin + nw - 1) / nw, lim = t_begin + (w + 1) * CH < t_end ? t_begin + (w + 1) * CH : t_end;
        int it = t_begin + w * CH; f32x4 vA[8], vB[8];
        bool hasA = it < lim, hasB = it + 1 < lim;
        if (hasA) { int r; const Conv c = conv_decode(ws, it, r); conv_load(c, r, tid, vA); }
        if (hasB) { int r; const Conv c = conv_decode(ws, it + 1, r); conv_load(c, r, tid, vB); }
        while (hasA) {
            { int r; const Conv c = conv_decode(ws, it, r); conv_stage(c, tid, vA, sm); }
            const bool hasA2 = it + 2 < lim;
            if (hasA2) { int r; const Conv c = conv_decode(ws, it + 2, r); conv_load(c, r, tid, vA); }
            __syncthreads(); { int r; const Conv c = conv_decode(ws, it, r); conv_store(c, r, tid, sm); } __syncthreads();
            if (!hasB) break;
            { int r; const Conv c = conv_decode(ws, it + 1, r); conv_stage(c, tid, vB, sm); }
            const bool hasB2 = it + 3 < lim;
            if (hasB2) { int r; const Conv c = conv_decode(ws, it + 3, r); conv_load(c, r, tid, vB); }
            __syncthreads(); { int r; const Conv c = conv_decode(ws, it + 1, r); conv_store(c, r, tid, sm); } __syncthreads();
            it += 2; hasA = hasA2; hasB = hasB2;
        }
    }
}
constexpr int XT_GU = (2 * DFF / 128) * (DM / 64), XT_DN = (DM / 128) * (DFF / 64), XT_E = XT_GU + XT_DN, XT_TOTAL = NEXP * XT_E;
struct XTile { const float* src; unsigned char* dst; int N, Kp; };
__device__ __forceinline__ XTile xtile_decode(unsigned char* ws, int it) {
    const int e = it / XT_E; int r = it - e * XT_E; XTile x;
    if (r < XT_GU) { const int rb = r / (DM / 64), kb = r - rb * (DM / 64);
        x.src = (rb & 1 ? INP(23) : INP(22)) + (size_t)e * DM * DFF + (size_t)(kb * 64) * DFF + (rb >> 1) * 128; x.N = DFF; x.Kp = DM;
        x.dst = ws + WB_EGU + (size_t)e * 2 * DFF * DM + (size_t)(rb * 128) * DM + kb * 64; }
    else { r -= XT_GU; const int rb = r / (DFF / 64), kb = r - rb * (DFF / 64);
        x.src = INP(24) + (size_t)e * DFF * DM + (size_t)(kb * 64) * DM + rb * 128; x.N = DM; x.Kp = DFF;
        x.dst = ws + WB_EDN + (size_t)e * DM * DFF + (size_t)(rb * 128) * DFF + kb * 64; }
    return x;
}
__device__ __forceinline__ void xtile_dma(const XTile& x, LAS unsigned char* slot, int wave, int lane) {
#pragma unroll
    for (int j = 0; j < 4; ++j) { const int k = wave * 8 + 2 * j;
        __builtin_amdgcn_global_load_lds((const unsigned*)(x.src + (size_t)(k + (lane >> 5)) * x.N + (lane & 31) * 4), (LAS unsigned*)(slot + k * 512), 16, 0, 0); }
}
__device__ __forceinline__ void xtile_emit(const XTile& x, const LAS unsigned char* slot, int tid) {
    const int n = tid >> 2, kc = tid & 3; const LAS float* f = (const LAS float*)slot + (16 * kc) * 128 + n; v4u o;
#pragma unroll
    for (int q = 0; q < 4; ++q) o[q] = pg8::pk4_fp8(f[(4 * q) * 128] * pg8::W8_SCALE, f[(4 * q + 1) * 128] * pg8::W8_SCALE, f[(4 * q + 2) * 128] * pg8::W8_SCALE, f[(4 * q + 3) * 128] * pg8::W8_SCALE);
    *(v4u*)(x.dst + (size_t)n * x.Kp + 16 * kc) = o;
}
__device__ __forceinline__ void conv_run_dma(unsigned char* ws, LAS unsigned char* sm, int tid, int nw, int w) {
    const int wave = __builtin_amdgcn_readfirstlane(tid >> 6), lane = tid & 63;
    const int CH = (XT_TOTAL + nw - 1) / nw, beg = w * CH, lim = beg + CH < XT_TOTAL ? beg + CH : XT_TOTAL;
    if (beg >= lim) return;
#pragma unroll
    for (int d = 0; d < 3; ++d) { const int t = beg + d < lim ? beg + d : lim - 1; const XTile x = xtile_decode(ws, t); xtile_dma(x, sm + d * 32768, wave, lane); }
    for (int it = beg; it < lim; ++it) {
        asm volatile("s_waitcnt vmcnt(8)" ::: "memory");
        __builtin_amdgcn_s_barrier(); asm volatile("" ::: "memory");
        { const int t = it + 3 < lim ? it + 3 : lim - 1; const XTile x = xtile_decode(ws, t); xtile_dma(x, sm + ((it + 3 - beg) & 3) * 32768, wave, lane); }
        { const XTile x = xtile_decode(ws, it); xtile_emit(x, sm + ((it - beg) & 3) * 32768, tid); }
        asm volatile("s_waitcnt lgkmcnt(0)" ::: "memory");
    }
    asm volatile("s_waitcnt vmcnt(0)" ::: "memory"); __builtin_amdgcn_s_barrier();
}
#ifndef CONV_CUS
#define CONV_CUS 50
#endif
constexpr int T_NONEXP = T_IN + T_QB + T_KVB + T_O + T_GU + T_DN + T_QKV + T_O;
constexpr int T_P1TAIL = T_IN + T_QB + T_KVB + T_O + T_GU + T_DN;
#define P1_TAIL_IDLE(G_) (((TOK / 256) * (N_IN / 256) > 4 * (G_) && (TOK / 256) * (N_IN / 256) <= 5 * (G_)) ? 5 * (G_) - (TOK / 256) * (N_IN / 256) : 0)
constexpr int T_EARLY = T_IN + T_QB + T_KVB + T_O;
__device__ __forceinline__ void p0_prologue(unsigned char* ws, LAS unsigned char* sm, int bx, int G, int gw, int NGW, int lane, int tid) {
    conv_run(ws, sm, tid, 0, CONV_CUS ? T_EARLY : T_TOTAL, G, bx);
    { const float* x = INP(0); bf16* xb = (bf16*)(ws + WS_XB); const int gt = gw * 64 + lane, NGT = NGW * 64;
      for (int i = gt; i < TOK * DM / 8; i += NGT) { const f32x4 a = *(const f32x4*)(x + (size_t)i * 8), b = *(const f32x4*)(x + (size_t)i * 8 + 4);
          *(v4u*)(xb + (size_t)i * 8) = pg8::pack8(a, b); } }
    { const int gt = gw * 64 + lane, NGT = NGW * 64;
      for (int i = gt; i < SEQ * 96; i += NGT) {
          const int pos = i / 96, f = i - pos * 96; const bool big = f < 64; const int fi = big ? f : f - 64;
          const double ex = -13.287712379549449 * (big ? (double)fi / 64.0 : (double)fi / 32.0);
          const double inv = ::exp2(ex);
          const double rev = (double)pos * inv * 0.15915494309189535;
          const float fr = (float)(rev - __builtin_rint(rev));
          const float cs = __builtin_amdgcn_cosf(fr), sn = __builtin_amdgcn_sinf(fr);
          if (big) { ((float*)(ws + WS_COS128))[pos * 64 + fi] = cs; ((float*)(ws + WS_SIN128))[pos * 64 + fi] = sn; }
          else { ((float*)(ws + WS_COS64))[pos * 32 + fi] = cs; ((float*)(ws + WS_SIN64))[pos * 32 + fi] = sn; }
      } }
}

__device__ __forceinline__ void ln_core(f32x4 (&v)[8], const float* g, const float* b, int lane, float* mean_out = nullptr, float* rstd_out = nullptr) {
    float s = 0.f;
#pragma unroll
    for (int j = 0; j < 8; ++j) s += (v[j][0] + v[j][1]) + (v[j][2] + v[j][3]);
    const float mean = wave_sum(s) * (1.f / DM); float s2 = 0.f;
#pragma unroll
    for (int j = 0; j < 8; ++j) { v[j] = v[j] - mean; s2 += (v[j][0] * v[j][0] + v[j][1] * v[j][1]) + (v[j][2] * v[j][2] + v[j][3] * v[j][3]); }
    const float rstd = 1.f / sqrtf(wave_sum(s2) * (1.f / DM) + LN_EPS_C);
    if (mean_out) { *mean_out = mean; *rstd_out = rstd; }
#pragma unroll
    for (int j = 0; j < 8; ++j) { const f32x4 gg = *(const f32x4*)(g + 4 * (lane + 64 * j)), bb = *(const f32x4*)(b + 4 * (lane + 64 * j)); v[j] = v[j] * rstd * gg + bb; }
}
template <int EXTRA, bool OUT8 = false, bool WRITE_XB = true>
__device__ __forceinline__ void ln_phase(pg8::res_t* XR, bf16* XB, const float* g, const float* b, const float* ew, const float* eb, unsigned char* ws, LAS float* sm, int gw, int NGW, int lane, int tid) {
    constexpr int NH = EXTRA == 1 ? 16 : (EXTRA == 2 ? 8 : 0);
    if constexpr (EXTRA != 0) {
        for (int k = tid; k < DM; k += NWAVES * 64)
#pragma unroll
            for (int q = 0; q < NH / 4; ++q) { const f32x4 w4 = *(const f32x4*)(ew + (size_t)k * NH + 4 * q);
#pragma unroll
                for (int cc = 0; cc < 4; ++cc) sm[(4 * q + cc) * DM + k] = w4[cc]; }
        __syncthreads();
    }
    for (int row0 = gw; row0 < TOK; row0 += 2 * NGW) {
        const int row1 = row0 + NGW; const bool two = row1 < TOK; const int r1 = two ? row1 : row0;
        f32x4 v0[8], v1[8];
#pragma unroll
        for (int j = 0; j < 8; ++j) {
#if XR_BF16
            const v2u w0 = *(const v2u*)(XR + (size_t)row0 * DM + 4 * (lane + 64 * j)), w1 = *(const v2u*)(XR + (size_t)r1 * DM + 4 * (lane + 64 * j)); v0[j] = pg8::res4(w0.x, w0.y); v1[j] = pg8::res4(w1.x, w1.y);
#else
            v0[j] = *(const f32x4*)(XR + (size_t)row0 * DM + 4 * (lane + 64 * j)); v1[j] = *(const f32x4*)(XR + (size_t)r1 * DM + 4 * (lane + 64 * j));
#endif
        }
        float mu0, rs0, mu1, rs1;
        ln_core(v0, g, b, lane, &mu0, &rs0); ln_core(v1, g, b, lane, &mu1, &rs1);
        if (lane == 0) { f32x2* ST = (f32x2*)(ws + WS_STATS); ST[row0] = (f32x2){mu0, rs0}; if (two) ST[row1] = (f32x2){mu1, rs1}; }
        if constexpr (WRITE_XB) {
#pragma unroll
        for (int j = 0; j < 8; ++j) {
            if constexpr (OUT8) { *(unsigned*)((unsigned char*)XB + (size_t)row0 * DM + 4 * (lane + 64 * j)) = pg8::pk4_fp8(v0[j][0], v0[j][1], v0[j][2], v0[j][3]); }
            else { v2u o; o.x = pk2(v0[j][0], v0[j][1]); o.y = pk2(v0[j][2], v0[j][3]); *(v2u*)(XB + (size_t)row0 * DM + 4 * (lane + 64 * j)) = o; } }
        if (two) {
#pragma unroll
            for (int j = 0; j < 8; ++j) {
                if constexpr (OUT8) { *(unsigned*)((unsigned char*)XB + (size_t)row1 * DM + 4 * (lane + 64 * j)) = pg8::pk4_fp8(v1[j][0], v1[j][1], v1[j][2], v1[j][3]); }
                else { v2u o; o.x = pk2(v1[j][0], v1[j][1]); o.y = pk2(v1[j][2], v1[j][3]); *(v2u*)(XB + (size_t)row1 * DM + 4 * (lane + 64 * j)) = o; } }
        }
        }
        if constexpr (EXTRA != 0) {
            float m0 = 0.f, m1 = 0.f;
#pragma unroll 2
            for (int h = 0; h < NH; ++h) { float s0 = 0.f, s1 = 0.f;
#pragma unroll
                for (int j = 0; j < 8; ++j) { const f32x4 w4 = *(const LAS f32x4*)(sm + h * DM + 4 * (lane + 64 * j));
                    s0 += (v0[j][0] * w4[0] + v0[j][1] * w4[1]) + (v0[j][2] * w4[2] + v0[j][3] * w4[3]);
                    s1 += (v1[j][0] * w4[0] + v1[j][1] * w4[1]) + (v1[j][2] * w4[2] + v1[j][3] * w4[3]); }
                s0 = wave_sum(s0); s1 = wave_sum(s1);
                if (lane == h) { m0 = s0; m1 = s1; } }
            if constexpr (EXTRA == 1) {
                if (lane < 16) { const float bb = eb[lane]; float z = m0 + bb;
                    ((float*)(ws + WS_LOGF))[(size_t)row0 * 16 + lane] = fminf(z, 0.f) - log1pf(__expf(-fabsf(z)));
                    z = m1 + bb;
                    if (two) ((float*)(ws + WS_LOGF))[(size_t)row1 * 16 + lane] = fminf(z, 0.f) - log1pf(__expf(-fabsf(z))); }
            } else {
                const float bb = lane < 8 ? eb[lane] : 0.f; m0 += bb; m1 += bb;
#pragma unroll
                for (int rr = 0; rr < 2; ++rr) {
                    float a[8];
#pragma unroll
                    for (int h = 0; h < 8; ++h) a[h] = __shfl(rr ? m1 : m0, h);
                    int e0 = 0; float l0 = a[0];
#pragma unroll
                    for (int h = 1; h < 8; ++h) if (a[h] > l0) { l0 = a[h]; e0 = h; }
                    int e1 = -1; float l1 = -__builtin_inff();
#pragma unroll
                    for (int h = 0; h < 8; ++h) if (h != e0 && a[h] > l1) { l1 = a[h]; e1 = h; }
                    const int row = rr ? row1 : row0;
                    if (lane == 0 && (rr == 0 || two)) { const float w0 = 1.f / (1.f + __expf(l1 - l0));
                        ((int*)(ws + RT_E))[row] = e0 | (e1 << 8);
                        ((f32x2*)(ws + RT_W))[row] = (f32x2){w0, 1.f - w0}; }
                }
            }
        }
    }
    if constexpr (EXTRA != 0) __syncthreads();
}
__device__ __forceinline__ void merge_phase(unsigned char* ws, int gw, int NGW, int lane) {
    const bf16* OG = (const bf16*)(ws + S_OG); const float* LSE = (const float*)(ws + WS_LSE); bf16* MIX = (bf16*)(ws + S_MIX);
    for (int tok = gw; tok < TOK; tok += NGW) {
#pragma unroll
        for (int h = 0; h < 6; ++h) {
            const float l0 = LSE[(size_t)tok * 6 + h], l1 = LSE[(size_t)TOK * 6 + (size_t)tok * 6 + h], l2 = LSE[(size_t)2 * TOK * 6 + (size_t)tok * 6 + h];
            const float mx = fmaxf(l0, fmaxf(l1, l2)); const float e0 = __expf(l0 - mx), e1 = __expf(l1 - mx), e2 = __expf(l2 - mx); const float inv = 1.f / (e0 + e1 + e2);
            const unsigned a = *(const unsigned*)(OG + (size_t)tok * 768 + h * 128 + 2 * lane), b = *(const unsigned*)(OG + (size_t)TOK * 768 + (size_t)tok * 768 + h * 128 + 2 * lane),
                           c = *(const unsigned*)(OG + (size_t)2 * TOK * 768 + (size_t)tok * 768 + h * 128 + 2 * lane);
            const float lo = (e0 * bf2f(a & 0xffff) + e1 * bf2f(b & 0xffff) + e2 * bf2f(c & 0xffff)) * inv, hi = (e0 * bf2f(a >> 16) + e1 * bf2f(b >> 16) + e2 * bf2f(c >> 16)) * inv;
            *(unsigned*)(MIX + (size_t)tok * DM + 1280 + h * 128 + 2 * lane) = pk2(lo, hi);
        }
    }
}
__device__ __forceinline__ void scan_phase(unsigned char* ws, LAS float* sm, int bh, int tid) {
    const int b = bh >> 4, h = bh & 15; const float* LOGF = (const float*)(ws + WS_LOGF); float* CUM = (float*)(ws + WS_CUM) + (size_t)bh * SEQ;
    float v[16]; float run = 0.f;
#pragma unroll
    for (int i = 0; i < 16; ++i) { run += LOGF[((size_t)b * SEQ + tid * 16 + i) * 16 + h]; v[i] = run; }
    const int lane = tid & 63, wave = tid >> 6;
    float inc = run;
#pragma unroll
    for (int o = 1; o < 64; o <<= 1) { const float t = __shfl_up(inc, o); if (lane >= o) inc += t; }
    if (lane == 63) sm[wave] = inc;
    __syncthreads();
    float base = inc - run;
#pragma unroll
    for (int w = 0; w < 8; ++w) if (w < wave) base += sm[w];
#pragma unroll
    for (int i = 0; i < 16; ++i) CUM[tid * 16 + i] = base + v[i];
    __syncthreads();
}
__device__ __forceinline__ void dispatch_phase(unsigned char* ws, LAS int* sm, int tid) {
    const int* E = (const int*)(ws + RT_E); int* SLOT = (int*)(ws + RT_SLOT); int* META = (int*)(ws + RT_META);
    int c[8]; LAS int* ev = sm + 8192 + tid * 33;
#pragma unroll
    for (int e = 0; e < 8; ++e) c[e] = 0;
#pragma unroll
    for (int i = 0; i < 8; ++i) { const v4u q = *(const v4u*)(E + tid * 32 + 4 * i); ev[4 * i] = (int)q.x; ev[4 * i + 1] = (int)q.y; ev[4 * i + 2] = (int)q.z; ev[4 * i + 3] = (int)q.w; }
#pragma unroll 2
    for (int i = 0; i < 32; ++i) { const int e0 = ev[i] & 255, e1 = ev[i] >> 8;
#pragma unroll
        for (int e = 0; e < 8; ++e) c[e] += (e0 == e) + (e1 == e); }
#pragma unroll
    for (int e = 0; e < 8; ++e) sm[tid * 8 + e] = c[e];
    __syncthreads();
    { const int wave = tid >> 6, lane = tid & 63;
      int loc[8]; int s = 0;
#pragma unroll
      for (int i = 0; i < 8; ++i) { loc[i] = s; s += sm[(lane * 8 + i) * 8 + wave]; }
      int inc = s;
#pragma unroll
      for (int o = 1; o < 64; o <<= 1) { const int t = __shfl_up(inc, o); if (lane >= o) inc += t; }
      const int exc = inc - s;
      __syncthreads();
#pragma unroll
      for (int i = 0; i < 8; ++i) sm[(lane * 8 + i) * 8 + wave] = exc + loc[i];
      if (lane == 63) sm[4096 + wave] = inc; }
    __syncthreads();
    if (tid == 0) { int off = 0;
        for (int e = 0; e < 8; ++e) { const int n = sm[4096 + e], np = (n + 255) & ~255; META[8 + e] = n; META[16 + e] = off; sm[4104 + e] = off;
            for (int t = off >> 8; t < (off + np) >> 8; ++t) META[32 + t] = e;
            off += np; }
        META[0] = off >> 8; }
    __syncthreads();
    int base[8];
#pragma unroll
    for (int e = 0; e < 8; ++e) base[e] = sm[4104 + e] + sm[tid * 8 + e];
#pragma unroll 2
    for (int i = 0; i < 32; ++i) { const int e0 = ev[i] & 255, e1 = ev[i] >> 8; int s0 = 0, s1 = 0;
#pragma unroll
        for (int e = 0; e < 8; ++e) { if (e0 == e) { s0 = base[e]; base[e]++; } if (e1 == e) { s1 = base[e]; base[e]++; } }
        *(v2u*)(SLOT + (tid * 32 + i) * 2) = (v2u){(unsigned)s0, (unsigned)s1}; }
    __syncthreads();
}
__device__ __forceinline__ void gather_phase(unsigned char* ws, const float* lg, const float* lb, int gw, int NGW, int lane) {
    const pg8::res_t* XR = (const pg8::res_t*)(ws + WS_XR); unsigned char* XP = ws + S_XP; const int* SLOT = (const int*)(ws + RT_SLOT); const int* META = (const int*)(ws + RT_META);
    for (int tok = gw; tok < TOK; tok += NGW) {
        const v2u sl = *(const v2u*)(SLOT + 2 * tok); const int s0 = (int)sl.x, s1 = (int)sl.y;
        const f32x2 st = ((const f32x2*)(ws + WS_STATS))[tok];
#pragma unroll
        for (int j = 0; j < 2; ++j) { const pg8::res_t* xp = XR + (size_t)tok * DM + 16 * (lane + 64 * j); const float* gp = lg + 16 * (lane + 64 * j); const float* bp = lb + 16 * (lane + 64 * j);
#if XR_BF16
            const v4u w0 = *(const v4u*)xp, w1 = *(const v4u*)(xp + 8); const f32x4 xa = pg8::res4(w0.x, w0.y), xb = pg8::res4(w0.z, w0.w), xc = pg8::res4(w1.x, w1.y), xd = pg8::res4(w1.z, w1.w);
#else
            const f32x4 xa = *(const f32x4*)xp, xb = *(const f32x4*)(xp + 4), xc = *(const f32x4*)(xp + 8), xd = *(const f32x4*)(xp + 12);
#endif
            const f32x4 a = (xa - st[0]) * st[1] * *(const f32x4*)gp + *(const f32x4*)bp, b = (xb - st[0]) * st[1] * *(const f32x4*)(gp + 4) + *(const f32x4*)(bp + 4),
                        c = (xc - st[0]) * st[1] * *(const f32x4*)(gp + 8) + *(const f32x4*)(bp + 8), d = (xd - st[0]) * st[1] * *(const f32x4*)(gp + 12) + *(const f32x4*)(bp + 12);
            v4u x; x.x = pg8::pk4_fp8(a[0], a[1], a[2], a[3]); x.y = pg8::pk4_fp8(b[0], b[1], b[2], b[3]); x.z = pg8::pk4_fp8(c[0], c[1], c[2], c[3]); x.w = pg8::pk4_fp8(d[0], d[1], d[2], d[3]);
            *(v4u*)(XP + (size_t)s0 * DM + 16 * (lane + 64 * j)) = x; *(v4u*)(XP + (size_t)s1 * DM + 16 * (lane + 64 * j)) = x; }
    }
    for (int e = 0; e < 8; ++e) { const int n = META[8 + e], off = META[16 + e], np = (n + 255) & ~255; const v4u z = {0u, 0u, 0u, 0u};
        for (int r = n + gw; r < np; r += NGW)
#pragma unroll
            for (int j = 0; j < 2; ++j) *(v4u*)(XP + (size_t)(off + r) * DM + 16 * (lane + 64 * j)) = z; }
}
__device__ __forceinline__ void final_phase(unsigned char* ws, float* out, const float* lg, const float* lb, const float* g, const float* b, int gw, int NGW, int lane) {
    const pg8::res_t* XR = (const pg8::res_t*)(ws + WS_XR); const bf16* YP = (const bf16*)(ws + S_XP); const bf16* YPB = (const bf16*)(ws + R_YPB); const int* SLOT = (const int*)(ws + RT_SLOT); const f32x2* RW = (const f32x2*)(ws + RT_W);
    for (int row = gw; row < TOK; row += NGW) {
        const v2u sl = *(const v2u*)(SLOT + 2 * row); const int s0 = (int)sl.x, s1 = (int)sl.y; const f32x2 w = RW[row]; const f32x2 st = ((const f32x2*)(ws + WS_STATS))[row];
        f32x4 v[8];
#pragma unroll
        for (int j = 0; j < 8; ++j) {
#if XR_BF16
            const v2u xw = *(const v2u*)(XR + (size_t)row * DM + 4 * (lane + 64 * j)); const f32x4 xr = pg8::res4(xw.x, xw.y);
#else
            const f32x4 xr = *(const f32x4*)(XR + (size_t)row * DM + 4 * (lane + 64 * j));
#endif
            const f32x4 x = (xr - st[0]) * st[1] * *(const f32x4*)(lg + 4 * (lane + 64 * j)) + *(const f32x4*)(lb + 4 * (lane + 64 * j));
            const v2u a = *(const v2u*)(YP + (size_t)s0 * DM + 4 * (lane + 64 * j)), c = *(const v2u*)(YP + (size_t)s1 * DM + 4 * (lane + 64 * j));
            f32x4 ya = {bf2f(a.x & 0xffff), bf2f(a.x >> 16), bf2f(a.y & 0xffff), bf2f(a.y >> 16)}, yc = {bf2f(c.x & 0xffff), bf2f(c.x >> 16), bf2f(c.y & 0xffff), bf2f(c.y >> 16)};
            if (s0 >= MOE_MAIN_TILES * 256) { const v2u q = *(const v2u*)(YPB + (size_t)(s0 - MOE_MAIN_TILES * 256) * DM + 4 * (lane + 64 * j)); ya += (f32x4){bf2f(q.x & 0xffff), bf2f(q.x >> 16), bf2f(q.y & 0xffff), bf2f(q.y >> 16)}; }
            if (s1 >= MOE_MAIN_TILES * 256) { const v2u q = *(const v2u*)(YPB + (size_t)(s1 - MOE_MAIN_TILES * 256) * DM + 4 * (lane + 64 * j)); yc += (f32x4){bf2f(q.x & 0xffff), bf2f(q.x >> 16), bf2f(q.y & 0xffff), bf2f(q.y >> 16)}; }
            const f32x4 m = ya * w[0] + yc * w[1];
            v[j] = x * pg8::ALPHA_RES + m; }
        ln_core(v, g, b, lane);
#pragma unroll
        for (int j = 0; j < 8; ++j) *(f32x4*)(out + (size_t)row * DM + 4 * (lane + 64 * j)) = v[j];
    }
}

__device__ __forceinline__ int snake_k(int i, int G, int c) { return (i & 1) ? i * G + (G - 1 - c) : i * G + c; }
__device__ __forceinline__ int snake_count(int total, int G, int c) { int n = 0; while (snake_k(n, G, c) < total) ++n; return n; }
struct FoxList {
    int G, c; unsigned char* ws; int j0, j1, j2, j3, n;
    __device__ __forceinline__ int first_tile(int i) const {
        const int k = snake_k(i, G, c), qb = 31 - (k >> 5), bh = k & 31, b = bh >> 4, h = bh & 15;
        const float* C = (const float*)(ws + WS_CUM) + (size_t)bh * SEQ;
        const unsigned* MP = (const unsigned*)(ws + WS_CTL) + CW_QKMAX;
        const float qm = __uint_as_float(MP[(0 * 2 + b) * 16 + h]), km = __uint_as_float(MP[(1 * 2 + b) * 16 + h]);
        const float S = 1.1f * 0.08838834764831845f * 4.0f * sqrtf(qm * km), thr = -(2.0f * S + 110.0f);
        const int lane = threadIdx.x & 63, nt0 = qb * 4;
        const float c0 = C[qb * 256];
        const bool keep0 = (lane < nt0) ? (c0 - C[64 * lane + 63] >= thr) : true, keep1 = (lane + 64 < nt0) ? (c0 - C[64 * (lane + 64) + 63] >= thr) : true;
        const unsigned long long m0 = __ballot(keep0), m1 = __ballot(keep1);
        int j = m0 ? __builtin_ctzll(m0) : 64 + (m1 ? __builtin_ctzll(m1) : 0);
        return j > nt0 ? nt0 : j; }
    __device__ __forceinline__ void init(int G_, int c_, unsigned char* ws_) { G = G_; c = c_; ws = ws_; n = snake_count(1024, G, c); j0 = j1 = j2 = j3 = 0;
        if (n > 0) j0 = first_tile(0); if (n > 1) j1 = first_tile(1); if (n > 2) j2 = first_tile(2); if (n > 3) j3 = first_tile(3); }
    __device__ __forceinline__ int count() const { return n; }
    __device__ __forceinline__ att::Item get(int i) const {
        const int k = snake_k(i, G, c), qb = 31 - (k >> 5), bh = k & 31, b = bh >> 4, h = bh & 15; att::Item it{};
        const bf16* Q1 = (const bf16*)(ws + R_Q1); const bf16* K1 = (const bf16*)(ws + R_K1); const bf16* V1 = (const bf16*)(ws + R_V1); bf16* MIX = (bf16*)(ws + S_MIX);
        it.Q = Q1 + ((size_t)b * SEQ + qb * 256) * DM + h * 128; it.K = K1 + (size_t)b * SEQ * DM + h * 128; it.V = V1 + (size_t)b * SEQ * DM + h * 128;
        it.O = MIX + ((size_t)b * SEQ + qb * 256) * DM + h * 128; it.C = (const float*)(ws + WS_CUM) + (size_t)bh * SEQ;
        it.Q2 = nullptr; it.K2 = nullptr; it.L = nullptr; it.qp = DM; it.kp = DM; it.vp = DM; it.op = DM; it.qp2 = 0; it.kp2 = 0; it.lp = 0; it.P0 = qb * 256; it.skv = SEQ; it.W = SEQ;
        it.jlo = i == 0 ? j0 : (i == 1 ? j1 : (i == 2 ? j2 : (i == 3 ? j3 : 0)));
        return it; }
};
struct MlaList {
    int G, c; unsigned char* ws;
    __device__ __forceinline__ int count() const { return snake_count(640, G, c); }
    __device__ __forceinline__ att::Item get(int i) const {
        const int k = snake_k(i, G, c), qb = 31 - k / 20, bh = k % 20, b = bh / 10, h = bh % 10; att::Item it{};
        const size_t r0 = (size_t)b * SEQ + qb * 256, k0 = (size_t)b * SEQ;
        it.Q = (const bf16*)(ws + R_QN) + r0 * 1280 + h * 128; it.Q2 = (const bf16*)(ws + R_QR) + r0 * 640 + h * 64;
        it.K = (const bf16*)(ws + R_KN) + k0 * 1280 + h * 128; it.K2 = (const bf16*)(ws + R_KR) + k0 * 64; it.V = (const bf16*)(ws + R_VV) + k0 * 1280 + h * 128;
        it.O = (bf16*)(ws + S_MIX) + r0 * DM + h * 128; it.C = nullptr; it.L = nullptr;
        it.qp = 1280; it.kp = 1280; it.vp = 1280; it.op = DM; it.qp2 = 640; it.kp2 = 64; it.lp = 0; it.P0 = qb * 256; it.skv = SEQ; it.W = SEQ;
        return it; }
};
struct DilList {
    int start, n; unsigned char* ws;
    __device__ __forceinline__ void init(int G, int c) {
        const int tgt = (4224000 + 1152 * 970 + G / 2) / G;
        int acc = 0, prev = 0, cur = 0;
        for (int j = 0; j <= c; ++j) {
            int s = 0; for (int i = 0; snake_k(i, G, j) < 640; ++i) s += 4 * (32 - snake_k(i, G, j) / 20);
            int d = tgt - 100 * s; if (d < 0) d = 0;
            acc += d; prev = cur; cur = (acc + 485) / 970; if (cur > 1152) cur = 1152; }
        if (c == G - 1) cur = 1152;
        if (prev > cur) prev = cur;
        start = prev; n = cur - prev;
    }
    __device__ __forceinline__ int count() const { return n; }
    __device__ __forceinline__ att::Item get(int i) const {
        const int k = start + i, j = k & 31, rest = k >> 5, g = rest % 3, h = (rest / 3) % 6, b = rest / 18, d = 1 << (2 * g), r = j & (d - 1), sb = j >> (2 * g); att::Item it{};
        const size_t t0 = (size_t)b * SEQ + (size_t)sb * 256 * d + r, tk = (size_t)b * SEQ + r;
        it.Q = (const bf16*)(ws + R_DQ) + t0 * 2304 + (g * 6 + h) * 128; it.K = (const bf16*)(ws + R_DK) + tk * 768 + h * 128; it.V = (const bf16*)(ws + R_DV) + tk * 768 + h * 128;
        it.O = (bf16*)(ws + S_OG) + (size_t)g * TOK * 768 + t0 * 768 + h * 128; it.L = (float*)(ws + WS_LSE) + (size_t)g * TOK * 6 + t0 * 6 + h;
        it.Q2 = nullptr; it.K2 = nullptr; it.C = nullptr; it.qp = 2304 * d; it.kp = 768 * d; it.vp = 768 * d; it.op = 768 * d; it.qp2 = 0; it.kp2 = 0; it.lp = 6 * d;
        it.P0 = sb * 256; it.skv = SEQ / d; it.W = 129;
        return it; }
};

struct Args { In in; float* out; unsigned char* ws; int ph_lo, ph_hi; };
static_assert(sizeof(Args) == 240, "kernarg layout");
__global__ void __launch_bounds__(NWAVES * 64, 2) mega_fwd(Args args) {
    extern __shared__ __attribute__((aligned(16))) unsigned char lds[];
    LAS unsigned char* ldsl = (LAS unsigned char*)lds;
    volatile LAS unsigned* MISC = (volatile LAS unsigned*)(ldsl + MISC_OFF);
    const int tid = threadIdx.x, lane = tid & 63, wave = __builtin_amdgcn_readfirstlane(tid >> 6);
    const int G = gridDim.x, bx = blockIdx.x, gw = bx * NWAVES + wave, NGW = G * NWAVES;
    unsigned char* ws = *(unsigned char* const KA_CONST*)((const KA_CONST char*)__builtin_amdgcn_kernarg_segment_ptr() + 224);
    gu32* ctl = (gu32*)(ws + WS_CTL);
    for (int u = tid; u < (LDS_BYTES - LDSCTL_OFF) / 4; u += NWAVES * 64) ((LAS unsigned*)(ldsl + LDSCTL_OFF))[u] = 0u;
    __syncthreads();
#if MK_PER_PHASE
#define GRID_BAR() do { } while (0)
#else
    XcdBarrier bar = xcd_barrier_post((unsigned*)(ctl + CW_BAR), MISC + 8);
#define GRID_BAR() xcd_barrier(bar)
#endif
    const int lo = *(const KA_CONST int*)((const KA_CONST char*)__builtin_amdgcn_kernarg_segment_ptr() + 232), hi = *(const KA_CONST int*)((const KA_CONST char*)__builtin_amdgcn_kernarg_segment_ptr() + 236);
#ifndef PH_MASK
#define PH_MASK 0x7ffff
#endif
#define IN(k) ((((PH_MASK) >> (k)) & 1) && lo <= (k) && (k) < hi)
#define BOTH(k) (IN(k) && IN((k) + 1))
#ifndef REP_MASK
#define REP_MASK 0
#endif
#define REP(k) (((REP_MASK) >> (k)) & 1)
#ifndef EPI_PROBE
#define EPI_PROBE (-1)
#define EPI_PROBE_MODE 1
#define EPI_AMP 8
#endif
#define PB(k) ((k) == EPI_PROBE ? EPI_PROBE_MODE : 0)
#ifndef STG_MODE
#define STG_MODE 0
#endif
#if STG_MODE == 1
#define STG_GRP (bx & 7)
#define STG_G 8
#elif STG_MODE == 2
#define STG_GRP ((bx >> 3) & 3)
#define STG_G 4
#endif
#if STG_MODE
#define STAGGER(period_ticks) do { const unsigned d = (unsigned)STG_GRP * (unsigned)(period_ticks) / STG_G; if (d) { const unsigned long long t0 = __builtin_amdgcn_s_memrealtime(); while (__builtin_amdgcn_s_memrealtime() - t0 < d) __builtin_amdgcn_s_sleep(4); } } while (0)
#else
#define STAGGER(period_ticks) do { } while (0)
#endif
#define EPI_SPIN(k) do { if ((k) == EPI_PROBE) { __syncthreads(); if (bx == 0) { const unsigned long long ticks = (unsigned long long)MISC[32] * EPI_AMP, t0 = __builtin_amdgcn_s_memrealtime(); while (__builtin_amdgcn_s_memrealtime() - t0 < ticks) __builtin_amdgcn_s_sleep(8); } } } while (0)
#define XB ((bf16*)(ws + WS_XB))
#define XR ((pg8::res_t*)(ws + WS_XR))
#if XR_BF16
#define RES0 ((const pg8::res_t*)XB)
#else
#define RES0 ((const pg8::res_t*)INP(0))
#endif
#define MIX ((bf16*)(ws + S_MIX))
#define COS128 ((const float*)(ws + WS_COS128))
#define SIN128 ((const float*)(ws + WS_SIN128))
#define COS64 ((const float*)(ws + WS_COS64))
#define SIN64 ((const float*)(ws + WS_SIN64))
#define SSQ ((float*)(ws + WS_SSQ))

    if (IN(0)) {
#if REP(0)
        p0_prologue(ws, ldsl + RING_OFF, bx, G, gw, NGW, lane, tid); GRID_BAR();
#endif
        p0_prologue(ws, ldsl + RING_OFF, bx, G, gw, NGW, lane, tid); if (BOTH(0)) GRID_BAR(); }
    if (IN(1)) {
        pg8::Gemm g{XB, (const bf16*)(ws + WB_IN), TOK, N_IN, DM}; pg8::StaticOrder S; S.init(TOK, N_IN, G, bx);
        pg8::EpiIn E{(bf16*)(ws + R_DQ), (bf16*)(ws + R_DK), (bf16*)(ws + R_DV), (bf16*)(ws + R_CQ), (bf16*)(ws + R_CKV), (bf16*)(ws + R_KR), SSQ, COS128, SIN128, COS64, SIN64};
#if REP(1)
        pg8::gemm_phase<pg8::EpiIn, pg8::StaticOrder, true, true>(ldsl + RING_OFF, g, S, E); GRID_BAR();
#endif
        STAGGER(4600);
        pg8::gemm_phase<pg8::EpiIn, pg8::StaticOrder, true, true, false, PB(1)>(ldsl + RING_OFF, g, S, E); EPI_SPIN(1);
        if (CONV_CUS && P1_TAIL_IDLE(G) > 0 && bx >= G - P1_TAIL_IDLE(G)) { __syncthreads(); conv_run(ws, ldsl + RING_OFF, tid, T_EARLY, T_P1TAIL, P1_TAIL_IDLE(G), bx - (G - P1_TAIL_IDLE(G))); }
        if (BOTH(1)) GRID_BAR();
    }
    if (IN(2)) {
        { pg8::Gemm g{(const bf16*)(ws + R_CQ), (const bf16*)(ws + WB_QB), TOK, 2048, 512}; pg8::StaticOrder S; S.init(TOK, 2048, G, bx);
          pg8::EpiQb E{(bf16*)(ws + R_QN), (bf16*)(ws + R_QR), SSQ, COS64, SIN64};
          pg8::gemm_phase<pg8::EpiQb, pg8::StaticOrder, true, true>(ldsl + RING_OFF, g, S, E); }
        { pg8::Gemm g{(const bf16*)(ws + R_CKV), (const bf16*)(ws + WB_KVB), TOK, 2560, 256}; pg8::StaticOrder S; S.init(TOK, 2560, G, bx);
          pg8::EpiKvb E{(bf16*)(ws + R_KN), (bf16*)(ws + R_VV), SSQ};
          pg8::gemm_phase<pg8::EpiKvb, pg8::StaticOrder, true, true>(ldsl + RING_OFF, g, S, E); }
        if (BOTH(2)) GRID_BAR();
    }
    if (IN(3)) {
        if (CONV_CUS && bx < CONV_CUS) { conv_run_dma(ws, ldsl + RING_OFF, tid, CONV_CUS, bx); __syncthreads(); conv_run(ws, ldsl + RING_OFF, tid, P1_TAIL_IDLE(G) > 0 ? T_P1TAIL : T_EARLY, T_NONEXP, CONV_CUS, bx); }
        else {
            const int Ga = G - CONV_CUS, ca = bx - CONV_CUS;
            { MlaList L{Ga, ca, ws}; att::attn_run<2, MlaList>((char*)lds + RING_OFF, L); }
            { DilList L; L.ws = ws; L.init(Ga, ca); att::attn_run<0, DilList>((char*)lds + RING_OFF, L); }
        }
        if (BOTH(3)) GRID_BAR();
    }
    if (IN(4)) {
#ifdef THIN_PROBE
        merge_phase(ws, gw, NGW, lane); GRID_BAR();
#endif
        merge_phase(ws, gw, NGW, lane); if (BOTH(4)) GRID_BAR(); }
    if (IN(5)) {
        pg8::Gemm g{MIX, (const bf16*)(ws + WB_O0), TOK, DM, DM}; pg8::StaticOrder S; S.init(TOK, DM, G, bx);
        pg8::EpiRes E{RES0, XR, 1.f, nullptr, nullptr, nullptr};
        pg8::gemm_phase<pg8::EpiRes, pg8::StaticOrder, true, true, false, PB(5)>(ldsl + RING_OFF, g, S, E); EPI_SPIN(5);
        if (BOTH(5)) GRID_BAR();
    }
    if (IN(6)) {
        ln_phase<0, FFN_GU_F8 != 0>(XR, XB, INP(7), INP(8), nullptr, nullptr, ws, (LAS float*)(ldsl + RING_OFF), gw, NGW, lane, tid); if (BOTH(6)) GRID_BAR(); }
    if (IN(7)) {
        pg8::Gemm g{XB, (const bf16*)(ws + WB_GU), TOK, 2 * DFF, FFN_GU_F8 ? DM / 2 : DM}; pg8::StaticOrder S; S.init(TOK, 2 * DFF, G, bx);
#if FFN_DN_F8
        pg8::EpiSwiglu8 E{ws + R_HF, DFF};
        pg8::gemm_phase<pg8::EpiSwiglu8, pg8::StaticOrder, true, true, true>(ldsl + RING_OFF, g, S, E);
#else
        pg8::EpiSwiglu E{(bf16*)(ws + R_HF), DFF, 0, FFN_GU_F8 ? 1.f / pg8::W8_SCALE : 1.f};
        STAGGER(2600);
        pg8::gemm_phase<pg8::EpiSwiglu, pg8::StaticOrder, true, true, FFN_GU_F8 != 0, PB(7)>(ldsl + RING_OFF, g, S, E); EPI_SPIN(7);
#endif
        if (BOTH(7)) GRID_BAR();
    }
    if (IN(8)) {
        pg8::Gemm g{(const bf16*)(ws + R_HF), (const bf16*)(ws + WB_DN), TOK, DM, FFN_DN_F8 ? DFF / 2 : DFF}; pg8::StaticOrder S; S.init(TOK, DM, G, bx);
        pg8::EpiRes E{XR, XR, FFN_DN_F8 ? 1.f / (pg8::W8_SCALE * pg8::H8_SCALE) : 1.f, (const float*)(ws + WS_STATS), INP(7), INP(8)};
        pg8::gemm_phase<pg8::EpiRes, pg8::StaticOrder, true, true, FFN_DN_F8 != 0, PB(8)>(ldsl + RING_OFF, g, S, E); EPI_SPIN(8);
        if (BOTH(8)) GRID_BAR();
    }
    if (IN(9)) {
        ln_phase<1, QKV_F8 != 0>(XR, XB, INP(12), INP(13), INP(15), INP(16), ws, (LAS float*)(ldsl + RING_OFF), gw, NGW, lane, tid); if (BOTH(9)) GRID_BAR(); }
    if (IN(10)) {
        if (bx < 32) scan_phase(ws, (LAS float*)(ldsl + RING_OFF), bx, tid);
        pg8::Gemm g{XB, (const bf16*)(ws + WB_QKV), TOK, 3 * DM, QKV_F8 ? DM / 2 : DM}; pg8::StaticOrder S; S.init(TOK, 3 * DM, G, bx);
        pg8::EpiPlain E{(bf16*)(ws + R_Q1), DM, DM, (size_t)TOK * DM, QKV_F8 ? 1.f / pg8::W8_SCALE : 1.f, (unsigned*)(ws + WS_CTL) + CW_QKMAX};
#if REP(10)
        pg8::gemm_phase<pg8::EpiPlain, pg8::StaticOrder, true, true, QKV_F8 != 0>(ldsl + RING_OFF, g, S, E); GRID_BAR();
#endif
        pg8::gemm_phase<pg8::EpiPlain, pg8::StaticOrder, true, true, QKV_F8 != 0, PB(10)>(ldsl + RING_OFF, g, S, E); EPI_SPIN(10);
        if (BOTH(10)) GRID_BAR();
    }
    if (IN(11)) {
#if REP(11)
        for (int rep_ = 0; rep_ < 2; ++rep_) { FoxList L; L.init(G, bx, ws); att::attn_run<1, FoxList>((char*)lds + RING_OFF, L); GRID_BAR(); }
#else
        { FoxList L; L.init(G, bx, ws); att::attn_run<1, FoxList>((char*)lds + RING_OFF, L); } if (BOTH(11)) GRID_BAR();
#endif
    }
    if (IN(12)) {
        pg8::Gemm g{MIX, (const bf16*)(ws + WB_O1), TOK, DM, DM}; pg8::StaticOrder S; S.init(TOK, DM, G, bx);
        pg8::EpiRes E{XR, XR, 1.f, (const float*)(ws + WS_STATS), INP(12), INP(13)};
        pg8::gemm_phase<pg8::EpiRes, pg8::StaticOrder, true, true, false, PB(12)>(ldsl + RING_OFF, g, S, E); EPI_SPIN(12);
        if (BOTH(12)) GRID_BAR();
    }
    if (IN(13)) {
        ln_phase<2, false, false>(XR, XB, INP(18), INP(19), INP(20), INP(21), ws, (LAS float*)(ldsl + RING_OFF), gw, NGW, lane, tid); if (BOTH(13)) GRID_BAR(); }
    if (IN(14)) {
#ifdef THIN_PROBE
        if (bx == 0) dispatch_phase(ws, (LAS int*)(ldsl + RING_OFF), tid); GRID_BAR();
#endif
        if (bx == 0) dispatch_phase(ws, (LAS int*)(ldsl + RING_OFF), tid); if (BOTH(14)) GRID_BAR(); }
    if (IN(15)) {
#ifdef THIN_PROBE
        gather_phase(ws, INP(18), INP(19), gw, NGW, lane); GRID_BAR();
#endif
        gather_phase(ws, INP(18), INP(19), gw, NGW, lane); if (BOTH(15)) GRID_BAR(); }
    if (IN(16) || IN(17)) {
        const int* META = (const int*)(ws + RT_META);
        const int ntiles = __builtin_amdgcn_readfirstlane(ld_i(META));
        if (IN(16)) {
            pg8::Gemm g{(const bf16*)(ws + S_XP), (const bf16*)(ws + WB_EGU), 0, 2 * DFF, DM / 2}; pg8::MoeOrder S; S.init(ntiles, 2 * DFF, G, bx, 0, META + 32, (size_t)2 * DFF * DM);
            pg8::EpiSwiglu8 E{ws + R_HE, DFF};
#if REP(16)
            pg8::gemm_phase<pg8::EpiSwiglu8, pg8::MoeOrder, true, true, true>(ldsl + RING_OFF, g, S, E); GRID_BAR();
#endif
            STAGGER(2400);
            pg8::gemm_phase<pg8::EpiSwiglu8, pg8::MoeOrder, true, true, true, PB(16)>(ldsl + RING_OFF, g, S, E); EPI_SPIN(16);
            if (BOTH(16)) GRID_BAR();
        }
        if (IN(17)) {
            const int nmain = ntiles < MOE_MAIN_TILES ? ntiles : MOE_MAIN_TILES;
            { pg8::Gemm g{(const bf16*)(ws + R_HE), (const bf16*)(ws + WB_EDN), 0, DM, DFF / 2}; pg8::MoeOrder S; S.init(nmain, DM, G, bx, 0, META + 32, (size_t)DM * DFF);
              pg8::EpiPlainS E{(bf16*)(ws + S_XP), DM, 1.f / (pg8::W8_SCALE * pg8::H8_SCALE), nullptr, 0};
              pg8::gemm_phase<pg8::EpiPlainS, pg8::MoeOrder, true, true, true>(ldsl + RING_OFF, g, S, E); }
            if (ntiles > MOE_MAIN_TILES) {
              pg8::Gemm g{(const bf16*)(ws + R_HE), (const bf16*)(ws + WB_EDN), 0, DM, DFF / 2, DFF / 4}; pg8::TailOrder S{MOE_MAIN_TILES, ntiles - MOE_MAIN_TILES, G, bx, META + 32, (size_t)DM * DFF, (size_t)DFF / 2};
              pg8::EpiPlainS E{(bf16*)(ws + S_XP), DM, 1.f / (pg8::W8_SCALE * pg8::H8_SCALE), (bf16*)(ws + R_YPB), MOE_MAIN_TILES * 256};
              pg8::gemm_phase<pg8::EpiPlainS, pg8::TailOrder, true, true, true>(ldsl + RING_OFF, g, S, E); }
            if (BOTH(17)) GRID_BAR();
        }
    }
    if (IN(18)) {
#ifdef THIN_PROBE
        final_phase(ws, *(float* const KA_CONST*)((const KA_CONST char*)__builtin_amdgcn_kernarg_segment_ptr() + 216), INP(18), INP(19), INP(25), INP(26), gw, NGW, lane); GRID_BAR();
#endif
#ifdef BAR_PROBE
        for (int i_ = 0; i_ < 20; ++i_) GRID_BAR();
#endif
        final_phase(ws, *(float* const KA_CONST*)((const KA_CONST char*)__builtin_amdgcn_kernarg_segment_ptr() + 216), INP(18), INP(19), INP(25), INP(26), gw, NGW, lane); }
#undef IN
#undef BOTH
#undef GRID_BAR
#undef XB
#undef XR
#undef RES0
#undef MIX
#undef COS128
#undef SIN128
#undef COS64
#undef SIN64
#undef SSQ
}

extern "C" void kernel_launch(void* const* d_in, const int* in_sizes, int n_in, void* d_out, int out_size, void* d_ws, size_t ws_size, hipStream_t stream) {
    static int grid = 0;
    if (grid == 0) {
        if (n_in != 27 || in_sizes[0] != TOK * DM || out_size != TOK * DM || ws_size < WS_END) {
            fprintf(stderr, "kernel_launch: built for 27 inputs, x/out of %d floats, >= %zu bytes of workspace; got n_in %d, in0 %d, out %d, ws %zu; nothing launched\n", TOK * DM, (size_t)WS_END, n_in, n_in > 0 ? in_sizes[0] : -1, out_size, ws_size);
            grid = -1; return; }
        int dev = 0, cus = 0, per_cu = 0;
        if (hipGetDevice(&dev) != hipSuccess || hipDeviceGetAttribute(&cus, hipDeviceAttributeMultiprocessorCount, dev) != hipSuccess) { fprintf(stderr, "kernel_launch: device query failed\n"); grid = -1; return; }
        if (hipFuncSetAttribute((const void*)mega_fwd, hipFuncAttributeMaxDynamicSharedMemorySize, LDS_BYTES) != hipSuccess) { fprintf(stderr, "kernel_launch: hipFuncSetAttribute failed\n"); grid = -1; return; }
        if (hipOccupancyMaxActiveBlocksPerMultiprocessor(&per_cu, (const void*)mega_fwd, NWAVES * 64, LDS_BYTES) != hipSuccess || per_cu < 1)
            fprintf(stderr, "kernel_launch: note: occupancy query reports %d workgroups per CU\n", per_cu);
        (void)hipGetLastError();
        grid = cus;
    }
    if (grid < 0) return;
    if (hipMemsetAsync((char*)d_ws + WS_CTL, 0, CTL_ZERO_BYTES, stream) != hipSuccess) { fprintf(stderr, "kernel_launch: memset failed\n"); return; }
    Args a{};
    for (int i = 0; i < 27; ++i) a.in.p[i] = (const float*)d_in[i];
    a.out = (float*)d_out; a.ws = (unsigned char*)d_ws;
#if MK_PER_PHASE
    for (int ph = 0; ph < NPH; ++ph) { a.ph_lo = ph; a.ph_hi = ph + 1; hipLaunchKernelGGL(mega_fwd, dim3(grid), dim3(NWAVES * 64), LDS_BYTES, stream, a); }
#else
    a.ph_lo = 0; a.ph_hi = NPH; hipLaunchKernelGGL(mega_fwd, dim3(grid), dim3(NWAVES * 64), LDS_BYTES, stream, a);
#endif
    const hipError_t le = hipPeekAtLastError();
    if (le != hipSuccess) fprintf(stderr, "kernel_launch: launch failed: %s\n", hipGetErrorName(le));
}
```
